# Optimizing an MI355X kernel written in HIP

```python
import math
import jax
import jax.numpy as jnp
from jax import lax
import numpy as np

D_MODEL = 1024
BATCH = 4
SEQ = 4096
DEPTH = 2

GRID_W = 64
CTX_LEN = 256
D_MIX = D_MODEL
EPS = 1e-6

MLA_HEADS = 6
MLA_NOPE = 64
MLA_ROPE = 32
MLA_QK = MLA_NOPE + MLA_ROPE
MLA_V = 64
MLA_Q_LORA = 256
MLA_KV_LORA = 128
ROPE_THETA = 10000.0
ROPE_FREQS = MLA_ROPE // 4
Q_BLOCK = 128

SSM_HEADS = 6
SSM_HEAD_DIM = 64
SSM_INNER = SSM_HEADS * SSM_HEAD_DIM
SSM_GROUPS = 2
SSM_STATE = 64
SSM_CONV = 3
SSM_CHUNK = 128
SSM_XBC = SSM_INNER + 2 * SSM_GROUPS * SSM_STATE

HY_CH = D_MIX - MLA_HEADS * MLA_V - SSM_INNER
HY_ORDER = 2
HY_CONV = 3
HY_BANDS = 16
HY_EMB = 1 + 2 * HY_BANDS
HY_HIDDEN = 64
HY_DECAY_PCT_SHORT = 0.3
HY_DECAY_PCT_LONG = 1.5
HY_DECAY_TARGET = 1e-2

D_FF = 4 * D_MODEL

IN_SPLITS = (MLA_Q_LORA, MLA_KV_LORA, MLA_ROPE, SSM_INNER, SSM_XBC, 2 * SSM_HEADS, (HY_ORDER + 1) * HY_CH)
IN_COLS = sum(IN_SPLITS)
IN_OFFSETS = tuple(int(v) for v in np.cumsum(IN_SPLITS)[:-1])

kernel_name = 'hybrid_mla_ssd_hyena_prefix_block'


def rms_norm(x, g):
    xf = x.astype(jnp.float32)
    y = xf * lax.rsqrt(jnp.mean(xf * xf, axis=-1, keepdims=True) + EPS)
    return (y * g.astype(jnp.float32)).astype(x.dtype)


def modulate(h, shift, scale):
    return h * (1 + scale) + shift


def dw_conv(u, w, b):
    pad = w.shape[0] // 2
    y = lax.conv_general_dilated(u, w[:, None, :].astype(u.dtype), window_strides=(1,),
                                 padding=[(pad, pad)], dimension_numbers=('NWC', 'WIO', 'NWC'),
                                 feature_group_count=u.shape[-1])
    return y + b.astype(u.dtype)


def axial_rope_tables(length):
    rows = length // GRID_W
    row = jnp.repeat(jnp.arange(rows), GRID_W).astype(jnp.float32)
    col = (jnp.arange(rows * GRID_W) % GRID_W).astype(jnp.float32)
    inv = ROPE_THETA ** (-jnp.arange(ROPE_FREQS, dtype=jnp.float32) / ROPE_FREQS)
    ang = jnp.stack([row[:, None] * inv, col[:, None] * inv], axis=1)
    return jnp.cos(ang), jnp.sin(ang)


def apply_axial_rope(x, cos, sin):
    xr = x.astype(jnp.float32).reshape(x.shape[:-1] + (2, 2, ROPE_FREQS))
    x1, x2 = xr[..., 0, :], xr[..., 1, :]
    cs, sn = cos[None, :, None], sin[None, :, None]
    out = jnp.stack([x1 * cs - x2 * sn, x2 * cs + x1 * sn], axis=-2)
    return out.reshape(x.shape).astype(x.dtype)


def mla_query(cq, g_cq, w_uq, g_qh, rope):
    b, l, _ = cq.shape
    q = (rms_norm(cq, g_cq) @ w_uq).reshape(b, l, MLA_HEADS, MLA_QK)
    q = rms_norm(q, g_qh)
    if rope is None:
        return q
    return jnp.concatenate([q[..., :MLA_NOPE], apply_axial_rope(q[..., MLA_NOPE:], *rope)], axis=-1)


def mla_keyval(ckv, krope, g_ckv, w_ukv, g_kh, rope):
    b, l, _ = ckv.shape
    kv = (rms_norm(ckv, g_ckv) @ w_ukv).reshape(b, l, MLA_HEADS, MLA_NOPE + MLA_V)
    k_nope, v = kv[..., :MLA_NOPE], kv[..., MLA_NOPE:]
    k_pe = jnp.broadcast_to(krope[:, :, None, :], (b, l, MLA_HEADS, MLA_ROPE))
    k = rms_norm(jnp.concatenate([k_nope, k_pe], axis=-1), g_kh)
    if rope is not None:
        k = jnp.concatenate([k[..., :MLA_NOPE], apply_axial_rope(k[..., MLA_NOPE:], *rope)], axis=-1)
    return k, v


def block_attention(q, k, v):
    b, lq, h, e = q.shape
    scale = 1.0 / math.sqrt(e)
    qb = q.reshape(b, lq // Q_BLOCK, Q_BLOCK, h, e).transpose(1, 0, 2, 3, 4)

    def one_block(qi):
        s = jnp.einsum('bqhe,bkhe->bhqk', qi, k, preferred_element_type=jnp.float32) * scale
        p = jax.nn.softmax(s, axis=-1).astype(v.dtype)
        return jnp.einsum('bhqk,bkhv->bqhv', p, v)

    out = lax.map(one_block, qb)
    return out.transpose(1, 0, 2, 3, 4).reshape(b, lq, h * v.shape[-1])


def ssd_scan(xh, dt, a, bh, ch, init_state):
    b, l, h, p = xh.shape
    n = bh.shape[-1]
    nc = l // SSM_CHUNK
    xc = xh.astype(jnp.float32).reshape(b, nc, SSM_CHUNK, h, p)
    bc = bh.astype(jnp.float32).reshape(b, nc, SSM_CHUNK, h, n)
    cc = ch.astype(jnp.float32).reshape(b, nc, SSM_CHUNK, h, n)
    dtc = dt.reshape(b, nc, SSM_CHUNK, h)
    cum = jnp.cumsum(dtc * a, axis=2)
    tri = jnp.tril(jnp.ones((SSM_CHUNK, SSM_CHUNK), dtype=bool))[None, None, :, :, None]
    seg = cum[:, :, :, None, :] - cum[:, :, None, :, :]
    decay = jnp.where(tri, jnp.exp(jnp.where(tri, seg, 0.0)), 0.0)
    scores = jnp.einsum('bcihn,bcjhn->bcijh', cc, bc) * decay
    y_diag = jnp.einsum('bcijh,bcjhp->bcihp', scores * dtc[:, :, None, :, :], xc)
    w_end = jnp.exp(cum[:, :, -1:, :] - cum) * dtc
    chunk_states = jnp.einsum('bcjhn,bcjh,bcjhp->bchpn', bc, w_end, xc)
    chunk_decay = jnp.exp(cum[:, :, -1, :])

    def step(s, inp):
        st, dec = inp
        return s * dec[:, :, None, None] + st, s

    final, prev = lax.scan(step, init_state.astype(jnp.float32),
                           (jnp.moveaxis(chunk_states, 1, 0), jnp.moveaxis(chunk_decay, 1, 0)))
    prev = jnp.moveaxis(prev, 0, 1)
    y_off = jnp.einsum('bcihn,bchpn->bcihp', cc, prev) * jnp.exp(cum)[..., None]
    return (y_diag + y_off).reshape(b, l, h, p), final


def ssm_prepare(xbc, dt_raw, w_conv, b_conv, dt_bias):
    b, l, _ = xbc.shape
    u = jax.nn.silu(dw_conv(xbc, w_conv, b_conv))
    rep = SSM_HEADS // SSM_GROUPS
    xs = u[..., :SSM_INNER].reshape(b, l, SSM_HEADS, SSM_HEAD_DIM)
    bs = jnp.repeat(u[..., SSM_INNER:SSM_INNER + SSM_GROUPS * SSM_STATE].reshape(b, l, SSM_GROUPS, SSM_STATE), rep, axis=2)
    cs = jnp.repeat(u[..., SSM_INNER + SSM_GROUPS * SSM_STATE:].reshape(b, l, SSM_GROUPS, SSM_STATE), rep, axis=2)
    dt = jax.nn.softplus(dt_raw.astype(jnp.float32).reshape(b, l, 2, SSM_HEADS) + dt_bias.astype(jnp.float32))
    return xs, bs, cs, dt


def bidir_ssd(xs, bs, cs, dt, a, init_fwd, init_bwd):
    flip = lambda t: jnp.flip(t, axis=1)
    y_f, s_f = ssd_scan(xs, dt[:, :, 0], a[0], bs, cs, init_fwd)
    y_b, s_b = ssd_scan(flip(xs), flip(dt[:, :, 1]), a[1], flip(bs), flip(cs), init_bwd)
    return y_f + flip(y_b), s_f, s_b


def ssm_out(y, xs, z, d_skip, g_norm):
    b, l = y.shape[:2]
    y = y + xs.astype(jnp.float32) * d_skip.astype(jnp.float32)[:, None]
    y = y.reshape(b, l, SSM_INNER) * jax.nn.silu(z.astype(jnp.float32))
    y = rms_norm(y.reshape(b, l, SSM_GROUPS, SSM_INNER // SSM_GROUPS), g_norm.reshape(SSM_GROUPS, -1))
    return y.reshape(b, l, SSM_INNER)


def hyena_filters(length, w_f1, b_f1, freq_f1, w_f2, b_f2, freq_f2, w_f3):
    f32 = jnp.float32
    t01 = jnp.linspace(0.0, 1.0, length, dtype=f32)[:, None]
    w = (2.0 * math.pi / length) * jnp.arange(length, dtype=f32)[:, None]
    bands = jnp.linspace(1e-4, HY_BANDS - 1, HY_BANDS, dtype=f32)[None, :]
    feats = jnp.concatenate([t01, jnp.cos(bands * w), -jnp.sin(bands * w)], axis=-1)
    h = jnp.sin(freq_f1.astype(f32) * (feats @ w_f1.astype(f32) + b_f1.astype(f32)))
    h = jnp.sin(freq_f2.astype(f32) * (h @ w_f2.astype(f32) + b_f2.astype(f32)))
    h = (h @ w_f3.astype(f32)).reshape(length, 2, HY_ORDER, HY_CH)
    deltas = jnp.abs(jnp.linspace(math.log(HY_DECAY_TARGET) / HY_DECAY_PCT_LONG,
                                  math.log(HY_DECAY_TARGET) / HY_DECAY_PCT_SHORT, HY_CH, dtype=f32))
    h = h * jnp.exp(-t01 * deltas)[:, None, None, :]
    filt = jnp.concatenate([h[:, 0], jnp.zeros((1, HY_ORDER, HY_CH), f32), jnp.flip(h[1:, 1], axis=0)], axis=0)
    return filt / (jnp.sum(jnp.abs(filt), axis=0, keepdims=True) + EPS)


def fft_long_conv(u, filt, d):
    l = u.shape[1]
    spec = jnp.fft.rfft(u, n=2 * l, axis=1) * jnp.fft.rfft(filt, axis=0)[None]
    return jnp.fft.irfft(spec, n=2 * l, axis=1)[:, :l] + u * d


def hyena_mixer(proj, w_conv, b_conv, w_f1, b_f1, freq_f1, w_f2, b_f2, freq_f2, w_f3, d_skip):
    l = proj.shape[1]
    parts = jnp.split(dw_conv(proj, w_conv, b_conv).astype(jnp.float32), HY_ORDER + 1, axis=-1)
    filt = hyena_filters(l, w_f1, b_f1, freq_f1, w_f2, b_f2, freq_f2, w_f3)
    z = parts[0]
    for o in range(HY_ORDER):
        z = parts[o + 1] * fft_long_conv(z, filt[:, o], d_skip[o].astype(jnp.float32))
    return z


def sq_relu_mlp(h, w1, w2):
    return jnp.square(jax.nn.relu(h @ w1)) @ w2


def setup_inputs(seed: int = 0) -> dict:
    f32 = jnp.float32
    keys = iter(jax.random.split(jax.random.key(seed), 40))

    def normal(shape, scale):
        return jax.random.normal(next(keys), shape, f32) * scale

    def gain(shape):
        return 1.0 + 0.05 * jax.random.normal(next(keys), shape, f32)

    dt0 = jnp.exp(jax.random.uniform(next(keys), (DEPTH, 2, SSM_HEADS), f32, math.log(1e-3), math.log(1e-1)))
    a0 = jax.random.uniform(next(keys), (DEPTH, 2, SSM_HEADS), f32, 1.0, 16.0)
    return {
        'x': normal((BATCH, SEQ, D_MODEL), 1.0),
        'c': normal((BATCH, D_MODEL), 1.0),
        'ctx': normal((BATCH, CTX_LEN, D_MODEL), 1.0),
        'c_ctx': normal((D_MODEL,), 1.0),
        'w_mod': normal((DEPTH, D_MODEL, 6 * D_MODEL), D_MODEL ** -0.5),
        'b_mod': normal((DEPTH, 6 * D_MODEL), 0.02),
        'g_norm_mix': gain((DEPTH, D_MODEL)),
        'g_norm_mlp': gain((DEPTH, D_MODEL)),
        'w_in': normal((DEPTH, D_MODEL, IN_COLS), D_MODEL ** -0.5),
        'w_out': normal((DEPTH, D_MIX, D_MODEL), D_MIX ** -0.5),
        'g_cq': gain((DEPTH, MLA_Q_LORA)),
        'g_ckv': gain((DEPTH, MLA_KV_LORA)),
        'w_uq': normal((DEPTH, MLA_Q_LORA, MLA_HEADS * MLA_QK), MLA_Q_LORA ** -0.5),
        'w_ukv': normal((DEPTH, MLA_KV_LORA, MLA_HEADS * (MLA_NOPE + MLA_V)), MLA_KV_LORA ** -0.5),
        'g_qhead': gain((DEPTH, MLA_QK)),
        'g_khead': gain((DEPTH, MLA_QK)),
        'w_conv_ssm': normal((DEPTH, SSM_CONV, SSM_XBC), SSM_CONV ** -0.5),
        'b_conv_ssm': normal((DEPTH, SSM_XBC), 0.02),
        'a_log': jnp.log(a0),
        'dt_bias': dt0 + jnp.log(-jnp.expm1(-dt0)),
        'd_skip_ssm': gain((DEPTH, SSM_HEADS)),
        'g_ssm_out': gain((DEPTH, SSM_INNER)),
        'w_conv_hy': normal((DEPTH, HY_CONV, (HY_ORDER + 1) * HY_CH), HY_CONV ** -0.5),
        'b_conv_hy': normal((DEPTH, (HY_ORDER + 1) * HY_CH), 0.02),
        'w_f1': normal((DEPTH, HY_EMB, HY_HIDDEN), HY_EMB ** -0.5),
        'b_f1': normal((DEPTH, HY_HIDDEN), 0.02),
        'freq_f1': gain((DEPTH, HY_HIDDEN)),
        'w_f2': normal((DEPTH, HY_HIDDEN, HY_HIDDEN), HY_HIDDEN ** -0.5),
        'b_f2': normal((DEPTH, HY_HIDDEN), 0.02),
        'freq_f2': gain((DEPTH, HY_HIDDEN)),
        'w_f3': normal((DEPTH, HY_HIDDEN, 2 * HY_ORDER * HY_CH), HY_HIDDEN ** -0.5),
        'd_skip_hy': normal((DEPTH, HY_ORDER, HY_CH), 1.0),
        'w_ff1': normal((DEPTH, D_MODEL, D_FF), D_MODEL ** -0.5),
        'w_ff2': normal((DEPTH, D_FF, D_MODEL), D_FF ** -0.5),
    }


def reference(x, c, ctx, c_ctx, w_mod, b_mod, g_norm_mix, g_norm_mlp, w_in, w_out,
              g_cq, g_ckv, w_uq, w_ukv, g_qhead, g_khead,
              w_conv_ssm, b_conv_ssm, a_log, dt_bias, d_skip_ssm, g_ssm_out,
              w_conv_hy, b_conv_hy, w_f1, b_f1, freq_f1, w_f2, b_f2, freq_f2, w_f3, d_skip_hy,
              w_ff1, w_ff2):
    bsz, seq, _ = x.shape
    rope_l = axial_rope_tables(seq)
    xl, xc = x, ctx
    for i in range(DEPTH):
        last = i == DEPTH - 1
        mod_l = jax.nn.silu(c) @ w_mod[i] + b_mod[i]
        mod_c = jax.nn.silu(c_ctx) @ w_mod[i] + b_mod[i]
        sh1_l, sc1_l, ga1_l, sh2_l, sc2_l, ga2_l = jnp.split(mod_l[:, None, :], 6, axis=-1)
        sh1_c, sc1_c, ga1_c, sh2_c, sc2_c, ga2_c = jnp.split(mod_c, 6, axis=-1)

        hl = modulate(rms_norm(xl, g_norm_mix[i]), sh1_l, sc1_l)
        hc = modulate(rms_norm(xc, g_norm_mix[i]), sh1_c, sc1_c)
        cq_l, ckv_l, kr_l, z_l, xbc_l, dt_l, hy_l = jnp.split(hl @ w_in[i], IN_OFFSETS, axis=-1)
        cq_c, ckv_c, kr_c, z_c, xbc_c, dt_c, hy_c = jnp.split(hc @ w_in[i], IN_OFFSETS, axis=-1)

        k_c, v_c = mla_keyval(ckv_c, kr_c, g_ckv[i], w_ukv[i], g_khead[i], None)
        k_l, v_l = mla_keyval(ckv_l, kr_l, g_ckv[i], w_ukv[i], g_khead[i], rope_l)
        q_l = mla_query(cq_l, g_cq[i], w_uq[i], g_qhead[i], rope_l)
        att_l = block_attention(q_l, jnp.concatenate([k_c, k_l], axis=1), jnp.concatenate([v_c, v_l], axis=1))

        a = -jnp.exp(a_log[i].astype(jnp.float32))
        xs_c, bs_c, cs_c, dts_c = ssm_prepare(xbc_c, dt_c, w_conv_ssm[i], b_conv_ssm[i], dt_bias[i])
        xs_l, bs_l, cs_l, dts_l = ssm_prepare(xbc_l, dt_l, w_conv_ssm[i], b_conv_ssm[i], dt_bias[i])
        zero = jnp.zeros((bsz, SSM_HEADS, SSM_HEAD_DIM, SSM_STATE), jnp.float32)
        y_c, s_fwd, s_bwd = bidir_ssd(xs_c, bs_c, cs_c, dts_c, a, zero, zero)
        y_l, _, _ = bidir_ssd(xs_l, bs_l, cs_l, dts_l, a, s_fwd, s_bwd)
        ssm_l = ssm_out(y_l, xs_l, z_l, d_skip_ssm[i], g_ssm_out[i])

        hyp = (w_conv_hy[i], b_conv_hy[i], w_f1[i], b_f1[i], freq_f1[i], w_f2[i], b_f2[i], freq_f2[i], w_f3[i], d_skip_hy[i])
        hyo_l = hyena_mixer(hy_l, *hyp)

        mix_l = jnp.concatenate([att_l, ssm_l.astype(xl.dtype), hyo_l.astype(xl.dtype)], axis=-1) @ w_out[i]
        xl = xl + ga1_l * mix_l
        xl = xl + ga2_l * sq_relu_mlp(modulate(rms_norm(xl, g_norm_mlp[i]), sh2_l, sc2_l), w_ff1[i], w_ff2[i])

        if not last:
            q_c = mla_query(cq_c, g_cq[i], w_uq[i], g_qhead[i], None)
            att_c = block_attention(q_c, k_c, v_c)
            ssm_c = ssm_out(y_c, xs_c, z_c, d_skip_ssm[i], g_ssm_out[i])
            hyo_c = hyena_mixer(hy_c, *hyp)
            mix_c = jnp.concatenate([att_c, ssm_c.astype(xc.dtype), hyo_c.astype(xc.dtype)], axis=-1) @ w_out[i]
            xc = xc + ga1_c * mix_c
            xc = xc + ga2_c * sq_relu_mlp(modulate(rms_norm(xc, g_norm_mlp[i]), sh2_c, sc2_c), w_ff1[i], w_ff2[i])
    return xl
```

```cpp
#include <hip/hip_runtime.h>
#include <hip/hip_cooperative_groups.h>
#include <cstdio>
#include <cstdint>
namespace cg = cooperative_groups;

#ifndef REP_MASK
#define REP_MASK 0
#endif
#define PROBE_SUB 0
#ifndef N_LAUNCH_MODE
#define N_LAUNCH_MODE 1
#endif

typedef unsigned short bf16_t;
typedef short bf16x8 __attribute__((ext_vector_type(8)));
typedef short s16x4 __attribute__((ext_vector_type(4)));
typedef float f32x16 __attribute__((ext_vector_type(16)));
typedef float f32x4 __attribute__((ext_vector_type(4)));
typedef unsigned u32x4 __attribute__((ext_vector_type(4)));
typedef unsigned u32x2 __attribute__((ext_vector_type(2)));
#define DI __device__ __forceinline__
#define MFMA(a, b, c) __builtin_amdgcn_mfma_f32_32x32x16_bf16((a), (b), (c), 0, 0, 0)

constexpr int D = 1024, NB = 4, SEQ = 4096, CTX = 256;
constexpr int NL = NB * SEQ, NC = NB * CTX, NT = NL + NC;
constexpr int INC = 2220, INP = 2304;
constexpr int O_CQ = 0, O_CKV = 256, O_KR = 384, O_Z = 416, O_XBC = 800, O_DT = 1440, O_HY = 1452;
constexpr int NKEY = CTX + SEQ;
constexpr int NCHK = 34;
constexpr float EPS = 1e-6f;
constexpr int LDS_MAIN = 73728;
constexpr int LDS_BYTES = LDS_MAIN + 16;
constexpr int NTHREADS = 256;

constexpr size_t WS_CTRL = 0;
constexpr size_t WS_MOD = 16384;
constexpr size_t WS_W = WS_MOD + 245760;
constexpr size_t W_IN = 0, W_OUT = W_IN + (size_t)INP * 1024 * 2, W_FF1 = W_OUT + 1024 * 1024 * 2, W_FF2 = W_FF1 + 4096 * 1024 * 2,
                 W_UQ = W_FF2 + 4096 * 1024 * 2, W_UKV = W_UQ + 576 * 256 * 2, W_END = W_UKV + 768 * 128 * 2;
constexpr size_t ST_BYTES = (size_t)2 * 4 * 6 * NCHK * 4096 * 4, WREG = ST_BYTES + 8192;
static_assert(W_END <= WREG, "weight region");
constexpr size_t WS_FL = WS_W + WREG;
constexpr size_t WS_FC = WS_FL + 2 * 256 * 8192 * 2;
constexpr size_t WS_FPL = WS_FC + 2 * 256 * 512 * 2;
constexpr size_t WS_FPC = WS_FPL + 128 * 1024 * 4;
constexpr size_t WS_XC = WS_FPC + 8 * 1024 * 4;
constexpr size_t WS_H = WS_XC + (size_t)NC * 1024 * 4;
constexpr size_t WS_Q = WS_H;
constexpr size_t WS_QC = WS_Q + (size_t)4 * 6 * 4096 * 96 * 2;
constexpr size_t WS_VT = WS_QC + (size_t)4 * 6 * 256 * 96 * 2;
constexpr size_t WS_PROJ = WS_H + (size_t)NT * 1024 * 2;
constexpr size_t WS_ST = WS_PROJ;
constexpr size_t WS_DEC = WS_ST + (size_t)2 * 4 * 6 * NCHK * 4096 * 4;
constexpr size_t WS_HYOT = WS_DEC + 8192;
constexpr size_t WS_MIX = WS_HYOT + (size_t)256 * NT * 2;
constexpr size_t WS_K = WS_PROJ + (size_t)NT * INP * 2;
constexpr size_t WS_UZ = WS_K + (size_t)4 * 6 * NKEY * 96 * 2;
constexpr size_t WS_DT = WS_UZ + (size_t)NT * 1024 * 2;
constexpr size_t WS_P = WS_DT + (size_t)NT * 12 * 4;
constexpr size_t WS_END = WS_P + (size_t)3 * 256 * NT * 2;
constexpr size_t WS_HID = WS_PROJ;
constexpr size_t WS_W2 = WS_END;
constexpr size_t WS_TOTAL = WS_W2 + WREG;
DI size_t wbase(int layer) { return layer ? WS_W2 : WS_W; }
DI size_t stbase(int layer) { return layer ? WS_W : WS_W2; }
static_assert(WS_MIX + (size_t)NT * 1024 * 2 <= WS_K, "alias overflow");
static_assert(WS_VT + (size_t)4 * 6 * 64 * NKEY * 2 <= WS_PROJ, "alias overflow");
static_assert(WS_HID + (size_t)NT * 4096 * 2 <= WS_END, "hid overflow");
static_assert(WS_TOTAL <= 268435456ull, "ws overflow");

struct Params { const float* in[34]; float* out; unsigned char* ws; };
enum { I_X = 0, I_C, I_CTX, I_CCTX, I_WMOD, I_BMOD, I_GMIX, I_GMLP, I_WIN, I_WOUT, I_GCQ, I_GCKV, I_WUQ, I_WUKV, I_GQH, I_GKH,
       I_WCS, I_BCS, I_ALOG, I_DTB, I_DSS, I_GSO, I_WCH, I_BCH, I_WF1, I_BF1, I_FQ1, I_WF2, I_BF2, I_FQ2, I_WF3, I_DSH, I_WFF1, I_WFF2 };

DI int get_tid() { int t = (int)__builtin_amdgcn_workitem_id_x(); asm volatile("" : "+v"(t)); return t; }
DI float bf2f(bf16_t v) { return __uint_as_float(((unsigned)v) << 16); }
DI unsigned pack2(float lo, float hi) { unsigned r; asm("v_cvt_pk_bf16_f32 %0, %1, %2" : "=v"(r) : "v"(lo), "v"(hi)); return r; }
DI bf16_t f2bf(float x) { unsigned r; asm("v_cvt_pk_bf16_f32 %0, %1, %1" : "=v"(r) : "v"(x)); return (bf16_t)r; }
DI int crow(int reg, int h) { return (reg & 3) + 8 * (reg >> 2) + 4 * h; }
DI f32x16 zero16() { f32x16 z; _Pragma("unroll") for (int i = 0; i < 16; ++i) z[i] = 0.f; return z; }
DI bf16x8 pack8(float a0, float a1, float a2, float a3, float a4, float a5, float a6, float a7) {
    u32x4 u; u.x = pack2(a0, a1); u.y = pack2(a2, a3); u.z = pack2(a4, a5); u.w = pack2(a6, a7); return __builtin_bit_cast(bf16x8, u);
}
DI bf16x8 ld8(const bf16_t* p) { return *(const bf16x8*)p; }
DI bf16x8 ld4x2(const bf16_t* p0, const bf16_t* p1) {
    u32x2 a = *(const u32x2*)p0, b = *(const u32x2*)p1; u32x4 u; u.x = a.x; u.y = a.y; u.z = b.x; u.w = b.y; return __builtin_bit_cast(bf16x8, u);
}
DI float xor_red32(float v) { v += __shfl_xor(v, 16); v += __shfl_xor(v, 8); v += __shfl_xor(v, 4); v += __shfl_xor(v, 2); v += __shfl_xor(v, 1); return v; }
DI float wave_sum(float v) { _Pragma("unroll") for (int o = 1; o < 64; o <<= 1) v += __shfl_xor(v, o); return v; }
DI float silu(float x) { return x / (1.f + __expf(-x)); }
DI float softplus(float x) { return fmaxf(x, 0.f) + log1pf(__expf(-fabsf(x))); }


#define XB_TMO      128
#define XB_XCNT(j)  (256  + 64 * (j))
#define XB_XSUB(j)  (1280 + 64 * (j))
#define XB_XGEN(j)  (2304 + 64 * (j))
#define XB_TOP      3328
#define XB_TOPGEN   3392
#define XCD_BAR_WORDS 3456
#define XB_SPIN_CAP (1u << 20)
#define LAS __attribute__((address_space(3)))
DI unsigned xb_ld(unsigned* p)              { return __hip_atomic_load(p, __ATOMIC_RELAXED, __HIP_MEMORY_SCOPE_AGENT); }
DI unsigned xb_add(unsigned* p, unsigned v) { return __hip_atomic_fetch_add(p, v, __ATOMIC_RELAXED, __HIP_MEMORY_SCOPE_AGENT); }
DI unsigned xb_xcc_id() { return (unsigned)__builtin_amdgcn_s_getreg((3 << 11) | 20) & 0xFu; }
#define XB_SPIN(cond, bar) do { unsigned _sp = 0; while (cond) { __builtin_amdgcn_s_sleep(1); \
    if ((++_sp & 255u) == 0u) { if (xb_ld(&(bar)[XB_TMO])) break; if (_sp > XB_SPIN_CAP) { atomicAdd(&(bar)[XB_TMO], 1u); break; } } } } while (0)
struct XcdBarrier { unsigned* bar; unsigned x; volatile LAS unsigned* st; };
DI XcdBarrier xcd_barrier_post(unsigned* bar, volatile LAS unsigned* st) {
    XcdBarrier b; b.bar = bar; b.x = xb_xcc_id(); b.st = st;
    if (__builtin_amdgcn_workitem_id_x() == 0) (void)xb_add(&bar[XB_XCNT(b.x)], 1u);
    return b;
}
DI void xcd_barrier_complete(unsigned* bar, unsigned x, unsigned& nloc, unsigned& nx) {
    const unsigned G = gridDim.x * gridDim.y * gridDim.z;
    unsigned sum, cnt, mine, sp = 0u;
    for (;;) {
        sum = 0u; cnt = 0u; mine = 0u;
#pragma unroll
        for (unsigned j = 0; j < 16; ++j) { const unsigned c = xb_ld(&bar[XB_XCNT(j)]); sum += c; cnt += (c > 0u) ? 1u : 0u; mine = (j == x) ? c : mine; }
        if (sum == G) break;
        __builtin_amdgcn_s_sleep(1);
        if ((++sp & 255u) == 0u) { if (xb_ld(&bar[XB_TMO])) break; if (sp > XB_SPIN_CAP) { atomicAdd(&bar[XB_TMO], 1u); break; } }
    }
    nloc = mine > 0u ? mine : 1u; nx = cnt > 0u ? cnt : 1u;
}
DI void xcd_barrier(const XcdBarrier& b) {
    asm volatile("s_waitcnt vmcnt(0)" ::: "memory");
    __syncthreads();
    if (__builtin_amdgcn_workitem_id_x() == 0) {
        unsigned* bar = b.bar;
        __builtin_amdgcn_s_waitcnt(0);
        unsigned nloc = b.st[0], nx = b.st[1];
        if (nloc == 0u) { xcd_barrier_complete(bar, b.x, nloc, nx); b.st[0] = nloc; b.st[1] = nx; }
        const unsigned old = xb_add(&bar[XB_XSUB(b.x)], 1u);
        const unsigned gen = old / nloc;
        if (old + 1u == (gen + 1u) * nloc) {
            __builtin_amdgcn_fence(__ATOMIC_RELEASE, "agent");
            asm volatile("s_waitcnt vmcnt(0)" ::: "memory");
            const unsigned og = xb_add(&bar[XB_TOP], 1u);
            const unsigned tg = og / nx;
            if (og + 1u == (tg + 1u) * nx) xb_add(&bar[XB_TOPGEN], 1u);
            else XB_SPIN(xb_ld(&bar[XB_TOPGEN]) == tg, bar);
            __builtin_amdgcn_fence(__ATOMIC_ACQUIRE, "agent");
            xb_add(&bar[XB_XGEN(b.x)], 1u);
            asm volatile("s_waitcnt vmcnt(0)" ::: "memory");
        } else {
            XB_SPIN(xb_ld(&bar[XB_XGEN(b.x)]) == gen, bar);
            __builtin_amdgcn_fence(__ATOMIC_ACQUIRE, "agent");
            asm volatile("s_waitcnt vmcnt(0)" ::: "memory");
        }
    }
    __syncthreads();
}

DI void row_info(int r, int& b, int& t, int& L) { if (r < NL) { b = r >> 12; t = r & 4095; L = SEQ; } else { int q = r - NL; b = q >> 8; t = q & 255; L = CTX; } }

template <class Epi>
DI void gemm_tile(const bf16_t* __restrict__ A, int lda, const bf16_t* __restrict__ Bt, int ldb, int K, int m0, int n0, unsigned char* smem, Epi epi, const bf16_t* __restrict__ HYT = nullptr) {
    constexpr int LS = 72;
    bf16_t* As = (bf16_t*)smem;
    bf16_t* Bs = As + 2 * 128 * LS;
    const int tid = get_tid(), lane = tid & 63, wave = tid >> 6, wr = wave >> 1, wc = wave & 1, li = lane & 31, lh = lane >> 5;
    f32x16 acc[2][2];
#pragma unroll
    for (int a = 0; a < 2; ++a)
#pragma unroll
        for (int b = 0; b < 2; ++b) acc[a][b] = zero16();
    u32x4 R0[8], R1[8];
    const int nk = K >> 6;
    auto gload = [&](u32x4 (&r)[8], int kt) {
#pragma unroll
        for (int i = 0; i < 4; ++i) { int id = tid + 256 * i, row = id >> 3, kc = id & 7;
            if (HYT && kt >= 12) r[i] = *(const u32x4*)(HYT + (size_t)((kt - 12) * 64 + (id >> 4)) * NT + m0 + (id & 15) * 8);
            else r[i] = *(const u32x4*)(A + (size_t)(m0 + row) * lda + kt * 64 + kc * 8);
            r[4 + i] = *(const u32x4*)(Bt + (size_t)(n0 + row) * ldb + kt * 64 + kc * 8); }
    };
    auto sstore = [&](const u32x4 (&r)[8], int buf, int kt) {
#pragma unroll
        for (int i = 0; i < 4; ++i) { int id = tid + 256 * i, row = id >> 3, kc = id & 7;
            if (HYT && kt >= 12) { const int kk = id >> 4, rr = (id & 15) * 8; bf16_t* d = As + (buf * 128 + rr) * LS + kk; const bf16x8 v = __builtin_bit_cast(bf16x8, r[i]);
#pragma unroll
                for (int e = 0; e < 8; ++e) d[e * LS] = (bf16_t)v[e]; }
            else *(u32x4*)(As + (buf * 128 + row) * LS + kc * 8) = r[i];
            *(u32x4*)(Bs + (buf * 128 + row) * LS + kc * 8) = r[4 + i]; }
    };
    auto step = [&](int kt, u32x4 (&ldset)[8], const u32x4 (&stset)[8]) {
        const int buf = kt & 1;
        if (kt + 2 < nk) gload(ldset, kt + 2);
        const bf16_t* Ab = As + (buf * 128 + 64 * wr + li) * LS + 8 * lh;
        const bf16_t* Bb = Bs + (buf * 128 + 64 * wc + li) * LS + 8 * lh;
        bf16x8 fa[2][2], fb[2][2], ga[2][2], gb[2][2];
#pragma unroll
        for (int k2 = 0; k2 < 2; ++k2) { fa[k2][0] = ld8(Ab + 16 * k2); fa[k2][1] = ld8(Ab + 32 * LS + 16 * k2); fb[k2][0] = ld8(Bb + 16 * k2); fb[k2][1] = ld8(Bb + 32 * LS + 16 * k2); }
        __builtin_amdgcn_sched_barrier(0);
#pragma unroll
        for (int k2 = 0; k2 < 2; ++k2) {
            acc[0][0] = MFMA(fa[k2][0], fb[k2][0], acc[0][0]); acc[0][1] = MFMA(fa[k2][0], fb[k2][1], acc[0][1]);
            acc[1][0] = MFMA(fa[k2][1], fb[k2][0], acc[1][0]); acc[1][1] = MFMA(fa[k2][1], fb[k2][1], acc[1][1]);
        }
#pragma unroll
        for (int k2 = 0; k2 < 2; ++k2) { const int ks = 2 + k2; ga[k2][0] = ld8(Ab + 16 * ks); ga[k2][1] = ld8(Ab + 32 * LS + 16 * ks); gb[k2][0] = ld8(Bb + 16 * ks); gb[k2][1] = ld8(Bb + 32 * LS + 16 * ks); }
#pragma unroll
        for (int k2 = 0; k2 < 2; ++k2) {
            acc[0][0] = MFMA(ga[k2][0], gb[k2][0], acc[0][0]); acc[0][1] = MFMA(ga[k2][0], gb[k2][1], acc[0][1]);
            acc[1][0] = MFMA(ga[k2][1], gb[k2][0], acc[1][0]); acc[1][1] = MFMA(ga[k2][1], gb[k2][1], acc[1][1]);
        }
        if (kt + 1 < nk) sstore(stset, buf ^ 1, kt + 1);
#pragma unroll
        for (int i = 0; i < 8; ++i) { __builtin_amdgcn_sched_group_barrier(0x008, 1, 0); __builtin_amdgcn_sched_group_barrier(0x100, 1, 0); }
#pragma unroll
        for (int i = 0; i < 8; ++i) { __builtin_amdgcn_sched_group_barrier(0x008, 1, 0); __builtin_amdgcn_sched_group_barrier(0x200, 1, 0); }
        __builtin_amdgcn_sched_barrier(0);
        __syncthreads();
    };
    gload(R0, 0); gload(R1, 1);
    sstore(R0, 0, 0); __syncthreads();
    for (int kt = 0; kt < nk; kt += 2) {
        step(kt, R0, R1);
        if (kt + 1 < nk) step(kt + 1, R1, R0);
    }
#pragma unroll
    for (int mi = 0; mi < 2; ++mi)
#pragma unroll
        for (int ni = 0; ni < 2; ++ni)
#pragma unroll
            for (int reg = 0; reg < 16; ++reg)
                epi(m0 + 64 * wr + 32 * mi + crow(reg, lh), n0 + 64 * wc + 32 * ni + li, acc[mi][ni][reg]);
}

DI void transpose_f32(const float* __restrict__ src, int ld_src, int Cvalid, bf16_t* __restrict__ dst, int ld_dst, int r0, int c0, const float* rscale, float* tile) {
    const int tid = get_tid();
    float tv[16];
#pragma unroll
    for (int j = 0; j < 16; ++j) { const int i = tid + 256 * j, r = i >> 6, c = i & 63; tv[j] = (c0 + c < Cvalid) ? src[(size_t)(r0 + r) * ld_src + c0 + c] : 0.f; }
#pragma unroll
    for (int j = 0; j < 16; ++j) { const int i = tid + 256 * j, r = i >> 6, c = i & 63; float v = tv[j]; if (rscale) v *= rscale[r0 + r]; tile[r * 65 + c] = v; }
    __syncthreads();
#pragma unroll
    for (int j = 0; j < 16; ++j) { const int i = tid + 256 * j, c = i >> 6, r = i & 63; dst[(size_t)(c0 + c) * ld_dst + r0 + r] = f2bf(tile[r * 65 + c]); }
    __syncthreads();
}
DI void transpose_bf16(const bf16_t* __restrict__ src, int ld_src, bf16_t* __restrict__ dst, int ld_dst, int r0, int c0, float* tile) {
    const int tid = get_tid();
    bf16_t tv[16];
#pragma unroll
    for (int j = 0; j < 16; ++j) { const int i = tid + 256 * j, r = i >> 6, c = i & 63; tv[j] = src[(size_t)(r0 + r) * ld_src + c0 + c]; }
#pragma unroll
    for (int j = 0; j < 16; ++j) { const int i = tid + 256 * j, r = i >> 6, c = i & 63; tile[r * 65 + c] = bf2f(tv[j]); }
    __syncthreads();
#pragma unroll
    for (int j = 0; j < 16; ++j) { const int i = tid + 256 * j, c = i >> 6, r = i & 63; dst[(size_t)(c0 + c) * ld_dst + r0 + r] = f2bf(tile[r * 65 + c]); }
    __syncthreads();
}
constexpr int WT_IN = 16 * 36, WT_OUT = 16 * 16, WT_FF1 = 16 * 64, WT_FF2 = 64 * 16, WT_UQ = 4 * 9, WT_UKV = 2 * 12;
constexpr int WT_TOTAL = WT_IN + WT_OUT + WT_FF1 + WT_FF2 + WT_UQ + WT_UKV;
DI void wprep_item(const Params& p, int layer, int it, unsigned char* smem) {
    float* tile = (float*)smem; bf16_t* W = (bf16_t*)(p.ws + wbase(layer));
    if (it < WT_IN) { int kt = it / 36, nt = it % 36; transpose_f32(p.in[I_WIN] + (size_t)layer * 1024 * INC, INC, INC, (bf16_t*)((unsigned char*)W + W_IN), 1024, kt * 64, nt * 64, nullptr, tile); return; } it -= WT_IN;
    if (it < WT_OUT) { int kt = it / 16, nt = it % 16; transpose_f32(p.in[I_WOUT] + (size_t)layer * 1024 * 1024, 1024, 1024, (bf16_t*)((unsigned char*)W + W_OUT), 1024, kt * 64, nt * 64, nullptr, tile); return; } it -= WT_OUT;
    if (it < WT_FF1) { int kt = it / 64, nt = it % 64; transpose_f32(p.in[I_WFF1] + (size_t)layer * 1024 * 4096, 4096, 4096, (bf16_t*)((unsigned char*)W + W_FF1), 1024, kt * 64, nt * 64, nullptr, tile); return; } it -= WT_FF1;
    if (it < WT_FF2) { int kt = it / 16, nt = it % 16; transpose_f32(p.in[I_WFF2] + (size_t)layer * 4096 * 1024, 1024, 1024, (bf16_t*)((unsigned char*)W + W_FF2), 4096, kt * 64, nt * 64, nullptr, tile); return; } it -= WT_FF2;
    if (it < WT_UQ) { int kt = it / 9, nt = it % 9; transpose_f32(p.in[I_WUQ] + (size_t)layer * 256 * 576, 576, 576, (bf16_t*)((unsigned char*)W + W_UQ), 256, kt * 64, nt * 64, p.in[I_GCQ] + layer * 256, tile); return; } it -= WT_UQ;
    { int kt = it / 12, nt = it % 12; transpose_f32(p.in[I_WUKV] + (size_t)layer * 128 * 768, 768, 768, (bf16_t*)((unsigned char*)W + W_UKV), 128, kt * 64, nt * 64, p.in[I_GCKV] + layer * 128, tile); }
}
DI void mod_item(const Params& p, int it, unsigned char* smem) {
    const int layer = it / 192, c0 = (it % 192) * 32, tid = get_tid();
    float* sl = (float*)smem;
    float* red = sl + 5 * 1024;
#pragma unroll
    for (int j = 0; j < 20; ++j) { const int i = tid + 256 * j, b = i >> 10, k = i & 1023; float v = (b < 4) ? p.in[I_C][b * 1024 + k] : p.in[I_CCTX][k]; sl[i] = silu(v); }
    __syncthreads();
    const int col = tid & 31, kg = tid >> 5;
    const float* W = p.in[I_WMOD] + (size_t)layer * 1024 * 6144 + c0 + col;
    float a0 = 0, a1 = 0, a2 = 0, a3 = 0, a4 = 0;
#pragma unroll 8
    for (int k = kg * 128; k < kg * 128 + 128; ++k) { float w = W[(size_t)k * 6144]; a0 += sl[k] * w; a1 += sl[1024 + k] * w; a2 += sl[2048 + k] * w; a3 += sl[3072 + k] * w; a4 += sl[4096 + k] * w; }
    red[(kg * 5 + 0) * 32 + col] = a0; red[(kg * 5 + 1) * 32 + col] = a1; red[(kg * 5 + 2) * 32 + col] = a2; red[(kg * 5 + 3) * 32 + col] = a3; red[(kg * 5 + 4) * 32 + col] = a4;
    __syncthreads();
    if (tid < 160) { int b = tid >> 5, c = tid & 31; float s = p.in[I_BMOD][layer * 6144 + c0 + c];
#pragma unroll
        for (int g = 0; g < 8; ++g) s += red[(g * 5 + b) * 32 + c];
        ((float*)(p.ws + WS_MOD))[(size_t)(layer * 5 + b) * 6144 + c0 + c] = s; }
    __syncthreads();
}
template <int L>
DI void filt_item(const Params& p, int layer, int it, unsigned char* smem, bf16_t* Fout, float* Part) {
    const int lb = it >> 2, cb = it & 3, tid = get_tid();
    float* feats = (float*)smem;
    float* h1 = feats + 32 * 33;
    float* h2 = h1 + 32 * 64;
    float* w1s = h2 + 32 * 64;
    float* w2s = w1s + 33 * 64;
    {
        const float* w1g = p.in[I_WF1] + layer * 33 * 64; const float* w2g = p.in[I_WF2] + layer * 64 * 64;
        float t1[9], t2[16];
#pragma unroll
        for (int j = 0; j < 9; ++j) { const int i = tid + 256 * j; t1[j] = (i < 33 * 64) ? w1g[i] : 0.f; }
#pragma unroll
        for (int j = 0; j < 16; ++j) t2[j] = w2g[tid + 256 * j];
#pragma unroll
        for (int j = 0; j < 9; ++j) { const int i = tid + 256 * j; if (i < 33 * 64) w1s[i] = t1[j]; }
#pragma unroll
        for (int j = 0; j < 16; ++j) w2s[tid + 256 * j] = t2[j];
    }
    const float wstep = (float)(2.0 * 3.14159265358979323846 / (double)L);
#pragma unroll 1
    for (int i = tid; i < 32 * 33; i += 256) { int lg = i / 33, f = i % 33, lag = lb * 32 + lg; float v;
        if (f == 0) v = (float)lag / (float)(L - 1);
        else { int bi = (f - 1) & 15; float band = 1e-4f + (float)bi * ((15.f - 1e-4f) / 15.f); float ang = band * (wstep * (float)lag); v = (f <= 16) ? cosf(ang) : -sinf(ang); }
        feats[i] = v; }
    __syncthreads();
    const float* w1 = w1s; const float* w2 = w2s;
#pragma unroll 1
    for (int i = tid; i < 2048; i += 256) { int lg = i >> 6, j = i & 63; float s = p.in[I_BF1][layer * 64 + j];
#pragma unroll 3
        for (int f = 0; f < 33; ++f) s += feats[lg * 33 + f] * w1[f * 64 + j];
        h1[i] = sinf(p.in[I_FQ1][layer * 64 + j] * s); }
    __syncthreads();
#pragma unroll 1
    for (int i = tid; i < 2048; i += 256) { int lg = i >> 6, j = i & 63; float s = p.in[I_BF2][layer * 64 + j];
#pragma unroll 4
        for (int f = 0; f < 64; ++f) s += h1[lg * 64 + f] * w2[f * 64 + j];
        h2[i] = sinf(p.in[I_FQ2][layer * 64 + j] * s); }
    __syncthreads();
    const int col = cb * 256 + tid, dir = col >> 9, o = (col >> 8) & 1, ch = col & 255;
    const float* w3 = p.in[I_WF3] + (size_t)layer * 64 * 1024 + col;
    const float d0 = -4.605170185988091f / 1.5f, d1 = -4.605170185988091f / 0.3f;
    const float delta = fabsf(d0 + (float)ch * ((d1 - d0) / 255.f));
    bf16_t* F = Fout + (size_t)(o * 256 + ch) * (2 * L);
    float asum = 0.f;
    float wreg[64];
#pragma unroll
    for (int k = 0; k < 64; ++k) wreg[k] = w3[k * 1024];
#pragma unroll 1
    for (int lg = 0; lg < 32; ++lg) {
        float a0 = 0.f, a1 = 0.f;
#pragma unroll
        for (int k = 0; k < 64; k += 8) { const f32x4 hv = *(const f32x4*)(h2 + lg * 64 + k), hw = *(const f32x4*)(h2 + lg * 64 + k + 4);
            a0 += hv.x * wreg[k] + hv.y * wreg[k + 1] + hv.z * wreg[k + 2] + hv.w * wreg[k + 3];
            a1 += hw.x * wreg[k + 4] + hw.y * wreg[k + 5] + hw.z * wreg[k + 6] + hw.w * wreg[k + 7]; }
        const int lag = lb * 32 + lg; const float t01 = (float)lag / (float)(L - 1); const float v = (a0 + a1) * __expf(-t01 * delta);
        if (dir == 0) { F[L + lag] = f2bf(v); asum += fabsf(v); }
        else { if (lag == 0) F[0] = 0; else { F[L - lag] = f2bf(v); asum += fabsf(v); } }
    }
    Part[lb * 1024 + col] = asum;
    __syncthreads();
}

DI void norm_rows(const Params& p, int layer, int which  , int nrows, bool from_input) {
    const int lane = get_tid() & 63, gw = blockIdx.x * 4 + (get_tid() >> 6), NGW = gridDim.x * 4;
    const float* g = p.in[which ? I_GMLP : I_GMIX] + layer * 1024;
    const float* MOD = (const float*)(p.ws + WS_MOD) + (size_t)layer * 5 * 6144;
    bf16_t* H = (bf16_t*)(p.ws + WS_H);
    for (int r = gw; r < nrows; r += NGW) {
        const float* src; int mb;
        if (r < NL) { src = (from_input ? p.in[I_X] : p.out) + (size_t)r * 1024; mb = r >> 12; }
        else { src = (from_input ? p.in[I_CTX] : (const float*)(p.ws + WS_XC)) + (size_t)(r - NL) * 1024; mb = 4; }
        const float* sh = MOD + mb * 6144 + (which ? 3072 : 0); const float* sc = sh + 1024;
        f32x4 v[4]; float ss = 0.f;
#pragma unroll
        for (int j = 0; j < 4; ++j) { v[j] = *(const f32x4*)(src + 256 * j + 4 * lane); ss += v[j].x * v[j].x + v[j].y * v[j].y + v[j].z * v[j].z + v[j].w * v[j].w; }
        const float rstd = 1.f / sqrtf(wave_sum(ss) * (1.f / 1024.f) + EPS);
#pragma unroll
        for (int j = 0; j < 4; ++j) { const int c = 256 * j + 4 * lane; f32x4 gg = *(const f32x4*)(g + c), s1 = *(const f32x4*)(sc + c), s0 = *(const f32x4*)(sh + c);
            float o0 = v[j].x * rstd * gg.x * (1.f + s1.x) + s0.x, o1 = v[j].y * rstd * gg.y * (1.f + s1.y) + s0.y, o2 = v[j].z * rstd * gg.z * (1.f + s1.z) + s0.z, o3 = v[j].w * rstd * gg.w * (1.f + s1.w) + s0.w;
            u32x2 w; w.x = pack2(o0, o1); w.y = pack2(o2, o3); *(u32x2*)(H + (size_t)r * 1024 + c) = w; }
    }
}

DI void hyconv_item(const Params& p, int layer, int it, unsigned char* smem) {
    const int rt = it / 12, ct = it % 12, r0 = rt * 64, c0 = ct * 64, tid = get_tid();
    float* tile = (float*)smem;
    const bf16_t* PROJ = (const bf16_t*)(p.ws + WS_PROJ);
    int b, t, L; row_info(r0, b, t, L);
    u32x2 hv[5];
#pragma unroll
    for (int j = 0; j < 5; ++j) { const int i = tid + 256 * j, rr = i >> 4, c = (i & 15) * 4, tt = t + rr - 1; hv[j].x = 0u; hv[j].y = 0u;
        if (i < 66 * 16 && tt >= 0 && tt < L) hv[j] = *(const u32x2*)(PROJ + (size_t)(r0 + rr - 1) * INP + O_HY + c0 + c); }
#pragma unroll
    for (int j = 0; j < 5; ++j) { const int i = tid + 256 * j, rr = i >> 4, c = (i & 15) * 4; const u32x2 v = hv[j];
        if (i < 66 * 16) { float* tp = tile + rr * 65 + c; tp[0] = bf2f((bf16_t)(v.x & 0xffff)); tp[1] = bf2f((bf16_t)(v.x >> 16)); tp[2] = bf2f((bf16_t)(v.y & 0xffff)); tp[3] = bf2f((bf16_t)(v.y >> 16)); } }
    const float* w = p.in[I_WCH] + layer * 3 * 768; const float* bb = p.in[I_BCH] + layer * 768;
    bf16_t* P = (bf16_t*)(p.ws + WS_P);
    float* wl = tile + 66 * 65;
    { const int q = tid >> 6, c = tid & 63; wl[tid] = (q == 0) ? bb[c0 + c] : w[(q - 1) * 768 + c0 + c]; }
    __syncthreads();
#pragma unroll
    for (int j = 0; j < 8; ++j) { const int i = tid + 256 * j, c = i >> 5, rp = (i & 31) * 2, cc = c0 + c;
        const float t0 = tile[rp * 65 + c], t1 = tile[(rp + 1) * 65 + c], t2 = tile[(rp + 2) * 65 + c], t3 = tile[(rp + 3) * 65 + c];
        const float bq = wl[c], wa = wl[64 + c], wb = wl[128 + c], wc = wl[192 + c];
        const float v0 = bq + wa * t0 + wb * t1 + wc * t2, v1 = bq + wa * t1 + wb * t2 + wc * t3;
        *(unsigned*)(P + (size_t)cc * NT + r0 + rp) = pack2(v0, v1); }
    __syncthreads();
}
DI void ssmconv_item(const Params& p, int layer, int it) {
    const int r0 = it * 32, tid = get_tid();
    const bf16_t* PROJ = (const bf16_t*)(p.ws + WS_PROJ); bf16_t* UZ = (bf16_t*)(p.ws + WS_UZ); float* DT = (float*)(p.ws + WS_DT);
    const float* w = p.in[I_WCS] + layer * 3 * 640; const float* bb = p.in[I_BCS] + layer * 640;
    int b, t0, L; row_info(r0, b, t0, L);
#pragma unroll 1
    for (int j0 = 0; j0 < 10; j0 += 5) {
        bf16x8 xc[5], xp[5], xn[5];
#pragma unroll
        for (int j = 0; j < 5; ++j) { const int i = tid + 256 * (j0 + j), rl = i / 80, c = (i - rl * 80) * 8, t = t0 + rl; const size_t r = r0 + rl;
            const bf16_t* src = PROJ + r * INP + O_XBC + c;
            xc[j] = ld8(src); xp[j] = xc[j]; xn[j] = xc[j];
            if (t > 0) xp[j] = ld8(src - INP);
            if (t < L - 1) xn[j] = ld8(src + INP); }
#pragma unroll
        for (int j = 0; j < 5; ++j) { const int i = tid + 256 * (j0 + j), rl = i / 80, c = (i - rl * 80) * 8, t = t0 + rl; const size_t r = r0 + rl;
            const bool hp = t > 0, hn = t < L - 1;
            const f32x4 b0 = *(const f32x4*)(bb + c), b1 = *(const f32x4*)(bb + c + 4), wa0 = *(const f32x4*)(w + c), wa1 = *(const f32x4*)(w + c + 4),
                        wb0 = *(const f32x4*)(w + 640 + c), wb1 = *(const f32x4*)(w + 640 + c + 4), wc0 = *(const f32x4*)(w + 1280 + c), wc1 = *(const f32x4*)(w + 1280 + c + 4);
            const float bv[8] = { b0.x, b0.y, b0.z, b0.w, b1.x, b1.y, b1.z, b1.w }, w0v[8] = { wa0.x, wa0.y, wa0.z, wa0.w, wa1.x, wa1.y, wa1.z, wa1.w },
                        w1v[8] = { wb0.x, wb0.y, wb0.z, wb0.w, wb1.x, wb1.y, wb1.z, wb1.w }, w2v[8] = { wc0.x, wc0.y, wc0.z, wc0.w, wc1.x, wc1.y, wc1.z, wc1.w };
            float o[8];
#pragma unroll
            for (int e = 0; e < 8; ++e) { float v = bv[e] + w1v[e] * bf2f((bf16_t)xc[j][e]);
                if (hp) v += w0v[e] * bf2f((bf16_t)xp[j][e]);
                if (hn) v += w2v[e] * bf2f((bf16_t)xn[j][e]);
                o[e] = silu(v); }
            *(bf16x8*)(UZ + r * 1024 + c) = pack8(o[0], o[1], o[2], o[3], o[4], o[5], o[6], o[7]); }
    }
    { u32x4 zc[6];
#pragma unroll
      for (int j = 0; j < 6; ++j) { const int i = tid + 256 * j, rl = i / 48, c = (i - rl * 48) * 8; zc[j] = *(const u32x4*)(PROJ + (size_t)(r0 + rl) * INP + O_Z + c); }
#pragma unroll
      for (int j = 0; j < 6; ++j) { const int i = tid + 256 * j, rl = i / 48, c = (i - rl * 48) * 8; *(u32x4*)(UZ + (size_t)(r0 + rl) * 1024 + 640 + c) = zc[j]; } }
    for (int i = tid; i < 32 * 12; i += 256) { const int rl = i / 12, c = i - rl * 12; const size_t r = r0 + rl;
        DT[r * 12 + c] = softplus(bf2f(PROJ[r * INP + O_DT + c]) + p.in[I_DTB][layer * 12 + c]); }
}
DI void qkv_item(const Params& p, int layer, int it, unsigned char* smem) {
    const int tid = get_tid(), lane = tid & 63, wave = tid >> 6, li = lane & 31, lh = lane >> 5;
    const int ug = it & 3, hd0 = 3 * (ug & 1);
    const int rbase = (it >> 2) * 128 + 32 * wave;
    const bf16_t* PROJ = (const bf16_t*)(p.ws + WS_PROJ);
    bf16_t* Ws = (bf16_t*)smem;
    int b, t0, L; row_info(rbase, b, t0, L);
    const bool lat = rbase < NL;
    float cs[16], sn[16];
    {
        const int axis = li >> 4, f = li & 7; const float inv = exp2f(-(float)f * (13.287712379549449f / 8.f));
#pragma unroll
        for (int reg = 0; reg < 16; ++reg) { int t = t0 + crow(reg, lh); float pos = (float)(axis ? (t & 63) : (t >> 6)); const float ang = pos * inv; cs[reg] = __cosf(ang); sn[reg] = __sinf(ang); }
    }
    const bool second = (li >> 3) & 1;
    if (ug < 2) {
        const bf16_t* Wq = (const bf16_t*)(p.ws + wbase(layer) + W_UQ);
        const float* gq = p.in[I_GQH] + layer * 96;
        const bf16_t* arow = PROJ + (size_t)(rbase + li) * INP + O_CQ + 8 * lh;
        float ss = 0.f;
#pragma unroll 1
        for (int kh = 0; kh < 2; ++kh) { bf16x8 a[8];
#pragma unroll
            for (int ks = 0; ks < 8; ++ks) a[ks] = ld8(arow + 128 * kh + 16 * ks);
#pragma unroll
            for (int ks = 0; ks < 8; ++ks) {
#pragma unroll
                for (int j = 0; j < 8; ++j) { float x = bf2f((bf16_t)a[ks][j]); ss += x * x; } } }
        ss += __shfl_xor(ss, 32);
        const float alpha = 1.f / sqrtf(ss * (1.f / 256.f) + EPS);
        float al[16];
#pragma unroll
        for (int reg = 0; reg < 16; ++reg) al[reg] = __shfl(alpha, crow(reg, lh));
        const float g0 = gq[li], g1 = gq[32 + li], g2 = gq[64 + li];
#pragma unroll 1
        for (int hd = hd0; hd < hd0 + 3; ++hd) {
            __syncthreads();
#pragma unroll 1
            for (int jb = 0; jb < 12; jb += 6) { u32x4 sw[6];
#pragma unroll
              for (int j = 0; j < 6; ++j) { const int i = tid + 256 * (jb + j), n = i >> 5, kc = i & 31; sw[j] = *(const u32x4*)(Wq + (size_t)(hd * 96 + n) * 256 + kc * 8); }
#pragma unroll
              for (int j = 0; j < 6; ++j) { const int i = tid + 256 * (jb + j), n = i >> 5, kc = i & 31; *(u32x4*)(Ws + n * 264 + kc * 8) = sw[j]; } }
            __syncthreads();
            f32x16 c0 = zero16(), c1 = zero16(), c2 = zero16();
            const bf16_t* wb = Ws + li * 264 + 8 * lh;
#pragma unroll 1
            for (int kh = 0; kh < 4; ++kh) { bf16x8 a[4];
#pragma unroll
                for (int ks = 0; ks < 4; ++ks) a[ks] = ld8(arow + 64 * kh + 16 * ks);
                __builtin_amdgcn_sched_barrier(0);
#pragma unroll
                for (int ks = 0; ks < 4; ++ks) { const bf16_t* w_ = wb + 64 * kh + 16 * ks;
                    c0 = MFMA(a[ks], ld8(w_), c0); c1 = MFMA(a[ks], ld8(w_ + 32 * 264), c1); c2 = MFMA(a[ks], ld8(w_ + 64 * 264), c2);
                    if ((ks & 1) == 1) __builtin_amdgcn_sched_barrier(0);
                } }
            bf16_t* Qp = lat ? (bf16_t*)(p.ws + WS_Q) + ((size_t)(b * 6 + hd) * SEQ + t0) * 96 : (bf16_t*)(p.ws + WS_QC) + ((size_t)(b * 6 + hd) * CTX + t0) * 96;
#pragma unroll
            for (int reg = 0; reg < 16; ++reg) {
                float s2 = xor_red32(c0[reg] * c0[reg] + c1[reg] * c1[reg] + c2[reg] * c2[reg]);
                const float ar = al[reg], rs = 1.f / sqrtf(ar * ar * s2 * (1.f / 96.f) + EPS), sc = ar * rs;
                float v0 = c0[reg] * sc * g0, v1 = c1[reg] * sc * g1, v2 = c2[reg] * sc * g2;
                float pr = __shfl_xor(v2, 8);
                if (lat) v2 = second ? (v2 * cs[reg] + pr * sn[reg]) : (v2 * cs[reg] - pr * sn[reg]);
                bf16_t* q = Qp + (size_t)crow(reg, lh) * 96;
                q[li] = f2bf(v0); q[32 + li] = f2bf(v1); q[64 + li] = f2bf(v2);
                if ((reg & 3) == 3) __builtin_amdgcn_sched_barrier(0);
            }
        }
        __syncthreads();
    }
    else {
        const bf16_t* Wkv = (const bf16_t*)(p.ws + wbase(layer) + W_UKV);
        const float* gk = p.in[I_GKH] + layer * 96;
        const bf16_t* arow = PROJ + (size_t)(rbase + li) * INP + O_CKV + 8 * lh;
        float ss = 0.f;
        { bf16x8 a[8];
#pragma unroll
          for (int ks = 0; ks < 8; ++ks) a[ks] = ld8(arow + 16 * ks);
#pragma unroll
          for (int ks = 0; ks < 8; ++ks) {
#pragma unroll
            for (int j = 0; j < 8; ++j) { float x = bf2f((bf16_t)a[ks][j]); ss += x * x; } } }
        ss += __shfl_xor(ss, 32);
        const float alpha = 1.f / sqrtf(ss * (1.f / 128.f) + EPS);
        float al[16], krv[16];
#pragma unroll
        for (int reg = 0; reg < 16; ++reg) { al[reg] = __shfl(alpha, crow(reg, lh)); krv[reg] = bf2f(PROJ[(size_t)(rbase + crow(reg, lh)) * INP + O_KR + li]); }
        const float g0 = gk[li], g1 = gk[32 + li], g2 = gk[64 + li];
        const int kbase = lat ? (CTX + t0) : t0;
#pragma unroll 1
        for (int hd = hd0; hd < hd0 + 3; ++hd) {
            __syncthreads();
#pragma unroll 1
            for (int jb = 0; jb < 8; jb += 4) { u32x4 sw[4];
#pragma unroll
              for (int j = 0; j < 4; ++j) { const int i = tid + 256 * (jb + j), n = i >> 4, kc = i & 15; sw[j] = *(const u32x4*)(Wkv + (size_t)(hd * 128 + n) * 128 + kc * 8); }
#pragma unroll
              for (int j = 0; j < 4; ++j) { const int i = tid + 256 * (jb + j), n = i >> 4, kc = i & 15; *(u32x4*)(Ws + n * 136 + kc * 8) = sw[j]; } }
            __syncthreads();
            f32x16 c0 = zero16(), c1 = zero16(), c2 = zero16(), c3 = zero16();
            const bf16_t* wb = Ws + li * 136 + 8 * lh;
#pragma unroll 1
            for (int kh = 0; kh < 2; ++kh) { bf16x8 a[4];
#pragma unroll
                for (int ks = 0; ks < 4; ++ks) a[ks] = ld8(arow + 64 * kh + 16 * ks);
                __builtin_amdgcn_sched_barrier(0);
#pragma unroll
                for (int ks = 0; ks < 4; ++ks) { const bf16_t* w_ = wb + 64 * kh + 16 * ks;
                    c0 = MFMA(a[ks], ld8(w_), c0); c1 = MFMA(a[ks], ld8(w_ + 32 * 136), c1);
                    c2 = MFMA(a[ks], ld8(w_ + 64 * 136), c2); c3 = MFMA(a[ks], ld8(w_ + 96 * 136), c3);
                    __builtin_amdgcn_sched_barrier(0);
                } }
            bf16_t* Kp = (bf16_t*)(p.ws + WS_K) + ((size_t)(b * 6 + hd) * NKEY + kbase) * 96;
            bf16_t* Vp = (bf16_t*)(p.ws + WS_VT) + ((size_t)(b * 6 + hd) * 64) * NKEY + kbase;
#pragma unroll
            for (int reg = 0; reg < 16; ++reg) {
                const float ar = al[reg];
                float s2 = xor_red32(ar * ar * (c0[reg] * c0[reg] + c1[reg] * c1[reg]) + krv[reg] * krv[reg]);
                const float rs = 1.f / sqrtf(s2 * (1.f / 96.f) + EPS);
                float v0 = c0[reg] * ar * rs * g0, v1 = c1[reg] * ar * rs * g1, v2 = krv[reg] * rs * g2;
                float pr = __shfl_xor(v2, 8);
                if (lat) v2 = second ? (v2 * cs[reg] + pr * sn[reg]) : (v2 * cs[reg] - pr * sn[reg]);
                bf16_t* k = Kp + (size_t)crow(reg, lh) * 96;
                k[li] = f2bf(v0); k[32 + li] = f2bf(v1); k[64 + li] = f2bf(v2);
                if ((reg & 3) == 3) __builtin_amdgcn_sched_barrier(0);
            }
#pragma unroll
            for (int rg = 0; rg < 4; ++rg) {
                const int k0 = 8 * rg + 4 * lh;
                u32x2 w0, w1;
                w0.x = pack2(c2[4 * rg] * al[4 * rg], c2[4 * rg + 1] * al[4 * rg + 1]); w0.y = pack2(c2[4 * rg + 2] * al[4 * rg + 2], c2[4 * rg + 3] * al[4 * rg + 3]);
                w1.x = pack2(c3[4 * rg] * al[4 * rg], c3[4 * rg + 1] * al[4 * rg + 1]); w1.y = pack2(c3[4 * rg + 2] * al[4 * rg + 2], c3[4 * rg + 3] * al[4 * rg + 3]);
                *(u32x2*)(Vp + (size_t)li * NKEY + k0) = w0;
                *(u32x2*)(Vp + (size_t)(32 + li) * NKEY + k0) = w1;
            }
        }
        __syncthreads();
    }
}

DI void attn_item(const Params& p, const bf16_t* Qbase  , int bh, int q0, int nkeys, int out_row0, unsigned char* smem) {
    constexpr int KS = 104, VS = 68;
    bf16_t* Ks = (bf16_t*)smem;
    bf16_t* Vs = Ks + 2 * 64 * KS;
    const int tid = get_tid(), lane = tid & 63, wave = tid >> 6, li = lane & 31, lh = lane >> 5;
    const bf16_t* Kg = (const bf16_t*)(p.ws + WS_K) + (size_t)bh * NKEY * 96;
    const bf16_t* Vg = (const bf16_t*)(p.ws + WS_VT) + (size_t)bh * 64 * NKEY;
    bf16x8 qf[6];
#pragma unroll
    for (int ks = 0; ks < 6; ++ks) qf[ks] = ld8(Qbase + (size_t)(q0 + 32 * wave + li) * 96 + 16 * ks + 8 * lh);
    u32x4 rk[3], rv[2];
    auto gload = [&](int kt) {
#pragma unroll
        for (int i = 0; i < 3; ++i) { int id = tid + 256 * i; rk[i] = *(const u32x4*)(Kg + (size_t)kt * 64 * 96 + id * 8); }
#pragma unroll
        for (int i = 0; i < 2; ++i) { int id = tid + 256 * i, v = id >> 3, kc = id & 7; rv[i] = *(const u32x4*)(Vg + (size_t)v * NKEY + kt * 64 + kc * 8); }
    };
    auto sstore = [&](int buf) {
#pragma unroll
        for (int i = 0; i < 3; ++i) { int id = tid + 256 * i, key = id / 12, dc = id - key * 12; *(u32x4*)(Ks + (buf * 64 + key) * KS + dc * 8) = rk[i]; }
#pragma unroll
        for (int i = 0; i < 2; ++i) { int id = tid + 256 * i, v = id >> 3, kc = id & 7; bf16_t* d = Vs + (buf * 64 + v) * VS + kc * 8;
            u32x2 lo, hi; lo.x = rv[i].x; lo.y = rv[i].y; hi.x = rv[i].z; hi.y = rv[i].w; *(u32x2*)d = lo; *(u32x2*)(d + 4) = hi; }
    };
    const int nkt = nkeys >> 6;
    const float scl = 0.10206207261596577f * 1.4426950408889634f;
    f32x16 o0 = zero16(), o1 = zero16(); float m = -1e30f, l = 0.f;
    __syncthreads();
    gload(0); sstore(0); __syncthreads();
    for (int kt = 0; kt < nkt; ++kt) {
        const int buf = kt & 1;
        if (kt + 1 < nkt) gload(kt + 1);
        __builtin_amdgcn_sched_barrier(0);
        f32x16 s0 = zero16(), s1 = zero16();
        const bf16_t* kb = Ks + (buf * 64 + li) * KS + 8 * lh;
#pragma unroll
        for (int ks = 0; ks < 6; ++ks) { s0 = MFMA(ld8(kb + 16 * ks), qf[ks], s0); s1 = MFMA(ld8(kb + 32 * KS + 16 * ks), qf[ks], s1); }
        float mx = fmaxf(s0[0], s1[0]);
#pragma unroll
        for (int r = 1; r < 16; ++r) mx = fmaxf(fmaxf(mx, s0[r]), s1[r]);
        mx = fmaxf(mx, __shfl_xor(mx, 32));
        const float mn = fmaxf(m, mx);
        if (__any(mn > m)) {
            const float corr = __builtin_amdgcn_exp2f((m - mn) * scl);
            l *= corr;
#pragma unroll
            for (int r = 0; r < 16; ++r) { o0[r] *= corr; o1[r] *= corr; }
            m = mn;
        }
        const float nb = -m * scl;
        float sum0 = 0.f, sum1 = 0.f;
#pragma unroll
        for (int r = 0; r < 16; ++r) { s0[r] = __builtin_amdgcn_exp2f(fmaf(s0[r], scl, nb)); s1[r] = __builtin_amdgcn_exp2f(fmaf(s1[r], scl, nb)); sum0 += s0[r]; sum1 += s1[r]; }
        float sum = sum0 + sum1;
        sum += __shfl_xor(sum, 32);
        l += sum;
        bf16x8 pf[2][2];
        pf[0][0] = pack8(s0[0], s0[1], s0[2], s0[3], s0[4], s0[5], s0[6], s0[7]); pf[0][1] = pack8(s0[8], s0[9], s0[10], s0[11], s0[12], s0[13], s0[14], s0[15]);
        pf[1][0] = pack8(s1[0], s1[1], s1[2], s1[3], s1[4], s1[5], s1[6], s1[7]); pf[1][1] = pack8(s1[8], s1[9], s1[10], s1[11], s1[12], s1[13], s1[14], s1[15]);
        const bf16_t* vb = Vs + (buf * 64 + li) * VS + 4 * lh;
#pragma unroll
        for (int j = 0; j < 2; ++j)
#pragma unroll
            for (int s = 0; s < 2; ++s) {
                const int ko = 32 * j + 16 * s;
                o0 = MFMA(ld4x2(vb + ko, vb + ko + 8), pf[j][s], o0);
                o1 = MFMA(ld4x2(vb + 32 * VS + ko, vb + 32 * VS + ko + 8), pf[j][s], o1);
            }
        __builtin_amdgcn_sched_barrier(0);
        if (kt + 1 < nkt) sstore(buf ^ 1);
        __syncthreads();
    }
    const float inv = 1.f / l;
    bf16_t* MIX = (bf16_t*)(p.ws + WS_MIX);
    const int hd = bh % 6;
    bf16_t* orow = MIX + (size_t)(out_row0 + q0 + 32 * wave + li) * 1024 + hd * 64;
#pragma unroll
    for (int rg = 0; rg < 4; ++rg) {
        u32x2 w0, w1;
        w0.x = pack2(o0[4 * rg] * inv, o0[4 * rg + 1] * inv); w0.y = pack2(o0[4 * rg + 2] * inv, o0[4 * rg + 3] * inv);
        w1.x = pack2(o1[4 * rg] * inv, o1[4 * rg + 1] * inv); w1.y = pack2(o1[4 * rg + 2] * inv, o1[4 * rg + 3] * inv);
        *(u32x2*)(orow + 8 * rg + 4 * lh) = w0;
        *(u32x2*)(orow + 32 + 8 * rg + 4 * lh) = w1;
    }
}

DI void wave_scan128(const float* v, float* out, bool reverse, int lane) {
    const float v0 = v[2 * lane], v1 = v[2 * lane + 1];
    float s = v0 + v1;
#pragma unroll
    for (int o = 1; o < 64; o <<= 1) { float t = __shfl_up(s, o); if (lane >= o) s += t; }
    const float total = __shfl(s, 63);
    if (!reverse) { out[2 * lane] = s - v1; out[2 * lane + 1] = s; }
    else { out[2 * lane] = total - (s - v0 - v1); out[2 * lane + 1] = total - (s - v1); }
}
DI int chunk_row0(int b, int cidx) { return cidx < 2 ? NL + b * CTX + cidx * 128 : b * SEQ + (cidx - 2) * 128; }

DI void ssdA_item(const Params& p, int layer, int it, unsigned char* smem) {
    const int cidx = it % NCHK, hd = (it / NCHK) % 6, b = it / (NCHK * 6), g = hd / 3;
    const int tid = get_tid(), lane = tid & 63, wave = tid >> 6, li = lane & 31, lh = lane >> 5;
    constexpr int TS = 136;
    bf16_t* BT = (bf16_t*)smem;
    bf16_t* XT = BT + 64 * TS;
    float* dtv = (float*)(XT + 64 * TS);
    float* av = dtv + 256;
    float* cum = av + 256;
    const int r0 = chunk_row0(b, cidx);
    const bf16_t* UZ = (const bf16_t*)(p.ws + WS_UZ); const float* DT = (const float*)(p.ws + WS_DT);
    __syncthreads();
    { const int t = tid & 127, d = tid >> 7; const float dt = DT[(size_t)(r0 + t) * 12 + d * 6 + hd]; const float a = -__expf(p.in[I_ALOG][layer * 12 + d * 6 + hd]); dtv[d * 128 + t] = dt; av[d * 128 + t] = dt * a; }
    { bf16x8 sv[4];
#pragma unroll
      for (int q = 0; q < 4; ++q) { const int i = tid + 256 * q, t = i >> 3, c8 = i & 7; sv[q] = ld8(UZ + (size_t)(r0 + t) * 1024 + 384 + g * 64 + c8 * 8); }
#pragma unroll
      for (int q = 0; q < 4; ++q) { const int i = tid + 256 * q, t = i >> 3, c8 = i & 7;
#pragma unroll
        for (int j = 0; j < 8; ++j) BT[(c8 * 8 + j) * TS + t] = (bf16_t)sv[q][j]; } }
    __syncthreads();
    if (wave < 2) wave_scan128(av + wave * 128, cum + wave * 128, wave == 1, lane);
    __syncthreads();
    float* ST = (float*)(p.ws + stbase(layer)); float* DEC = (float*)(p.ws + stbase(layer) + ST_BYTES);
    for (int d = 0; d < 2; ++d) {
        const float total = d == 0 ? cum[127] : cum[128];
        { bf16x8 sv[4];
#pragma unroll
          for (int q = 0; q < 4; ++q) { const int i = tid + 256 * q, t = i >> 3, c8 = i & 7; sv[q] = ld8(UZ + (size_t)(r0 + t) * 1024 + hd * 64 + c8 * 8); }
#pragma unroll
          for (int q = 0; q < 4; ++q) { const int i = tid + 256 * q, t = i >> 3, c8 = i & 7;
            const float w = __expf(total - cum[d * 128 + t]) * dtv[d * 128 + t];
#pragma unroll
            for (int j = 0; j < 8; ++j) XT[(c8 * 8 + j) * TS + t] = f2bf(bf2f((bf16_t)sv[q][j]) * w); } }
        __syncthreads();
        const int pt = wave >> 1, nt = wave & 1;
        f32x16 acc = zero16();
#pragma unroll
        for (int ks = 0; ks < 8; ++ks) acc = MFMA(ld8(XT + (32 * pt + li) * TS + 16 * ks + 8 * lh), ld8(BT + (32 * nt + li) * TS + 16 * ks + 8 * lh), acc);
        float* st = ST + ((((size_t)d * 4 + b) * 6 + hd) * NCHK + cidx) * 4096;
#pragma unroll
        for (int reg = 0; reg < 16; ++reg) st[(32 * pt + crow(reg, lh)) * 64 + 32 * nt + li] = acc[reg];
        if (tid == 0) DEC[(((size_t)d * 4 + b) * 6 + hd) * NCHK + cidx] = __expf(total);
        __syncthreads();
    }
}
DI void hy_rawload(const unsigned* fd, unsigned (&raw)[10]) {
#pragma unroll
    for (int j = 0; j < 5; ++j) { raw[j] = fd[j]; raw[5 + j] = fd[j - 8]; }
}
DI void hy_conv(const bf16_t* ub, const bf16_t* filt, f32x16 (&acc)[2], int nbase, int li, int lh) {
    const int klo = 32 * nbase - 127, khi = 32 * (nbase + 1) + 31;
    const int m0 = 4096 + li - 8 * lh - 7;
    const unsigned sh = (unsigned)(m0 & 1) * 16u;
    const unsigned* fd0 = (const unsigned*)filt + (m0 >> 1);
    unsigned raw[10];
    hy_rawload(fd0 + 16 * klo, raw);
#pragma unroll 4
    for (int k = klo; k <= khi; ++k) {
        u32x4 ua, ub4;
        ua.x = __builtin_amdgcn_alignbit(raw[1], raw[0], sh); ua.y = __builtin_amdgcn_alignbit(raw[2], raw[1], sh); ua.z = __builtin_amdgcn_alignbit(raw[3], raw[2], sh); ua.w = __builtin_amdgcn_alignbit(raw[4], raw[3], sh);
        ub4.x = __builtin_amdgcn_alignbit(raw[6], raw[5], sh); ub4.y = __builtin_amdgcn_alignbit(raw[7], raw[6], sh); ub4.z = __builtin_amdgcn_alignbit(raw[8], raw[7], sh); ub4.w = __builtin_amdgcn_alignbit(raw[9], raw[8], sh);
        const bf16x8 a0 = __builtin_bit_cast(bf16x8, ua), a1 = __builtin_bit_cast(bf16x8, ub4);
        if (k < khi) hy_rawload(fd0 + 16 * (k + 1), raw);
        bf16x8 b0[2], b1[2]; bool use[2];
#pragma unroll
        for (int n = 0; n < 2; ++n) {
            const int nn = nbase + n; use[n] = (k >= 32 * nn - 127) && (k <= 32 * nn + 31);
            const int c = 32 * nn + li - k;
            const bf16_t* up = ub + c * 40 + 8 * lh;
            b0[n] = ld8(up); b1[n] = ld8(up + 16);
        }
#pragma unroll
        for (int n = 0; n < 2; ++n) if (use[n]) { acc[n] = MFMA(a0, b0[n], acc[n]); acc[n] = MFMA(a1, b1[n], acc[n]); }
    }
}
DI u32x4 rev8(u32x4 v) { u32x4 r; r.x = (v.w >> 16) | (v.w << 16); r.y = (v.z >> 16) | (v.z << 16); r.z = (v.y >> 16) | (v.y << 16); r.w = (v.x >> 16) | (v.x << 16); return r; }
DI void hyena_lat_item(const Params& p, int layer, int it, unsigned char* smem) {
    const int ch = it >> 1, bp = it & 1;
    const int tid = get_tid(), lane = tid & 63, wave = tid >> 6, li = lane & 31, lh = lane >> 5;
    const int bl = wave >> 1, nbase = 2 * (wave & 1), bg = 2 * bp + bl;
    constexpr int UB = 192 * 40;
    bf16_t* U = (bf16_t*)smem + 32 * 40;
    bf16_t* Fl = (bf16_t*)smem + 2 * UB;
    float* red = (float*)(Fl + 8192 + 16);
    const bf16_t* P = (const bf16_t*)(p.ws + WS_P); const bf16_t* FL = (const bf16_t*)(p.ws + WS_FL); const float* FP = (const float*)(p.ws + WS_FPL);
    __syncthreads();
    { const int lb = tid & 127, dir = tid >> 7;
      float v0 = wave_sum(FP[lb * 1024 + dir * 512 + ch]), v1 = wave_sum(FP[lb * 1024 + dir * 512 + 256 + ch]);
      if (lane == 0) { red[wave] = v0; red[4 + wave] = v1; } }
    { u32x4 su[4], sf[4];
#pragma unroll
      for (int j = 0; j < 4; ++j) su[j] = *(const u32x4*)(P + (size_t)ch * NT + (size_t)bp * 2 * SEQ + (tid + 256 * j) * 8);
#pragma unroll
      for (int j = 0; j < 4; ++j) sf[j] = *(const u32x4*)(FL + (size_t)(0 * 256 + ch) * 8192 + (tid + 256 * j) * 8);
#pragma unroll
      for (int j = 0; j < 4; ++j) { const int i = tid + 256 * j, b = i >> 9, r = i & 511, blk = r >> 2, q = r & 3; *(u32x4*)(U + b * UB + blk * 40 + q * 8) = rev8(su[j]); }
      { unsigned zz = 0u; asm volatile("" : "+v"(zz)); u32x4 z4; z4.x = zz; z4.y = zz; z4.z = zz; z4.w = zz;
#pragma unroll
        for (int j = 0; j < 3; ++j) { const int i = tid + 256 * j; if (i < 2 * 2 * 32 * 5) { const int b = i / 320, r = i - b * 320, side = r / 160, e = r - side * 160; *(u32x4*)(U + b * UB + (side ? 128 * 40 : -32 * 40) + e * 8) = z4; } } }
#pragma unroll
      for (int j = 0; j < 4; ++j) *(u32x4*)(Fl + (tid + 256 * j) * 8) = sf[j];
      if (tid < 8) ((unsigned*)(Fl + 8192))[tid] = 0u; }
    __syncthreads();
    const float inv0 = 1.f / (red[0] + red[1] + red[2] + red[3] + EPS), inv1 = 1.f / (red[4] + red[5] + red[6] + red[7] + EPS);
    const float d0 = p.in[I_DSH][layer * 512 + ch], d1 = p.in[I_DSH][layer * 512 + 256 + ch];
    bf16_t* ub = U + bl * UB;
    f32x16 acc[2];
    acc[0] = zero16(); acc[1] = zero16();
    hy_conv(ub, Fl, acc, nbase, li, lh);
    __syncthreads();
    { u32x4 sf[4];
#pragma unroll
      for (int j = 0; j < 4; ++j) sf[j] = *(const u32x4*)(FL + (size_t)(1 * 256 + ch) * 8192 + (tid + 256 * j) * 8);
#pragma unroll
      for (int n = 0; n < 2; ++n)
#pragma unroll
        for (int rg = 0; rg < 4; ++rg) {
            const int a = 32 * (nbase + n) + li, ii = 8 * rg + 4 * lh; bf16_t* up = ub + a * 40 + 8 * rg + 4 * (1 - lh);
            const u32x2 zz = *(const u32x2*)up; const u32x2 pp = *(const u32x2*)(P + (size_t)(256 + ch) * NT + bg * SEQ + 32 * a + ii);
            float z[4] = { bf2f((bf16_t)(zz.y >> 16)), bf2f((bf16_t)(zz.y & 0xffff)), bf2f((bf16_t)(zz.x >> 16)), bf2f((bf16_t)(zz.x & 0xffff)) };
            float q[4] = { bf2f((bf16_t)(pp.x & 0xffff)), bf2f((bf16_t)(pp.x >> 16)), bf2f((bf16_t)(pp.y & 0xffff)), bf2f((bf16_t)(pp.y >> 16)) };
            float o[4];
#pragma unroll
            for (int e = 0; e < 4; ++e) o[e] = q[e] * (acc[n][4 * rg + e] * inv0 + z[e] * d0);
            u32x2 w; w.x = pack2(o[3], o[2]); w.y = pack2(o[1], o[0]); *(u32x2*)up = w;
        }
#pragma unroll
      for (int j = 0; j < 4; ++j) *(u32x4*)(Fl + (tid + 256 * j) * 8) = sf[j]; }
    __syncthreads();
    acc[0] = zero16(); acc[1] = zero16();
    hy_conv(ub, Fl, acc, nbase, li, lh);
    bf16_t* HY = (bf16_t*)(p.ws + WS_HYOT);
#pragma unroll
    for (int n = 0; n < 2; ++n)
#pragma unroll
        for (int rg = 0; rg < 4; ++rg) {
            const int a = 32 * (nbase + n) + li, ii = 8 * rg + 4 * lh; const bf16_t* up = ub + a * 40 + 8 * rg + 4 * (1 - lh);
            const u32x2 zz = *(const u32x2*)up; const u32x2 pp = *(const u32x2*)(P + (size_t)(512 + ch) * NT + bg * SEQ + 32 * a + ii);
            float z[4] = { bf2f((bf16_t)(zz.y >> 16)), bf2f((bf16_t)(zz.y & 0xffff)), bf2f((bf16_t)(zz.x >> 16)), bf2f((bf16_t)(zz.x & 0xffff)) };
            float q[4] = { bf2f((bf16_t)(pp.x & 0xffff)), bf2f((bf16_t)(pp.x >> 16)), bf2f((bf16_t)(pp.y & 0xffff)), bf2f((bf16_t)(pp.y >> 16)) };
            float o[4];
#pragma unroll
            for (int e = 0; e < 4; ++e) o[e] = q[e] * (acc[n][4 * rg + e] * inv1 + z[e] * d1);
            u32x2 w; w.x = pack2(o[0], o[1]); w.y = pack2(o[2], o[3]); *(u32x2*)(HY + (size_t)ch * NT + bg * SEQ + 32 * a + ii) = w;
        }
}
DI void hyena_ctx_item(const Params& p, int layer, int ch, unsigned char* smem) {
    const int tid = get_tid();
    float* u = (float*)smem;
    float* f = u + 1024;
    const bf16_t* P = (const bf16_t*)(p.ws + WS_P); const bf16_t* FC = (const bf16_t*)(p.ws + WS_FC); const float* FP = (const float*)(p.ws + WS_FPC);
    bf16_t* HY = (bf16_t*)(p.ws + WS_HYOT);
    __syncthreads();
    float nrm[2] = { 0.f, 0.f };
#pragma unroll
    for (int o = 0; o < 2; ++o) for (int lb = 0; lb < 8; ++lb) nrm[o] += FP[lb * 1024 + o * 256 + ch] + FP[lb * 1024 + 512 + o * 256 + ch];
    for (int i = tid; i < 1024; i += 256) u[i] = bf2f(P[(size_t)ch * NT + NL + i]);
    float zprev[4];
    for (int o = 0; o < 2; ++o) {
        for (int i = tid; i < 512; i += 256) f[i] = bf2f(FC[(size_t)(o * 256 + ch) * 512 + i]);
        __syncthreads();
        float y[4] = { 0.f, 0.f, 0.f, 0.f };
        for (int s = 0; s < 256; ++s) { const float fv = f[256 + tid - s]; y[0] += fv * u[s]; y[1] += fv * u[256 + s]; y[2] += fv * u[512 + s]; y[3] += fv * u[768 + s]; }
        const float inv = 1.f / (nrm[o] + EPS), dsk = p.in[I_DSH][layer * 512 + o * 256 + ch];
#pragma unroll
        for (int b = 0; b < 4; ++b) { const float pv = bf2f(P[(size_t)((o + 1) * 256 + ch) * NT + NL + b * 256 + tid]); zprev[b] = pv * (y[b] * inv + u[b * 256 + tid] * dsk); }
        __syncthreads();
        if (o == 0) {
#pragma unroll
            for (int b = 0; b < 4; ++b) u[b * 256 + tid] = zprev[b]; }
        else {
#pragma unroll
            for (int b = 0; b < 4; ++b) HY[(size_t)ch * NT + NL + b * 256 + tid] = f2bf(zprev[b]); }
        __syncthreads();
    }
}

DI void ssd_scan(const Params& p, int layer) {
    float* ST = (float*)(p.ws + stbase(layer)); const float* DEC = (const float*)(p.ws + stbase(layer) + ST_BYTES);
    const int total = 2 * 4 * 6 * 4096;
    for (int i = blockIdx.x * 256 + get_tid(); i < total; i += gridDim.x * 256) {
        const int e = i & 4095, dbh = i >> 12, d = dbh / 24;
        float* st = ST + (size_t)dbh * NCHK * 4096 + e; const float* dec = DEC + dbh * NCHK;
        float x[NCHK], dc[NCHK];
#pragma unroll
        for (int c = 0; c < NCHK; ++c) { x[c] = st[(size_t)c * 4096]; dc[c] = dec[c]; }
        float s = 0.f;
        if (d == 0) {
#pragma unroll
            for (int c = 0; c < NCHK; ++c) { st[(size_t)c * 4096] = s; s = s * dc[c] + x[c]; } }
        else {
#pragma unroll
            for (int c = 1; c >= 0; --c) { st[(size_t)c * 4096] = s; s = s * dc[c] + x[c]; }
#pragma unroll
            for (int c = NCHK - 1; c >= 2; --c) { st[(size_t)c * 4096] = s; s = s * dc[c] + x[c]; } }
    }
}

DI void ssdC_item(const Params& p, int layer, int it, unsigned char* smem) {
    const int g = it & 1, cidx = (it >> 1) % NCHK, b = it / (2 * NCHK);
    const int tid = get_tid(), lane = tid & 63, wave = tid >> 6, li = lane & 31, lh = lane >> 5;
    constexpr int NS = 72, TS = 136;
    bf16_t* Bn = (bf16_t*)smem;
    bf16_t* Cn = Bn + 128 * NS;
    bf16_t* XT = Cn + 128 * NS;
    float* dtv = (float*)(XT + 64 * TS);
    float* av = dtv + 256;
    float* cum = av + 256;
    const int r0 = chunk_row0(b, cidx);
    const bf16_t* UZ = (const bf16_t*)(p.ws + WS_UZ); const float* DT = (const float*)(p.ws + WS_DT); const float* ST = (const float*)(p.ws + stbase(layer));
    __syncthreads();
    { u32x4 sb[4], sc[4];
#pragma unroll
      for (int q = 0; q < 4; ++q) { const int i = tid + 256 * q, t = i >> 3, c8 = i & 7;
        sb[q] = *(const u32x4*)(UZ + (size_t)(r0 + t) * 1024 + 384 + g * 64 + c8 * 8); sc[q] = *(const u32x4*)(UZ + (size_t)(r0 + t) * 1024 + 512 + g * 64 + c8 * 8); }
#pragma unroll
      for (int q = 0; q < 4; ++q) { const int i = tid + 256 * q, t = i >> 3, c8 = i & 7; *(u32x4*)(Bn + t * NS + c8 * 8) = sb[q]; *(u32x4*)(Cn + t * NS + c8 * 8) = sc[q]; } }
    const int itok = 32 * wave + li;
    float ssq = 0.f;
    bf16_t* orow = (bf16_t*)(p.ws + WS_MIX) + (size_t)(r0 + itok) * 1024 + 384 + g * 192;
#pragma unroll 1
    for (int hh = 0; hh < 3; ++hh) {
        const int hd = g * 3 + hh;
        __syncthreads();
        { const int t = tid & 127, d = tid >> 7; const float dt = DT[(size_t)(r0 + t) * 12 + d * 6 + hd]; const float a = -__expf(p.in[I_ALOG][layer * 12 + d * 6 + hd]); dtv[d * 128 + t] = dt; av[d * 128 + t] = dt * a; }
        { bf16x8 sv[4];
#pragma unroll
          for (int q = 0; q < 4; ++q) { const int i = tid + 256 * q, t = i >> 3, c8 = i & 7; sv[q] = ld8(UZ + (size_t)(r0 + t) * 1024 + hd * 64 + c8 * 8); }
#pragma unroll
          for (int q = 0; q < 4; ++q) { const int i = tid + 256 * q, t = i >> 3, c8 = i & 7;
#pragma unroll
            for (int j = 0; j < 8; ++j) XT[(c8 * 8 + j) * TS + t] = (bf16_t)sv[q][j]; } }
        __syncthreads();
        if (wave < 2) wave_scan128(av + wave * 128, cum + wave * 128, wave == 1, lane);
        __syncthreads();
        f32x16 y0 = zero16(), y1 = zero16();
#pragma unroll 1
        for (int d = 0; d < 2; ++d) {
            const float ci = cum[d * 128 + itok], ei = __expf(ci);
            {
                const float* prev = ST + ((((size_t)d * 4 + b) * 6 + hd) * NCHK + cidx) * 4096;
#pragma unroll
                for (int ks = 0; ks < 4; ++ks) {
                    const f32x4 pa = *(const f32x4*)(prev + (li) * 64 + 16 * ks + 8 * lh), pb = *(const f32x4*)(prev + (li) * 64 + 16 * ks + 8 * lh + 4);
                    const f32x4 pc = *(const f32x4*)(prev + (32 + li) * 64 + 16 * ks + 8 * lh), pd = *(const f32x4*)(prev + (32 + li) * 64 + 16 * ks + 8 * lh + 4);
                    const bf16x8 cr = ld8(Cn + itok * NS + 16 * ks + 8 * lh);
                    const bf16x8 cf = pack8(bf2f((bf16_t)cr[0]) * ei, bf2f((bf16_t)cr[1]) * ei, bf2f((bf16_t)cr[2]) * ei, bf2f((bf16_t)cr[3]) * ei,
                                            bf2f((bf16_t)cr[4]) * ei, bf2f((bf16_t)cr[5]) * ei, bf2f((bf16_t)cr[6]) * ei, bf2f((bf16_t)cr[7]) * ei);
                    y0 = MFMA(pack8(pa.x, pa.y, pa.z, pa.w, pb.x, pb.y, pb.z, pb.w), cf, y0);
                    y1 = MFMA(pack8(pc.x, pc.y, pc.z, pc.w, pd.x, pd.y, pd.z, pd.w), cf, y1);
                }
            }
#pragma unroll 1
            for (int jt = 0; jt < 4; ++jt) {
                if (d == 0 ? (jt > wave) : (jt < wave)) continue;
                f32x16 gt = zero16();
#pragma unroll
                for (int ks = 0; ks < 4; ++ks) gt = MFMA(ld8(Bn + (32 * jt + li) * NS + 16 * ks + 8 * lh), ld8(Cn + itok * NS + 16 * ks + 8 * lh), gt);
#pragma unroll
                for (int r = 0; r < 16; ++r) { const int j = 32 * jt + crow(r, lh); const bool valid = d == 0 ? (j <= itok) : (j >= itok);
                    const float df = fminf(ci - cum[d * 128 + j], 0.f);
                    gt[r] = valid ? gt[r] * __expf(df) * dtv[d * 128 + j] : 0.f; }
                const bf16x8 pf0 = pack8(gt[0], gt[1], gt[2], gt[3], gt[4], gt[5], gt[6], gt[7]), pf1 = pack8(gt[8], gt[9], gt[10], gt[11], gt[12], gt[13], gt[14], gt[15]);
                const bf16_t* xb = XT + li * TS + 32 * jt + 4 * lh;
                y0 = MFMA(ld4x2(xb, xb + 8), pf0, y0); y0 = MFMA(ld4x2(xb + 16, xb + 24), pf1, y0);
                y1 = MFMA(ld4x2(xb + 32 * TS, xb + 32 * TS + 8), pf0, y1); y1 = MFMA(ld4x2(xb + 32 * TS + 16, xb + 32 * TS + 24), pf1, y1);
            }
        }
        const float dsk = p.in[I_DSS][layer * 6 + hd];
        const bf16_t* zrow = UZ + (size_t)(r0 + itok) * 1024 + 640 + hd * 64;
#pragma unroll
        for (int pt = 0; pt < 2; ++pt)
#pragma unroll
            for (int rg = 0; rg < 4; ++rg) {
                const int p0 = 32 * pt + 8 * rg + 4 * lh;
                const u32x2 zz = *(const u32x2*)(zrow + p0);
                const float z[4] = { bf2f((bf16_t)(zz.x & 0xffff)), bf2f((bf16_t)(zz.x >> 16)), bf2f((bf16_t)(zz.y & 0xffff)), bf2f((bf16_t)(zz.y >> 16)) };
                float o[4];
#pragma unroll
                for (int e = 0; e < 4; ++e) { const float yv = (pt ? y1[4 * rg + e] : y0[4 * rg + e]) + bf2f(XT[(p0 + e) * TS + itok]) * dsk; o[e] = yv * silu(z[e]); ssq += o[e] * o[e]; }
                u32x2 w; w.x = pack2(o[0], o[1]); w.y = pack2(o[2], o[3]); *(u32x2*)(orow + hh * 64 + p0) = w;
            }
    }
    ssq += __shfl_xor(ssq, 32);
    const float rstd = 1.f / sqrtf(ssq * (1.f / 192.f) + EPS);
    const float* gn = p.in[I_GSO] + layer * 384 + g * 192;
#pragma unroll 1
    for (int q = 0; q < 24; ++q) {
        const int c = 8 * q + 4 * lh; const u32x2 w = *(const u32x2*)(orow + c); const f32x4 gg = *(const f32x4*)(gn + c);
        u32x2 o; o.x = pack2(bf2f((bf16_t)(w.x & 0xffff)) * rstd * gg.x, bf2f((bf16_t)(w.x >> 16)) * rstd * gg.y);
        o.y = pack2(bf2f((bf16_t)(w.y & 0xffff)) * rstd * gg.z, bf2f((bf16_t)(w.y >> 16)) * rstd * gg.w);
        *(u32x2*)(orow + c) = o;
    }
}

DI int dyn_next(const Params& p, unsigned char* smem, int word) {
    volatile LAS unsigned* st = (volatile LAS unsigned*)(smem + LDS_MAIN);
    __syncthreads();
    if (get_tid() == 0) st[2] = atomicAdd((unsigned*)(p.ws + WS_CTRL) + word, 1u);
    __syncthreads();
    const unsigned v = st[2];
    return v > 0x3fffffffu ? 0x3fffffff : (int)v;
}
#define XCD_TILE_LOOP(MT, NTN, m_, n_) for (int lt_ = (bid >> 3), m_ = 0, n_ = 0; (lt_ < ((MT) >> 3) * (NTN)) && ((m_ = (bid & 7) + 8 * (lt_ / (NTN))), (n_ = lt_ % (NTN)), true); lt_ += (G >> 3))
constexpr int NPHASE = 24, PPL = 12;
DI void run_phase(const Params& p, int ph, unsigned char* smem, int sub = 0) {
    const int layer = ph / PPL, k = ph % PPL, G = gridDim.x, bid = blockIdx.x;
    const float* MOD = (const float*)(p.ws + WS_MOD) + (size_t)layer * 5 * 6144;
    switch (k) {
    case 0: {
        if (layer != 0) break;
        const int n1 = 384, n4 = n1 + WT_IN;
        for (int it = dyn_next(p, smem, 20); it < n4; it = dyn_next(p, smem, 20)) {
            if (it < n1) mod_item(p, it, smem);
            else wprep_item(p, 0, it - n1, smem);
        }
    } break;
    case 1: {
        norm_rows(p, layer, 0, NT, layer == 0);
    } break;
    case 2: {
        bf16_t* PROJ = (bf16_t*)(p.ws + WS_PROJ);
        auto epi = [&](int r, int c, float v) { PROJ[(size_t)r * INP + c] = f2bf(v); };
        XCD_TILE_LOOP(NT / 128, INP / 128, tm, tn) gemm_tile((const bf16_t*)(p.ws + WS_H), 1024, (const bf16_t*)(p.ws + wbase(layer) + W_IN), 1024, 1024, tm * 128, tn * 128, smem, epi);
        if (layer == 0) {
            const int n2 = 512, n3 = n2 + 32, n4 = n3 + (WT_TOTAL - WT_IN);
            for (int it = dyn_next(p, smem, 22); it < n4; it = dyn_next(p, smem, 22)) {
                if (it < n2) filt_item<SEQ>(p, 0, it, smem, (bf16_t*)(p.ws + WS_FL), (float*)(p.ws + WS_FPL));
                else if (it < n3) filt_item<CTX>(p, 0, it - n2, smem, (bf16_t*)(p.ws + WS_FC), (float*)(p.ws + WS_FPC));
                else wprep_item(p, 0, WT_IN + (it - n3), smem);
            }
        }
    } break;
    case 3: {
        const int n0 = NT / 128, n1 = n0 + (NT / 128) * 4, n3 = n1 + (NT / 64) * 12;
        for (int it = dyn_next(p, smem, 18 + layer); it < n3; it = dyn_next(p, smem, 18 + layer)) {
            if (it < n0) {
                if (sub == 0 || sub == 2) {
                    for (int q = 0; q < 4; ++q) ssmconv_item(p, layer, 4 * it + q);
                    __threadfence_block(); __syncthreads();
                    const int r0 = it * 128; int b, cidx;
                    if (r0 < NL) { b = r0 >> 12; cidx = 2 + ((r0 & 4095) >> 7); } else { b = (r0 - NL) >> 8; cidx = ((r0 - NL) & 255) >> 7; }
                    for (int hd = 0; hd < 6; ++hd) ssdA_item(p, layer, (b * 6 + hd) * NCHK + cidx, smem);
                }
            }
            else if (it < n1) { if (sub == 0 || sub == 1) qkv_item(p, layer, it - n0, smem); }
            else { if (sub == 0 || sub == 3) hyconv_item(p, layer, it - n1, smem); }
        }
    } break;
    case 4: break;
    case 5: ssd_scan(p, layer); break;
    case 6: {
        const int nH = 512, nA = 4 * 6 * 32, nS = 4 * NCHK * 2, nAc = (layer == 0) ? 4 * 6 * 2 : 0, nHc = (layer == 0) ? 256 : 0;
        const int n1 = nH, n2 = n1 + nA, n3 = n2 + nS, n4 = n3 + nAc, n5 = n4 + nHc;
        unsigned* ctr = (unsigned*)(p.ws + WS_CTRL) + 16 + layer;
        volatile LAS unsigned* st = (volatile LAS unsigned*)(smem + LDS_MAIN);
        for (;;) {
            __syncthreads();
            if (get_tid() == 0) st[2] = sub ? 0xffffffffu : atomicAdd(ctr, 1u);
            __syncthreads();
            const int it = (int)st[2];
            if (it < 0 || it >= n5) break;
            if (it < n1) hyena_lat_item(p, layer, it, smem);
            else if (it < n2) { const int j = it - n1, bh = j >> 5, qt = j & 31; attn_item(p, (const bf16_t*)(p.ws + WS_Q) + (size_t)bh * SEQ * 96, bh, qt * 128, NKEY, (bh / 6) * SEQ, smem); }
            else if (it < n3) { const int j = it - n2, cidx = (j >> 1) % NCHK; if (!(layer == 1 && cidx < 2)) ssdC_item(p, layer, j, smem); }
            else if (it < n4) { const int j = it - n3, bh = j >> 1, qt = j & 1; attn_item(p, (const bf16_t*)(p.ws + WS_QC) + (size_t)bh * CTX * 96, bh, qt * 128, CTX, NL + (bh / 6) * CTX, smem); }
            else hyena_ctx_item(p, layer, it - n4, smem);
        }
    } break;
    case 7: break;
    case 8: {
        const float* xin = p.in[I_X]; const float* cin = p.in[I_CTX]; float* out = p.out; float* XC = (float*)(p.ws + WS_XC);
        auto epi = [&](int r, int c, float v) {
            if (r < NL) { const float ga = MOD[(r >> 12) * 6144 + 2048 + c]; const size_t o = (size_t)r * 1024 + c; out[o] = (layer == 0 ? xin[o] : out[o]) + ga * v; }
            else { const float ga = MOD[4 * 6144 + 2048 + c]; const size_t o = (size_t)(r - NL) * 1024 + c; XC[o] = cin[o] + ga * v; } };
        XCD_TILE_LOOP((layer == 0 ? NT : NL) / 128, 8, tm, tn) gemm_tile((const bf16_t*)(p.ws + WS_MIX), 1024, (const bf16_t*)(p.ws + wbase(layer) + W_OUT), 1024, 1024, tm * 128, tn * 128, smem, epi, (const bf16_t*)(p.ws + WS_HYOT));
        if (layer == 0) {
            const int n1 = 512, n2 = n1 + WT_TOTAL;
            for (int it = dyn_next(p, smem, 21); it < n2; it = dyn_next(p, smem, 21)) {
                if (it < n1) filt_item<SEQ>(p, 1, it, smem, (bf16_t*)(p.ws + WS_FL), (float*)(p.ws + WS_FPL));
                else wprep_item(p, 1, it - n1, smem);
            }
        }
    } break;
    case 9: norm_rows(p, layer, 1, layer == 0 ? NT : NL, false); break;
    case 10: {
        bf16_t* HID = (bf16_t*)(p.ws + WS_HID);
        auto epi = [&](int r, int c, float v) { const float a = fmaxf(v, 0.f); HID[(size_t)r * 4096 + c] = f2bf(a * a); };
        XCD_TILE_LOOP((layer == 0 ? NT : NL) / 128, 32, tm, tn) gemm_tile((const bf16_t*)(p.ws + WS_H), 1024, (const bf16_t*)(p.ws + wbase(layer) + W_FF1), 1024, 1024, tm * 128, tn * 128, smem, epi);
    } break;
    case 11: {
        float* out = p.out; float* XC = (float*)(p.ws + WS_XC);
        auto epi = [&](int r, int c, float v) {
            if (r < NL) { const float ga = MOD[(r >> 12) * 6144 + 5120 + c]; out[(size_t)r * 1024 + c] += ga * v; }
            else { const float ga = MOD[4 * 6144 + 5120 + c]; XC[(size_t)(r - NL) * 1024 + c] += ga * v; } };
        XCD_TILE_LOOP(NL / 128, 8, tm, tn) gemm_tile((const bf16_t*)(p.ws + WS_HID), 4096, (const bf16_t*)(p.ws + wbase(layer) + W_FF2), 4096, 4096, tm * 128, tn * 128, smem, epi);
        if (layer == 0) {
            auto epa = [&](int r, int c, float v) { const float ga = MOD[4 * 6144 + 5120 + c]; atomicAdd(&XC[(size_t)(r - NL) * 1024 + c], ga * v); };
            for (int it = bid; it < 64 * 8; it += G) { const int tl = it >> 3, ks = it & 7;
                gemm_tile((const bf16_t*)(p.ws + WS_HID) + ks * 512, 4096, (const bf16_t*)(p.ws + wbase(layer) + W_FF2) + ks * 512, 4096, 512, NL + (tl / 8) * 128, (tl % 8) * 128, smem, epa); }
        }
    } break;
    }
}

__global__ void __launch_bounds__(NTHREADS, 2) mega_fwd(Params p, int ph_lo, int ph_hi) {
    extern __shared__ __align__(16) unsigned char smem[];
    volatile LAS unsigned* st = (volatile LAS unsigned*)(smem + LDS_MAIN);
    if (__builtin_amdgcn_workitem_id_x() == 0) { st[0] = 0u; st[1] = 0u; }
    __syncthreads();
    const bool multi = ph_hi - ph_lo > 1;
    XcdBarrier xb; xb.bar = (unsigned*)(p.ws + WS_CTRL); xb.x = 0; xb.st = st;
    if (multi) xb = xcd_barrier_post((unsigned*)(p.ws + WS_CTRL), st);
    if (ph_hi < 0) cg::this_grid().sync();
    for (int ph = ph_lo; ph < ph_hi; ++ph) {
        if (ph == PPL || (ph % PPL) == 7 || (ph % PPL) == 4) continue;
        run_phase(p, ph, smem);
#if REP_MASK
        if ((REP_MASK >> (ph % PPL)) & 1) { xcd_barrier(xb); run_phase(p, ph, smem, PROBE_SUB); }
#endif
        if (ph + 1 < ph_hi) xcd_barrier(xb);
    }
}

extern "C" void kernel_launch(void* const* d_in, const int* in_sizes, int n_in, void* d_out, int out_size, void* d_ws, size_t ws_size, hipStream_t stream) {
    static int grid = 0;
    if (grid == 0) {
        if (n_in != 34 || ws_size < WS_TOTAL) { fprintf(stderr, "kernel_launch: unexpected n_in %d / ws %zu (need %zu)\n", n_in, ws_size, (size_t)WS_TOTAL); grid = -1; return; }
        int dev = 0, cus = 0, per_cu = 0;
        hipGetDevice(&dev);
        hipDeviceGetAttribute(&cus, hipDeviceAttributeMultiprocessorCount, dev);
        hipFuncSetAttribute((const void*)mega_fwd, hipFuncAttributeMaxDynamicSharedMemorySize, LDS_BYTES);
        hipOccupancyMaxActiveBlocksPerMultiprocessor(&per_cu, (const void*)mega_fwd, NTHREADS, LDS_BYTES);
        if (per_cu < 1) per_cu = 1;
        if (per_cu > 2) per_cu = 2;
        grid = cus * per_cu;
        fprintf(stderr, "kernel_launch: cus %d per_cu %d grid %d\n", cus, per_cu, grid);
    }
    if (grid < 0) return;
    Params p{};
    for (int i = 0; i < 34; ++i) p.in[i] = (const float*)d_in[i];
    p.out = (float*)d_out; p.ws = (unsigned char*)d_ws;
#if N_LAUNCH_MODE == 1
    hipMemsetAsync((unsigned char*)d_ws + WS_CTRL, 0, XCD_BAR_WORDS * 4, stream);
    int lo = 0, hi = NPHASE;
    void* args[] = { &p, &lo, &hi };
    hipError_t e = hipLaunchCooperativeKernel((const void*)mega_fwd, dim3(grid), dim3(NTHREADS), args, LDS_BYTES, stream);
    if (e != hipSuccess) fprintf(stderr, "cooperative launch failed: %s (grid %d)\n", hipGetErrorString(e), grid);
#else
    for (int ph = 0; ph < NPHASE; ++ph) { if (ph == PPL) continue; mega_fwd<<<dim3(grid), dim3(NTHREADS), LDS_BYTES, stream>>>(p, ph, ph + 1); }
#endif
}
```

```cpp
#include <hip/hip_runtime.h>
#include <hip/hip_cooperative_groups.h>
#include <cstdio>
#include <cstdint>
namespace cg = cooperative_groups;

#ifndef REP_MASK
#define REP_MASK 0
#endif
#define PROBE_SUB 0
#ifndef N_LAUNCH_MODE
#define N_LAUNCH_MODE 1
#endif

typedef unsigned short bf16_t;
typedef short bf16x8 __attribute__((ext_vector_type(8)));
typedef short s16x4 __attribute__((ext_vector_type(4)));
typedef float f32x16 __attribute__((ext_vector_type(16)));
typedef float f32x4 __attribute__((ext_vector_type(4)));
typedef unsigned u32x4 __attribute__((ext_vector_type(4)));
typedef unsigned u32x2 __attribute__((ext_vector_type(2)));
#define DI __device__ __forceinline__
#define MFMA(a, b, c) __builtin_amdgcn_mfma_f32_32x32x16_bf16((a), (b), (c), 0, 0, 0)

constexpr int D = 1024, NB = 4, SEQ = 4096, CTX = 256;
constexpr int NL = NB * SEQ, NC = NB * CTX, NT = NL + NC;
constexpr int INC = 2220, INP = 2304;
constexpr int O_CQ = 0, O_CKV = 256, O_KR = 384, O_Z = 416, O_XBC = 800, O_DT = 1440, O_HY = 1452;
constexpr int NKEY = CTX + SEQ;
constexpr int NCHK = 34;
constexpr float EPS = 1e-6f;
constexpr int LDS_MAIN = 73728;
constexpr int LDS_BYTES = LDS_MAIN + 16;
constexpr int NTHREADS = 256;

constexpr size_t WS_CTRL = 0;
constexpr size_t WS_MOD = 16384;
constexpr size_t WS_W = WS_MOD + 245760;
constexpr size_t W_IN = 0, W_OUT = W_IN + (size_t)INP * 1024 * 2, W_FF1 = W_OUT + 1024 * 1024 * 2, W_FF2 = W_FF1 + 4096 * 1024 * 2,
                 W_UQ = W_FF2 + 4096 * 1024 * 2, W_UKV = W_UQ + 576 * 256 * 2, W_END = W_UKV + 768 * 128 * 2;
constexpr size_t ST_BYTES = (size_t)2 * 4 * 6 * NCHK * 4096 * 4, WREG = ST_BYTES + 8192;
static_assert(W_END <= WREG, "weight region");
constexpr size_t WS_FL = WS_W + WREG;
constexpr size_t WS_FC = WS_FL + 2 * 256 * 8192 * 2;
constexpr size_t WS_FPL = WS_FC + 2 * 256 * 512 * 2;
constexpr size_t WS_FPC = WS_FPL + 128 * 1024 * 4;
constexpr size_t WS_XC = WS_FPC + 8 * 1024 * 4;
constexpr size_t WS_H = WS_XC + (size_t)NC * 1024 * 4;
constexpr size_t WS_Q = WS_H;
constexpr size_t WS_QC = WS_Q + (size_t)4 * 6 * 4096 * 96 * 2;
constexpr size_t WS_VT = WS_QC + (size_t)4 * 6 * 256 * 96 * 2;
constexpr size_t WS_PROJ = WS_H + (size_t)NT * 1024 * 2;
constexpr size_t WS_ST = WS_PROJ;
constexpr size_t WS_DEC = WS_ST + (size_t)2 * 4 * 6 * NCHK * 4096 * 4;
constexpr size_t WS_HYOT = WS_DEC + 8192;
constexpr size_t WS_MIX = WS_HYOT + (size_t)256 * NT * 2;
constexpr size_t WS_K = WS_PROJ + (size_t)NT * INP * 2;
constexpr size_t WS_UZ = WS_K + (size_t)4 * 6 * NKEY * 96 * 2;
constexpr size_t WS_DT = WS_UZ + (size_t)NT * 1024 * 2;
constexpr size_t WS_P = WS_DT + (size_t)NT * 12 * 4;
constexpr size_t WS_END = WS_P + (size_t)3 * 256 * NT * 2;
constexpr size_t WS_HID = WS_PROJ;
constexpr size_t WS_W2 = WS_END;
constexpr size_t WS_TOTAL = WS_W2 + WREG;
DI size_t wbase(int layer) { return layer ? WS_W2 : WS_W; }
DI size_t stbase(int layer) { return layer ? WS_W : WS_W2; }
static_assert(WS_MIX + (size_t)NT * 1024 * 2 <= WS_K, "alias overflow");
static_assert(WS_VT + (size_t)4 * 6 * 64 * NKEY * 2 <= WS_PROJ, "alias overflow");
static_assert(WS_HID + (size_t)NT * 4096 * 2 <= WS_END, "hid overflow");
static_assert(WS_TOTAL <= 268435456ull, "ws overflow");

struct Params { const float* in[34]; float* out; unsigned char* ws; };
enum { I_X = 0, I_C, I_CTX, I_CCTX, I_WMOD, I_BMOD, I_GMIX, I_GMLP, I_WIN, I_WOUT, I_GCQ, I_GCKV, I_WUQ, I_WUKV, I_GQH, I_GKH,
       I_WCS, I_BCS, I_ALOG, I_DTB, I_DSS, I_GSO, I_WCH, I_BCH, I_WF1, I_BF1, I_FQ1, I_WF2, I_BF2, I_FQ2, I_WF3, I_DSH, I_WFF1, I_WFF2 };

DI int get_tid() { int t = (int)__builtin_amdgcn_workitem_id_x(); asm volatile("" : "+v"(t)); return t; }
DI float bf2f(bf16_t v) { return __uint_as_float(((unsigned)v) << 16); }
DI unsigned pack2(float lo, float hi) { unsigned r; asm("v_cvt_pk_bf16_f32 %0, %1, %2" : "=v"(r) : "v"(lo), "v"(hi)); return r; }
DI bf16_t f2bf(float x) { unsigned r; asm("v_cvt_pk_bf16_f32 %0, %1, %1" : "=v"(r) : "v"(x)); return (bf16_t)r; }
DI int crow(int reg, int h) { return (reg & 3) + 8 * (reg >> 2) + 4 * h; }
DI f32x16 zero16() { f32x16 z; _Pragma("unroll") for (int i = 0; i < 16; ++i) z[i] = 0.f; return z; }
DI bf16x8 pack8(float a0, float a1, float a2, float a3, float a4, float a5, float a6, float a7) {
    u32x4 u; u.x = pack2(a0, a1); u.y = pack2(a2, a3); u.z = pack2(a4, a5); u.w = pack2(a6, a7); return __builtin_bit_cast(bf16x8, u);
}
DI bf16x8 ld8(const bf16_t* p) { return *(const bf16x8*)p; }
DI bf16x8 ld4x2(const bf16_t* p0, const bf16_t* p1) {
    u32x2 a = *(const u32x2*)p0, b = *(const u32x2*)p1; u32x4 u; u.x = a.x; u.y = a.y; u.z = b.x; u.w = b.y; return __builtin_bit_cast(bf16x8, u);
}
DI float xor_red32(float v) { v += __shfl_xor(v, 16); v += __shfl_xor(v, 8); v += __shfl_xor(v, 4); v += __shfl_xor(v, 2); v += __shfl_xor(v, 1); return v; }
DI float wave_sum(float v) { _Pragma("unroll") for (int o = 1; o < 64; o <<= 1) v += __shfl_xor(v, o); return v; }
DI float silu(float x) { return x / (1.f + __expf(-x)); }
DI float softplus(float x) { return fmaxf(x, 0.f) + log1pf(__expf(-fabsf(x))); }


#define XB_TMO      128
#define XB_XCNT(j)  (256  + 64 * (j))
#define XB_XSUB(j)  (1280 + 64 * (j))
#define XB_XGEN(j)  (2304 + 64 * (j))
#define XB_TOP      3328
#define XB_TOPGEN   3392
#define XCD_BAR_WORDS 3456
#define XB_SPIN_CAP (1u << 20)
#define LAS __attribute__((address_space(3)))
DI unsigned xb_ld(unsigned* p)              { return __hip_atomic_load(p, __ATOMIC_RELAXED, __HIP_MEMORY_SCOPE_AGENT); }
DI unsigned xb_add(unsigned* p, unsigned v) { return __hip_atomic_fetch_add(p, v, __ATOMIC_RELAXED, __HIP_MEMORY_SCOPE_AGENT); }
DI unsigned xb_xcc_id() { return (unsigned)__builtin_amdgcn_s_getreg((3 << 11) | 20) & 0xFu; }
#define XB_SPIN(cond, bar) do { unsigned _sp = 0; while (cond) { __builtin_amdgcn_s_sleep(1); \
    if ((++_sp & 255u) == 0u) { if (xb_ld(&(bar)[XB_TMO])) break; if (_sp > XB_SPIN_CAP) { atomicAdd(&(bar)[XB_TMO], 1u); break; } } } } while (0)
struct XcdBarrier { unsigned* bar; unsigned x; volatile LAS unsigned* st; };
DI XcdBarrier xcd_barrier_post(unsigned* bar, volatile LAS unsigned* st) {
    XcdBarrier b; b.bar = bar; b.x = xb_xcc_id(); b.st = st;
    if (__builtin_amdgcn_workitem_id_x() == 0) (void)xb_add(&bar[XB_XCNT(b.x)], 1u);
    return b;
}
DI void xcd_barrier_complete(unsigned* bar, unsigned x, unsigned& nloc, unsigned& nx) {
    const unsigned G = gridDim.x * gridDim.y * gridDim.z;
    unsigned sum, cnt, mine, sp = 0u;
    for (;;) {
        sum = 0u; cnt = 0u; mine = 0u;
#pragma unroll
        for (unsigned j = 0; j < 16; ++j) { const unsigned c = xb_ld(&bar[XB_XCNT(j)]); sum += c; cnt += (c > 0u) ? 1u : 0u; mine = (j == x) ? c : mine; }
        if (sum == G) break;
        __builtin_amdgcn_s_sleep(1);
        if ((++sp & 255u) == 0u) { if (xb_ld(&bar[XB_TMO])) break; if (sp > XB_SPIN_CAP) { atomicAdd(&bar[XB_TMO], 1u); break; } }
    }
    nloc = mine > 0u ? mine : 1u; nx = cnt > 0u ? cnt : 1u;
}
DI void xcd_barrier(const XcdBarrier& b) {
    asm volatile("s_waitcnt vmcnt(0)" ::: "memory");
    __syncthreads();
    if (__builtin_amdgcn_workitem_id_x() == 0) {
        unsigned* bar = b.bar;
        __builtin_amdgcn_s_waitcnt(0);
        unsigned nloc = b.st[0], nx = b.st[1];
        if (nloc == 0u) { xcd_barrier_complete(bar, b.x, nloc, nx); b.st[0] = nloc; b.st[1] = nx; }
        const unsigned old = xb_add(&bar[XB_XSUB(b.x)], 1u);
        const unsigned gen = old / nloc;
        if (old + 1u == (gen + 1u) * nloc) {
            __builtin_amdgcn_fence(__ATOMIC_RELEASE, "agent");
            asm volatile("s_waitcnt vmcnt(0)" ::: "memory");
            const unsigned og = xb_add(&bar[XB_TOP], 1u);
            const unsigned tg = og / nx;
            if (og + 1u == (tg + 1u) * nx) xb_add(&bar[XB_TOPGEN], 1u);
            else XB_SPIN(xb_ld(&bar[XB_TOPGEN]) == tg, bar);
            __builtin_amdgcn_fence(__ATOMIC_ACQUIRE, "agent");
            xb_add(&bar[XB_XGEN(b.x)], 1u);
            asm volatile("s_waitcnt vmcnt(0)" ::: "memory");
        } else {
            XB_SPIN(xb_ld(&bar[XB_XGEN(b.x)]) == gen, bar);
            __builtin_amdgcn_fence(__ATOMIC_ACQUIRE, "agent");
            asm volatile("s_waitcnt vmcnt(0)" ::: "memory");
        }
    }
    __syncthreads();
}

DI void row_info(int r, int& b, int& t, int& L) { if (r < NL) { b = r >> 12; t = r & 4095; L = SEQ; } else { int q = r - NL; b = q >> 8; t = q & 255; L = CTX; } }

template <class Epi, class ColV>
DI void gemm_tile(const bf16_t* __restrict__ A, int lda, const bf16_t* __restrict__ Bt, int ldb, int K, int m0, int n0, unsigned char* smem, Epi epi, ColV colv, const bf16_t* __restrict__ HYT = nullptr) {
    constexpr int LS = 72;
    bf16_t* As = (bf16_t*)smem;
    bf16_t* Bs = As + 2 * 128 * LS;
    const int tid = get_tid(), lane = tid & 63, wave = tid >> 6, wr = wave >> 1, wc = wave & 1, li = lane & 31, lh = lane >> 5;
    f32x16 acc[2][2];
#pragma unroll
    for (int a = 0; a < 2; ++a)
#pragma unroll
        for (int b = 0; b < 2; ++b) acc[a][b] = zero16();
    u32x4 R0[8], R1[8];
    const int nk = K >> 6;
    auto gload = [&](u32x4 (&r)[8], int kt) {
#pragma unroll
        for (int i = 0; i < 4; ++i) { int id = tid + 256 * i, row = id >> 3, kc = id & 7;
            if (HYT && kt >= 12) r[i] = *(const u32x4*)(HYT + (size_t)((kt - 12) * 64 + (id >> 4)) * NT + m0 + (id & 15) * 8);
            else r[i] = *(const u32x4*)(A + (size_t)(m0 + row) * lda + kt * 64 + kc * 8);
            r[4 + i] = *(const u32x4*)(Bt + (size_t)(n0 + row) * ldb + kt * 64 + kc * 8); }
    };
    auto sstore = [&](const u32x4 (&r)[8], int buf, int kt) {
#pragma unroll
        for (int i = 0; i < 4; ++i) { int id = tid + 256 * i, row = id >> 3, kc = id & 7;
            if (HYT && kt >= 12) { const int kk = id >> 4, rr = (id & 15) * 8; bf16_t* d = As + (buf * 128 + rr) * LS + kk; const bf16x8 v = __builtin_bit_cast(bf16x8, r[i]);
#pragma unroll
                for (int e = 0; e < 8; ++e) d[e * LS] = (bf16_t)v[e]; }
            else *(u32x4*)(As + (buf * 128 + row) * LS + kc * 8) = r[i];
            *(u32x4*)(Bs + (buf * 128 + row) * LS + kc * 8) = r[4 + i]; }
    };
    auto step = [&](int kt, u32x4 (&ldset)[8], const u32x4 (&stset)[8]) {
        const int buf = kt & 1;
        if (kt + 2 < nk) gload(ldset, kt + 2);
        const bf16_t* Ab = As + (buf * 128 + 64 * wr + li) * LS + 8 * lh;
        const bf16_t* Bb = Bs + (buf * 128 + 64 * wc + li) * LS + 8 * lh;
        bf16x8 fa[2][2], fb[2][2], ga[2][2], gb[2][2];
#pragma unroll
        for (int k2 = 0; k2 < 2; ++k2) { fa[k2][0] = ld8(Ab + 16 * k2); fa[k2][1] = ld8(Ab + 32 * LS + 16 * k2); fb[k2][0] = ld8(Bb + 16 * k2); fb[k2][1] = ld8(Bb + 32 * LS + 16 * k2); }
        __builtin_amdgcn_sched_barrier(0);
#pragma unroll
        for (int k2 = 0; k2 < 2; ++k2) {
            acc[0][0] = MFMA(fa[k2][0], fb[k2][0], acc[0][0]); acc[0][1] = MFMA(fa[k2][0], fb[k2][1], acc[0][1]);
            acc[1][0] = MFMA(fa[k2][1], fb[k2][0], acc[1][0]); acc[1][1] = MFMA(fa[k2][1], fb[k2][1], acc[1][1]);
        }
#pragma unroll
        for (int k2 = 0; k2 < 2; ++k2) { const int ks = 2 + k2; ga[k2][0] = ld8(Ab + 16 * ks); ga[k2][1] = ld8(Ab + 32 * LS + 16 * ks); gb[k2][0] = ld8(Bb + 16 * ks); gb[k2][1] = ld8(Bb + 32 * LS + 16 * ks); }
#pragma unroll
        for (int k2 = 0; k2 < 2; ++k2) {
            acc[0][0] = MFMA(ga[k2][0], gb[k2][0], acc[0][0]); acc[0][1] = MFMA(ga[k2][0], gb[k2][1], acc[0][1]);
            acc[1][0] = MFMA(ga[k2][1], gb[k2][0], acc[1][0]); acc[1][1] = MFMA(ga[k2][1], gb[k2][1], acc[1][1]);
        }
        if (kt + 1 < nk) sstore(stset, buf ^ 1, kt + 1);
#pragma unroll
        for (int i = 0; i < 8; ++i) { __builtin_amdgcn_sched_group_barrier(0x008, 1, 0); __builtin_amdgcn_sched_group_barrier(0x100, 1, 0); }
#pragma unroll
        for (int i = 0; i < 8; ++i) { __builtin_amdgcn_sched_group_barrier(0x008, 1, 0); __builtin_amdgcn_sched_group_barrier(0x200, 1, 0); }
        __builtin_amdgcn_sched_barrier(0);
        __syncthreads();
    };
    gload(R0, 0); gload(R1, 1);
    sstore(R0, 0, 0); __syncthreads();
    for (int kt = 0; kt < nk; kt += 2) {
        step(kt, R0, R1);
        if (kt + 1 < nk) step(kt + 1, R1, R0);
    }
    const float cv0 = colv(m0, n0 + 64 * wc + li), cv1 = colv(m0, n0 + 64 * wc + 32 + li);
#pragma unroll
    for (int mi = 0; mi < 2; ++mi)
#pragma unroll
        for (int ni = 0; ni < 2; ++ni)
#pragma unroll
            for (int reg = 0; reg < 16; ++reg)
                epi(m0 + 64 * wr + 32 * mi + crow(reg, lh), n0 + 64 * wc + 32 * ni + li, acc[mi][ni][reg], ni ? cv1 : cv0);
}

DI void transpose_f32(const float* __restrict__ src, int ld_src, int Cvalid, bf16_t* __restrict__ dst, int ld_dst, int r0, int c0, const float* rscale, float* tile) {
    const int tid = get_tid();
    float tv[16];
#pragma unroll
    for (int j = 0; j < 16; ++j) { const int i = tid + 256 * j, r = i >> 6, c = i & 63; tv[j] = (c0 + c < Cvalid) ? src[(size_t)(r0 + r) * ld_src + c0 + c] : 0.f; }
#pragma unroll
    for (int j = 0; j < 16; ++j) { const int i = tid + 256 * j, r = i >> 6, c = i & 63; float v = tv[j]; if (rscale) v *= rscale[r0 + r]; tile[r * 65 + c] = v; }
    __syncthreads();
#pragma unroll
    for (int j = 0; j < 16; ++j) { const int i = tid + 256 * j, c = i >> 6, r = i & 63; dst[(size_t)(c0 + c) * ld_dst + r0 + r] = f2bf(tile[r * 65 + c]); }
    __syncthreads();
}
DI void transpose_bf16(const bf16_t* __restrict__ src, int ld_src, bf16_t* __restrict__ dst, int ld_dst, int r0, int c0, float* tile) {
    const int tid = get_tid();
    bf16_t tv[16];
#pragma unroll
    for (int j = 0; j < 16; ++j) { const int i = tid + 256 * j, r = i >> 6, c = i & 63; tv[j] = src[(size_t)(r0 + r) * ld_src + c0 + c]; }
#pragma unroll
    for (int j = 0; j < 16; ++j) { const int i = tid + 256 * j, r = i >> 6, c = i & 63; tile[r * 65 + c] = bf2f(tv[j]); }
    __syncthreads();
#pragma unroll
    for (int j = 0; j < 16; ++j) { const int i = tid + 256 * j, c = i >> 6, r = i & 63; dst[(size_t)(c0 + c) * ld_dst + r0 + r] = f2bf(tile[r * 65 + c]); }
    __syncthreads();
}
constexpr int WT_IN = 16 * 36, WT_OUT = 16 * 16, WT_FF1 = 16 * 64, WT_FF2 = 64 * 16, WT_UQ = 4 * 9, WT_UKV = 2 * 12;
constexpr int WT_TOTAL = WT_IN + WT_OUT + WT_FF1 + WT_FF2 + WT_UQ + WT_UKV;
DI void wprep_item(const Params& p, int layer, int it, unsigned char* smem) {
    float* tile = (float*)smem; bf16_t* W = (bf16_t*)(p.ws + wbase(layer));
    if (it < WT_IN) { int kt = it / 36, nt = it % 36; transpose_f32(p.in[I_WIN] + (size_t)layer * 1024 * INC, INC, INC, (bf16_t*)((unsigned char*)W + W_IN), 1024, kt * 64, nt * 64, nullptr, tile); return; } it -= WT_IN;
    if (it < WT_OUT) { int kt = it / 16, nt = it % 16; transpose_f32(p.in[I_WOUT] + (size_t)layer * 1024 * 1024, 1024, 1024, (bf16_t*)((unsigned char*)W + W_OUT), 1024, kt * 64, nt * 64, nullptr, tile); return; } it -= WT_OUT;
    if (it < WT_FF1) { int kt = it / 64, nt = it % 64; transpose_f32(p.in[I_WFF1] + (size_t)layer * 1024 * 4096, 4096, 4096, (bf16_t*)((unsigned char*)W + W_FF1), 1024, kt * 64, nt * 64, nullptr, tile); return; } it -= WT_FF1;
    if (it < WT_FF2) { int kt = it / 16, nt = it % 16; transpose_f32(p.in[I_WFF2] + (size_t)layer * 4096 * 1024, 1024, 1024, (bf16_t*)((unsigned char*)W + W_FF2), 4096, kt * 64, nt * 64, nullptr, tile); return; } it -= WT_FF2;
    if (it < WT_UQ) { int kt = it / 9, nt = it % 9; transpose_f32(p.in[I_WUQ] + (size_t)layer * 256 * 576, 576, 576, (bf16_t*)((unsigned char*)W + W_UQ), 256, kt * 64, nt * 64, p.in[I_GCQ] + layer * 256, tile); return; } it -= WT_UQ;
    { int kt = it / 12, nt = it % 12; transpose_f32(p.in[I_WUKV] + (size_t)layer * 128 * 768, 768, 768, (bf16_t*)((unsigned char*)W + W_UKV), 128, kt * 64, nt * 64, p.in[I_GCKV] + layer * 128, tile); }
}
DI void mod_item(const Params& p, int it, unsigned char* smem) {
    const int layer = it / 192, c0 = (it % 192) * 32, tid = get_tid();
    float* sl = (float*)smem;
    float* red = sl + 5 * 1024;
#pragma unroll
    for (int j = 0; j < 20; ++j) { const int i = tid + 256 * j, b = i >> 10, k = i & 1023; float v = (b < 4) ? p.in[I_C][b * 1024 + k] : p.in[I_CCTX][k]; sl[i] = silu(v); }
    __syncthreads();
    const int col = tid & 31, kg = tid >> 5;
    const float* W = p.in[I_WMOD] + (size_t)layer * 1024 * 6144 + c0 + col;
    float a0 = 0, a1 = 0, a2 = 0, a3 = 0, a4 = 0;
#pragma unroll 8
    for (int k = kg * 128; k < kg * 128 + 128; ++k) { float w = W[(size_t)k * 6144]; a0 += sl[k] * w; a1 += sl[1024 + k] * w; a2 += sl[2048 + k] * w; a3 += sl[3072 + k] * w; a4 += sl[4096 + k] * w; }
    red[(kg * 5 + 0) * 32 + col] = a0; red[(kg * 5 + 1) * 32 + col] = a1; red[(kg * 5 + 2) * 32 + col] = a2; red[(kg * 5 + 3) * 32 + col] = a3; red[(kg * 5 + 4) * 32 + col] = a4;
    __syncthreads();
    if (tid < 160) { int b = tid >> 5, c = tid & 31; float s = p.in[I_BMOD][layer * 6144 + c0 + c];
#pragma unroll
        for (int g = 0; g < 8; ++g) s += red[(g * 5 + b) * 32 + c];
        ((float*)(p.ws + WS_MOD))[(size_t)(layer * 5 + b) * 6144 + c0 + c] = s; }
    __syncthreads();
}
template <int L>
DI void filt_item(const Params& p, int layer, int it, unsigned char* smem, bf16_t* Fout, float* Part) {
    const int lb = it >> 2, cb = it & 3, tid = get_tid();
    float* feats = (float*)smem;
    float* h1 = feats + 32 * 33;
    float* h2 = h1 + 32 * 64;
    float* w1s = h2 + 32 * 64;
    float* w2s = w1s + 33 * 64;
    {
        const float* w1g = p.in[I_WF1] + layer * 33 * 64; const float* w2g = p.in[I_WF2] + layer * 64 * 64;
        float t1[9], t2[16];
#pragma unroll
        for (int j = 0; j < 9; ++j) { const int i = tid + 256 * j; t1[j] = (i < 33 * 64) ? w1g[i] : 0.f; }
#pragma unroll
        for (int j = 0; j < 16; ++j) t2[j] = w2g[tid + 256 * j];
#pragma unroll
        for (int j = 0; j < 9; ++j) { const int i = tid + 256 * j; if (i < 33 * 64) w1s[i] = t1[j]; }
#pragma unroll
        for (int j = 0; j < 16; ++j) w2s[tid + 256 * j] = t2[j];
    }
    const float wstep = (float)(2.0 * 3.14159265358979323846 / (double)L);
#pragma unroll 1
    for (int i = tid; i < 32 * 33; i += 256) { int lg = i / 33, f = i % 33, lag = lb * 32 + lg; float v;
        if (f == 0) v = (float)lag / (float)(L - 1);
        else { int bi = (f - 1) & 15; float band = 1e-4f + (float)bi * ((15.f - 1e-4f) / 15.f); float ang = band * (wstep * (float)lag); v = (f <= 16) ? cosf(ang) : -sinf(ang); }
        feats[i] = v; }
    __syncthreads();
    const float* w1 = w1s; const float* w2 = w2s;
#pragma unroll 1
    for (int i = tid; i < 2048; i += 256) { int lg = i >> 6, j = i & 63; float s = p.in[I_BF1][layer * 64 + j];
#pragma unroll 3
        for (int f = 0; f < 33; ++f) s += feats[lg * 33 + f] * w1[f * 64 + j];
        h1[i] = sinf(p.in[I_FQ1][layer * 64 + j] * s); }
    __syncthreads();
#pragma unroll 1
    for (int i = tid; i < 2048; i += 256) { int lg = i >> 6, j = i & 63; float s = p.in[I_BF2][layer * 64 + j];
#pragma unroll 4
        for (int f = 0; f < 64; ++f) s += h1[lg * 64 + f] * w2[f * 64 + j];
        h2[i] = sinf(p.in[I_FQ2][layer * 64 + j] * s); }
    __syncthreads();
    const int col = cb * 256 + tid, dir = col >> 9, o = (col >> 8) & 1, ch = col & 255;
    const float* w3 = p.in[I_WF3] + (size_t)layer * 64 * 1024 + col;
    const float d0 = -4.605170185988091f / 1.5f, d1 = -4.605170185988091f / 0.3f;
    const float delta = fabsf(d0 + (float)ch * ((d1 - d0) / 255.f));
    bf16_t* F = Fout + (size_t)(o * 256 + ch) * (2 * L);
    float asum = 0.f;
    float wreg[64];
#pragma unroll
    for (int k = 0; k < 64; ++k) wreg[k] = w3[k * 1024];
#pragma unroll 1
    for (int lg = 0; lg < 32; ++lg) {
        float a0 = 0.f, a1 = 0.f;
#pragma unroll
        for (int k = 0; k < 64; k += 8) { const f32x4 hv = *(const f32x4*)(h2 + lg * 64 + k), hw = *(const f32x4*)(h2 + lg * 64 + k + 4);
            a0 += hv.x * wreg[k] + hv.y * wreg[k + 1] + hv.z * wreg[k + 2] + hv.w * wreg[k + 3];
            a1 += hw.x * wreg[k + 4] + hw.y * wreg[k + 5] + hw.z * wreg[k + 6] + hw.w * wreg[k + 7]; }
        const int lag = lb * 32 + lg; const float t01 = (float)lag / (float)(L - 1); const float v = (a0 + a1) * __expf(-t01 * delta);
        if (dir == 0) { F[L + lag] = f2bf(v); asum += fabsf(v); }
        else { if (lag == 0) F[0] = 0; else { F[L - lag] = f2bf(v); asum += fabsf(v); } }
    }
    Part[lb * 1024 + col] = asum;
    __syncthreads();
}

DI void norm_rows(const Params& p, int layer, int which  , int nrows, bool from_input) {
    const int lane = get_tid() & 63, gw = blockIdx.x * 4 + (get_tid() >> 6), NGW = gridDim.x * 4;
    const float* g = p.in[which ? I_GMLP : I_GMIX] + layer * 1024;
    const float* MOD = (const float*)(p.ws + WS_MOD) + (size_t)layer * 5 * 6144;
    bf16_t* H = (bf16_t*)(p.ws + WS_H);
    for (int r = gw; r < nrows; r += NGW) {
        const float* src; int mb;
        if (r < NL) { src = (from_input ? p.in[I_X] : p.out) + (size_t)r * 1024; mb = r >> 12; }
        else { src = (from_input ? p.in[I_CTX] : (const float*)(p.ws + WS_XC)) + (size_t)(r - NL) * 1024; mb = 4; }
        const float* sh = MOD + mb * 6144 + (which ? 3072 : 0); const float* sc = sh + 1024;
        f32x4 v[4]; float ss = 0.f;
#pragma unroll
        for (int j = 0; j < 4; ++j) { v[j] = *(const f32x4*)(src + 256 * j + 4 * lane); ss += v[j].x * v[j].x + v[j].y * v[j].y + v[j].z * v[j].z + v[j].w * v[j].w; }
        const float rstd = 1.f / sqrtf(wave_sum(ss) * (1.f / 1024.f) + EPS);
#pragma unroll
        for (int j = 0; j < 4; ++j) { const int c = 256 * j + 4 * lane; f32x4 gg = *(const f32x4*)(g + c), s1 = *(const f32x4*)(sc + c), s0 = *(const f32x4*)(sh + c);
            float o0 = v[j].x * rstd * gg.x * (1.f + s1.x) + s0.x, o1 = v[j].y * rstd * gg.y * (1.f + s1.y) + s0.y, o2 = v[j].z * rstd * gg.z * (1.f + s1.z) + s0.z, o3 = v[j].w * rstd * gg.w * (1.f + s1.w) + s0.w;
            u32x2 w; w.x = pack2(o0, o1); w.y = pack2(o2, o3); *(u32x2*)(H + (size_t)r * 1024 + c) = w; }
    }
}

DI void hyconv_item(const Params& p, int layer, int it, unsigned char* smem) {
    const int rt = it / 12, ct = it % 12, r0 = rt * 64, c0 = ct * 64, tid = get_tid();
    float* tile = (float*)smem;
    const bf16_t* PROJ = (const bf16_t*)(p.ws + WS_PROJ);
    int b, t, L; row_info(r0, b, t, L);
    u32x2 hv[5];
#pragma unroll
    for (int j = 0; j < 5; ++j) { const int i = tid + 256 * j, rr = i >> 4, c = (i & 15) * 4, tt = t + rr - 1; hv[j].x = 0u; hv[j].y = 0u;
        if (i < 66 * 16 && tt >= 0 && tt < L) hv[j] = *(const u32x2*)(PROJ + (size_t)(r0 + rr - 1) * INP + O_HY + c0 + c); }
#pragma unroll
    for (int j = 0; j < 5; ++j) { const int i = tid + 256 * j, rr = i >> 4, c = (i & 15) * 4; const u32x2 v = hv[j];
        if (i < 66 * 16) { float* tp = tile + rr * 65 + c; tp[0] = bf2f((bf16_t)(v.x & 0xffff)); tp[1] = bf2f((bf16_t)(v.x >> 16)); tp[2] = bf2f((bf16_t)(v.y & 0xffff)); tp[3] = bf2f((bf16_t)(v.y >> 16)); } }
    const float* w = p.in[I_WCH] + layer * 3 * 768; const float* bb = p.in[I_BCH] + layer * 768;
    bf16_t* P = (bf16_t*)(p.ws + WS_P);
    float* wl = tile + 66 * 65;
    { const int q = tid >> 6, c = tid & 63; wl[tid] = (q == 0) ? bb[c0 + c] : w[(q - 1) * 768 + c0 + c]; }
    __syncthreads();
#pragma unroll
    for (int j = 0; j < 8; ++j) { const int i = tid + 256 * j, c = i >> 5, rp = (i & 31) * 2, cc = c0 + c;
        const float t0 = tile[rp * 65 + c], t1 = tile[(rp + 1) * 65 + c], t2 = tile[(rp + 2) * 65 + c], t3 = tile[(rp + 3) * 65 + c];
        const float bq = wl[c], wa = wl[64 + c], wb = wl[128 + c], wc = wl[192 + c];
        const float v0 = bq + wa * t0 + wb * t1 + wc * t2, v1 = bq + wa * t1 + wb * t2 + wc * t3;
        *(unsigned*)(P + (size_t)cc * NT + r0 + rp) = pack2(v0, v1); }
    __syncthreads();
}
DI void ssmconv_item(const Params& p, int layer, int it) {
    const int r0 = it * 32, tid = get_tid();
    const bf16_t* PROJ = (const bf16_t*)(p.ws + WS_PROJ); bf16_t* UZ = (bf16_t*)(p.ws + WS_UZ); float* DT = (float*)(p.ws + WS_DT);
    const float* w = p.in[I_WCS] + layer * 3 * 640; const float* bb = p.in[I_BCS] + layer * 640;
    int b, t0, L; row_info(r0, b, t0, L);
#pragma unroll 1
    for (int j0 = 0; j0 < 10; j0 += 5) {
        bf16x8 xc[5], xp[5], xn[5];
#pragma unroll
        for (int j = 0; j < 5; ++j) { const int i = tid + 256 * (j0 + j), rl = i / 80, c = (i - rl * 80) * 8, t = t0 + rl; const size_t r = r0 + rl;
            const bf16_t* src = PROJ + r * INP + O_XBC + c;
            xc[j] = ld8(src); xp[j] = xc[j]; xn[j] = xc[j];
            if (t > 0) xp[j] = ld8(src - INP);
            if (t < L - 1) xn[j] = ld8(src + INP); }
#pragma unroll
        for (int j = 0; j < 5; ++j) { const int i = tid + 256 * (j0 + j), rl = i / 80, c = (i - rl * 80) * 8, t = t0 + rl; const size_t r = r0 + rl;
            const bool hp = t > 0, hn = t < L - 1;
            const f32x4 b0 = *(const f32x4*)(bb + c), b1 = *(const f32x4*)(bb + c + 4), wa0 = *(const f32x4*)(w + c), wa1 = *(const f32x4*)(w + c + 4),
                        wb0 = *(const f32x4*)(w + 640 + c), wb1 = *(const f32x4*)(w + 640 + c + 4), wc0 = *(const f32x4*)(w + 1280 + c), wc1 = *(const f32x4*)(w + 1280 + c + 4);
            const float bv[8] = { b0.x, b0.y, b0.z, b0.w, b1.x, b1.y, b1.z, b1.w }, w0v[8] = { wa0.x, wa0.y, wa0.z, wa0.w, wa1.x, wa1.y, wa1.z, wa1.w },
                        w1v[8] = { wb0.x, wb0.y, wb0.z, wb0.w, wb1.x, wb1.y, wb1.z, wb1.w }, w2v[8] = { wc0.x, wc0.y, wc0.z, wc0.w, wc1.x, wc1.y, wc1.z, wc1.w };
            float o[8];
#pragma unroll
            for (int e = 0; e < 8; ++e) { float v = bv[e] + w1v[e] * bf2f((bf16_t)xc[j][e]);
                if (hp) v += w0v[e] * bf2f((bf16_t)xp[j][e]);
                if (hn) v += w2v[e] * bf2f((bf16_t)xn[j][e]);
                o[e] = silu(v); }
            *(bf16x8*)(UZ + r * 1024 + c) = pack8(o[0], o[1], o[2], o[3], o[4], o[5], o[6], o[7]); }
    }
    { u32x4 zc[6];
#pragma unroll
      for (int j = 0; j < 6; ++j) { const int i = tid + 256 * j, rl = i / 48, c = (i - rl * 48) * 8; zc[j] = *(const u32x4*)(PROJ + (size_t)(r0 + rl) * INP + O_Z + c); }
#pragma unroll
      for (int j = 0; j < 6; ++j) { const int i = tid + 256 * j, rl = i / 48, c = (i - rl * 48) * 8; *(u32x4*)(UZ + (size_t)(r0 + rl) * 1024 + 640 + c) = zc[j]; } }
    for (int i = tid; i < 32 * 12; i += 256) { const int rl = i / 12, c = i - rl * 12; const size_t r = r0 + rl;
        DT[r * 12 + c] = softplus(bf2f(PROJ[r * INP + O_DT + c]) + p.in[I_DTB][layer * 12 + c]); }
}
DI void qkv_item(const Params& p, int layer, int it, unsigned char* smem) {
    const int tid = get_tid(), lane = tid & 63, wave = tid >> 6, li = lane & 31, lh = lane >> 5;
    const int ug = it & 3, hd0 = 3 * (ug & 1);
    const int rbase = (it >> 2) * 128 + 32 * wave;
    const bf16_t* PROJ = (const bf16_t*)(p.ws + WS_PROJ);
    bf16_t* Ws = (bf16_t*)smem;
    int b, t0, L; row_info(rbase, b, t0, L);
    const bool lat = rbase < NL;
    float cs[16], sn[16];
    {
        const int axis = li >> 4, f = li & 7; const float inv = exp2f(-(float)f * (13.287712379549449f / 8.f));
#pragma unroll
        for (int reg = 0; reg < 16; ++reg) { int t = t0 + crow(reg, lh); float pos = (float)(axis ? (t & 63) : (t >> 6)); const float ang = pos * inv; cs[reg] = __cosf(ang); sn[reg] = __sinf(ang); }
    }
    const bool second = (li >> 3) & 1;
    if (ug < 2) {
        const bf16_t* Wq = (const bf16_t*)(p.ws + wbase(layer) + W_UQ);
        const float* gq = p.in[I_GQH] + layer * 96;
        const bf16_t* arow = PROJ + (size_t)(rbase + li) * INP + O_CQ + 8 * lh;
        float ss = 0.f;
#pragma unroll 1
        for (int kh = 0; kh < 2; ++kh) { bf16x8 a[8];
#pragma unroll
            for (int ks = 0; ks < 8; ++ks) a[ks] = ld8(arow + 128 * kh + 16 * ks);
#pragma unroll
            for (int ks = 0; ks < 8; ++ks) {
#pragma unroll
                for (int j = 0; j < 8; ++j) { float x = bf2f((bf16_t)a[ks][j]); ss += x * x; } } }
        ss += __shfl_xor(ss, 32);
        const float alpha = 1.f / sqrtf(ss * (1.f / 256.f) + EPS);
        float al[16];
#pragma unroll
        for (int reg = 0; reg < 16; ++reg) al[reg] = __shfl(alpha, crow(reg, lh));
        const float g0 = gq[li], g1 = gq[32 + li], g2 = gq[64 + li];
#pragma unroll 1
        for (int hd = hd0; hd < hd0 + 3; ++hd) {
            __syncthreads();
#pragma unroll 1
            for (int jb = 0; jb < 12; jb += 6) { u32x4 sw[6];
#pragma unroll
              for (int j = 0; j < 6; ++j) { const int i = tid + 256 * (jb + j), n = i >> 5, kc = i & 31; sw[j] = *(const u32x4*)(Wq + (size_t)(hd * 96 + n) * 256 + kc * 8); }
#pragma unroll
              for (int j = 0; j < 6; ++j) { const int i = tid + 256 * (jb + j), n = i >> 5, kc = i & 31; *(u32x4*)(Ws + n * 264 + kc * 8) = sw[j]; } }
            __syncthreads();
            f32x16 c0 = zero16(), c1 = zero16(), c2 = zero16();
            const bf16_t* wb = Ws + li * 264 + 8 * lh;
#pragma unroll 1
            for (int kh = 0; kh < 4; ++kh) { bf16x8 a[4];
#pragma unroll
                for (int ks = 0; ks < 4; ++ks) a[ks] = ld8(arow + 64 * kh + 16 * ks);
                __builtin_amdgcn_sched_barrier(0);
#pragma unroll
                for (int ks = 0; ks < 4; ++ks) { const bf16_t* w_ = wb + 64 * kh + 16 * ks;
                    c0 = MFMA(a[ks], ld8(w_), c0); c1 = MFMA(a[ks], ld8(w_ + 32 * 264), c1); c2 = MFMA(a[ks], ld8(w_ + 64 * 264), c2);
                    if ((ks & 1) == 1) __builtin_amdgcn_sched_barrier(0);
                } }
            bf16_t* Qp = lat ? (bf16_t*)(p.ws + WS_Q) + ((size_t)(b * 6 + hd) * SEQ + t0) * 96 : (bf16_t*)(p.ws + WS_QC) + ((size_t)(b * 6 + hd) * CTX + t0) * 96;
#pragma unroll
            for (int reg = 0; reg < 16; ++reg) {
                float s2 = xor_red32(c0[reg] * c0[reg] + c1[reg] * c1[reg] + c2[reg] * c2[reg]);
                const float ar = al[reg], rs = 1.f / sqrtf(ar * ar * s2 * (1.f / 96.f) + EPS), sc = ar * rs;
                float v0 = c0[reg] * sc * g0, v1 = c1[reg] * sc * g1, v2 = c2[reg] * sc * g2;
                float pr = __shfl_xor(v2, 8);
                if (lat) v2 = second ? (v2 * cs[reg] + pr * sn[reg]) : (v2 * cs[reg] - pr * sn[reg]);
                bf16_t* q = Qp + (size_t)crow(reg, lh) * 96;
                q[li] = f2bf(v0); q[32 + li] = f2bf(v1); q[64 + li] = f2bf(v2);
                if ((reg & 3) == 3) __builtin_amdgcn_sched_barrier(0);
            }
        }
        __syncthreads();
    }
    else {
        const bf16_t* Wkv = (const bf16_t*)(p.ws + wbase(layer) + W_UKV);
        const float* gk = p.in[I_GKH] + layer * 96;
        const bf16_t* arow = PROJ + (size_t)(rbase + li) * INP + O_CKV + 8 * lh;
        float ss = 0.f;
        { bf16x8 a[8];
#pragma unroll
          for (int ks = 0; ks < 8; ++ks) a[ks] = ld8(arow + 16 * ks);
#pragma unroll
          for (int ks = 0; ks < 8; ++ks) {
#pragma unroll
            for (int j = 0; j < 8; ++j) { float x = bf2f((bf16_t)a[ks][j]); ss += x * x; } } }
        ss += __shfl_xor(ss, 32);
        const float alpha = 1.f / sqrtf(ss * (1.f / 128.f) + EPS);
        float al[16], krv[16];
#pragma unroll
        for (int reg = 0; reg < 16; ++reg) { al[reg] = __shfl(alpha, crow(reg, lh)); krv[reg] = bf2f(PROJ[(size_t)(rbase + crow(reg, lh)) * INP + O_KR + li]); }
        const float g0 = gk[li], g1 = gk[32 + li], g2 = gk[64 + li];
        const int kbase = lat ? (CTX + t0) : t0;
#pragma unroll 1
        for (int hd = hd0; hd < hd0 + 3; ++hd) {
            __syncthreads();
#pragma unroll 1
            for (int jb = 0; jb < 8; jb += 4) { u32x4 sw[4];
#pragma unroll
              for (int j = 0; j < 4; ++j) { const int i = tid + 256 * (jb + j), n = i >> 4, kc = i & 15; sw[j] = *(const u32x4*)(Wkv + (size_t)(hd * 128 + n) * 128 + kc * 8); }
#pragma unroll
              for (int j = 0; j < 4; ++j) { const int i = tid + 256 * (jb + j), n = i >> 4, kc = i & 15; *(u32x4*)(Ws + n * 136 + kc * 8) = sw[j]; } }
            __syncthreads();
            f32x16 c0 = zero16(), c1 = zero16(), c2 = zero16(), c3 = zero16();
            const bf16_t* wb = Ws + li * 136 + 8 * lh;
#pragma unroll 1
            for (int kh = 0; kh < 2; ++kh) { bf16x8 a[4];
#pragma unroll
                for (int ks = 0; ks < 4; ++ks) a[ks] = ld8(arow + 64 * kh + 16 * ks);
                __builtin_amdgcn_sched_barrier(0);
#pragma unroll
                for (int ks = 0; ks < 4; ++ks) { const bf16_t* w_ = wb + 64 * kh + 16 * ks;
                    c0 = MFMA(a[ks], ld8(w_), c0); c1 = MFMA(a[ks], ld8(w_ + 32 * 136), c1);
                    c2 = MFMA(a[ks], ld8(w_ + 64 * 136), c2); c3 = MFMA(a[ks], ld8(w_ + 96 * 136), c3);
                    __builtin_amdgcn_sched_barrier(0);
                } }
            bf16_t* Kp = (bf16_t*)(p.ws + WS_K) + ((size_t)(b * 6 + hd) * NKEY + kbase) * 96;
            bf16_t* Vp = (bf16_t*)(p.ws + WS_VT) + ((size_t)(b * 6 + hd) * 64) * NKEY + kbase;
#pragma unroll
            for (int reg = 0; reg < 16; ++reg) {
                const float ar = al[reg];
                float s2 = xor_red32(ar * ar * (c0[reg] * c0[reg] + c1[reg] * c1[reg]) + krv[reg] * krv[reg]);
                const float rs = 1.f / sqrtf(s2 * (1.f / 96.f) + EPS);
                float v0 = c0[reg] * ar * rs * g0, v1 = c1[reg] * ar * rs * g1, v2 = krv[reg] * rs * g2;
                float pr = __shfl_xor(v2, 8);
                if (lat) v2 = second ? (v2 * cs[reg] + pr * sn[reg]) : (v2 * cs[reg] - pr * sn[reg]);
                bf16_t* k = Kp + (size_t)crow(reg, lh) * 96;
                k[li] = f2bf(v0); k[32 + li] = f2bf(v1); k[64 + li] = f2bf(v2);
                if ((reg & 3) == 3) __builtin_amdgcn_sched_barrier(0);
            }
#pragma unroll
            for (int rg = 0; rg < 4; ++rg) {
                const int k0 = 8 * rg + 4 * lh;
                u32x2 w0, w1;
                w0.x = pack2(c2[4 * rg] * al[4 * rg], c2[4 * rg + 1] * al[4 * rg + 1]); w0.y = pack2(c2[4 * rg + 2] * al[4 * rg + 2], c2[4 * rg + 3] * al[4 * rg + 3]);
                w1.x = pack2(c3[4 * rg] * al[4 * rg], c3[4 * rg + 1] * al[4 * rg + 1]); w1.y = pack2(c3[4 * rg + 2] * al[4 * rg + 2], c3[4 * rg + 3] * al[4 * rg + 3]);
                *(u32x2*)(Vp + (size_t)li * NKEY + k0) = w0;
                *(u32x2*)(Vp + (size_t)(32 + li) * NKEY + k0) = w1;
            }
        }
        __syncthreads();
    }
}

DI void attn_item(const Params& p, const bf16_t* Qbase  , int bh, int q0, int nkeys, int out_row0, unsigned char* smem) {
    constexpr int KS = 104, VS = 68;
    bf16_t* Ks = (bf16_t*)smem;
    bf16_t* Vs = Ks + 2 * 64 * KS;
    const int tid = get_tid(), lane = tid & 63, wave = tid >> 6, li = lane & 31, lh = lane >> 5;
    const bf16_t* Kg = (const bf16_t*)(p.ws + WS_K) + (size_t)bh * NKEY * 96;
    const bf16_t* Vg = (const bf16_t*)(p.ws + WS_VT) + (size_t)bh * 64 * NKEY;
    bf16x8 qf[6];
#pragma unroll
    for (int ks = 0; ks < 6; ++ks) qf[ks] = ld8(Qbase + (size_t)(q0 + 32 * wave + li) * 96 + 16 * ks + 8 * lh);
    u32x4 rk[3], rv[2];
    auto gload = [&](int kt) {
#pragma unroll
        for (int i = 0; i < 3; ++i) { int id = tid + 256 * i; rk[i] = *(const u32x4*)(Kg + (size_t)kt * 64 * 96 + id * 8); }
#pragma unroll
        for (int i = 0; i < 2; ++i) { int id = tid + 256 * i, v = id >> 3, kc = id & 7; rv[i] = *(const u32x4*)(Vg + (size_t)v * NKEY + kt * 64 + kc * 8); }
    };
    auto sstore = [&](int buf) {
#pragma unroll
        for (int i = 0; i < 3; ++i) { int id = tid + 256 * i, key = id / 12, dc = id - key * 12; *(u32x4*)(Ks + (buf * 64 + key) * KS + dc * 8) = rk[i]; }
#pragma unroll
        for (int i = 0; i < 2; ++i) { int id = tid + 256 * i, v = id >> 3, kc = id & 7; bf16_t* d = Vs + (buf * 64 + v) * VS + kc * 8;
            u32x2 lo, hi; lo.x = rv[i].x; lo.y = rv[i].y; hi.x = rv[i].z; hi.y = rv[i].w; *(u32x2*)d = lo; *(u32x2*)(d + 4) = hi; }
    };
    const int nkt = nkeys >> 6;
    const float scl = 0.10206207261596577f * 1.4426950408889634f;
    f32x16 o0 = zero16(), o1 = zero16(); float m = -1e30f, l = 0.f;
    __syncthreads();
    gload(0); sstore(0); __syncthreads();
    for (int kt = 0; kt < nkt; ++kt) {
        const int buf = kt & 1;
        if (kt + 1 < nkt) gload(kt + 1);
        __builtin_amdgcn_sched_barrier(0);
        f32x16 s0 = zero16(), s1 = zero16();
        const bf16_t* kb = Ks + (buf * 64 + li) * KS + 8 * lh;
#pragma unroll
        for (int ks = 0; ks < 6; ++ks) { s0 = MFMA(ld8(kb + 16 * ks), qf[ks], s0); s1 = MFMA(ld8(kb + 32 * KS + 16 * ks), qf[ks], s1); }
        float mx = fmaxf(s0[0], s1[0]);
#pragma unroll
        for (int r = 1; r < 16; ++r) mx = fmaxf(fmaxf(mx, s0[r]), s1[r]);
        mx = fmaxf(mx, __shfl_xor(mx, 32));
        const float mn = fmaxf(m, mx);
        if (__any(mn > m)) {
            const float corr = __builtin_amdgcn_exp2f((m - mn) * scl);
            l *= corr;
#pragma unroll
            for (int r = 0; r < 16; ++r) { o0[r] *= corr; o1[r] *= corr; }
            m = mn;
        }
        const float nb = -m * scl;
        float sum0 = 0.f, sum1 = 0.f;
#pragma unroll
        for (int r = 0; r < 16; ++r) { s0[r] = __builtin_amdgcn_exp2f(fmaf(s0[r], scl, nb)); s1[r] = __builtin_amdgcn_exp2f(fmaf(s1[r], scl, nb)); sum0 += s0[r]; sum1 += s1[r]; }
        float sum = sum0 + sum1;
        sum += __shfl_xor(sum, 32);
        l += sum;
        bf16x8 pf[2][2];
        pf[0][0] = pack8(s0[0], s0[1], s0[2], s0[3], s0[4], s0[5], s0[6], s0[7]); pf[0][1] = pack8(s0[8], s0[9], s0[10], s0[11], s0[12], s0[13], s0[14], s0[15]);
        pf[1][0] = pack8(s1[0], s1[1], s1[2], s1[3], s1[4], s1[5], s1[6], s1[7]); pf[1][1] = pack8(s1[8], s1[9], s1[10], s1[11], s1[12], s1[13], s1[14], s1[15]);
        const bf16_t* vb = Vs + (buf * 64 + li) * VS + 4 * lh;
#pragma unroll
        for (int j = 0; j < 2; ++j)
#pragma unroll
            for (int s = 0; s < 2; ++s) {
                const int ko = 32 * j + 16 * s;
                o0 = MFMA(ld4x2(vb + ko, vb + ko + 8), pf[j][s], o0);
                o1 = MFMA(ld4x2(vb + 32 * VS + ko, vb + 32 * VS + ko + 8), pf[j][s], o1);
            }
        __builtin_amdgcn_sched_barrier(0);
        if (kt + 1 < nkt) sstore(buf ^ 1);
        __syncthreads();
    }
    const float inv = 1.f / l;
    bf16_t* MIX = (bf16_t*)(p.ws + WS_MIX);
    const int hd = bh % 6;
    bf16_t* orow = MIX + (size_t)(out_row0 + q0 + 32 * wave + li) * 1024 + hd * 64;
#pragma unroll
    for (int rg = 0; rg < 4; ++rg) {
        u32x2 w0, w1;
        w0.x = pack2(o0[4 * rg] * inv, o0[4 * rg + 1] * inv); w0.y = pack2(o0[4 * rg + 2] * inv, o0[4 * rg + 3] * inv);
        w1.x = pack2(o1[4 * rg] * inv, o1[4 * rg + 1] * inv); w1.y = pack2(o1[4 * rg + 2] * inv, o1[4 * rg + 3] * inv);
        *(u32x2*)(orow + 8 * rg + 4 * lh) = w0;
        *(u32x2*)(orow + 32 + 8 * rg + 4 * lh) = w1;
    }
}

DI void wave_scan128(const float* v, float* out, bool reverse, int lane) {
    const float v0 = v[2 * lane], v1 = v[2 * lane + 1];
    float s = v0 + v1;
#pragma unroll
    for (int o = 1; o < 64; o <<= 1) { float t = __shfl_up(s, o); if (lane >= o) s += t; }
    const float total = __shfl(s, 63);
    if (!reverse) { out[2 * lane] = s - v1; out[2 * lane + 1] = s; }
    else { out[2 * lane] = total - (s - v0 - v1); out[2 * lane + 1] = total - (s - v1); }
}
DI int chunk_row0(int b, int cidx) { return cidx < 2 ? NL + b * CTX + cidx * 128 : b * SEQ + (cidx - 2) * 128; }

DI void ssdA_item(const Params& p, int layer, int it, unsigned char* smem) {
    const int cidx = it % NCHK, hd = (it / NCHK) % 6, b = it / (NCHK * 6), g = hd / 3;
    const int tid = get_tid(), lane = tid & 63, wave = tid >> 6, li = lane & 31, lh = lane >> 5;
    constexpr int TS = 136;
    bf16_t* BT = (bf16_t*)smem;
    bf16_t* XT = BT + 64 * TS;
    float* dtv = (float*)(XT + 64 * TS);
    float* av = dtv + 256;
    float* cum = av + 256;
    const int r0 = chunk_row0(b, cidx);
    const bf16_t* UZ = (const bf16_t*)(p.ws + WS_UZ); const float* DT = (const float*)(p.ws + WS_DT);
    __syncthreads();
    { const int t = tid & 127, d = tid >> 7; const float dt = DT[(size_t)(r0 + t) * 12 + d * 6 + hd]; const float a = -__expf(p.in[I_ALOG][layer * 12 + d * 6 + hd]); dtv[d * 128 + t] = dt; av[d * 128 + t] = dt * a; }
    { bf16x8 sv[4];
#pragma unroll
      for (int q = 0; q < 4; ++q) { const int i = tid + 256 * q, t = i >> 3, c8 = i & 7; sv[q] = ld8(UZ + (size_t)(r0 + t) * 1024 + 384 + g * 64 + c8 * 8); }
#pragma unroll
      for (int q = 0; q < 4; ++q) { const int i = tid + 256 * q, t = i >> 3, c8 = i & 7;
#pragma unroll
        for (int j = 0; j < 8; ++j) BT[(c8 * 8 + j) * TS + t] = (bf16_t)sv[q][j]; } }
    __syncthreads();
    if (wave < 2) wave_scan128(av + wave * 128, cum + wave * 128, wave == 1, lane);
    __syncthreads();
    float* ST = (float*)(p.ws + stbase(layer)); float* DEC = (float*)(p.ws + stbase(layer) + ST_BYTES);
    for (int d = 0; d < 2; ++d) {
        const float total = d == 0 ? cum[127] : cum[128];
        { bf16x8 sv[4];
#pragma unroll
          for (int q = 0; q < 4; ++q) { const int i = tid + 256 * q, t = i >> 3, c8 = i & 7; sv[q] = ld8(UZ + (size_t)(r0 + t) * 1024 + hd * 64 + c8 * 8); }
#pragma unroll
          for (int q = 0; q < 4; ++q) { const int i = tid + 256 * q, t = i >> 3, c8 = i & 7;
            const float w = __expf(total - cum[d * 128 + t]) * dtv[d * 128 + t];
#pragma unroll
            for (int j = 0; j < 8; ++j) XT[(c8 * 8 + j) * TS + t] = f2bf(bf2f((bf16_t)sv[q][j]) * w); } }
        __syncthreads();
        const int pt = wave >> 1, nt = wave & 1;
        f32x16 acc = zero16();
#pragma unroll
        for (int ks = 0; ks < 8; ++ks) acc = MFMA(ld8(XT + (32 * pt + li) * TS + 16 * ks + 8 * lh), ld8(BT + (32 * nt + li) * TS + 16 * ks + 8 * lh), acc);
        float* st = ST + ((((size_t)d * 4 + b) * 6 + hd) * NCHK + cidx) * 4096;
#pragma unroll
        for (int reg = 0; reg < 16; ++reg) st[(32 * pt + crow(reg, lh)) * 64 + 32 * nt + li] = acc[reg];
        if (tid == 0) DEC[(((size_t)d * 4 + b) * 6 + hd) * NCHK + cidx] = __expf(total);
        __syncthreads();
    }
}
DI void hy_rawload(const unsigned* fd, unsigned (&raw)[10]) {
#pragma unroll
    for (int j = 0; j < 5; ++j) { raw[j] = fd[j]; raw[5 + j] = fd[j - 8]; }
}
DI void hy_conv(const bf16_t* ub, const bf16_t* filt, f32x16 (&acc)[2], int nbase, int li, int lh) {
    const int klo = 32 * nbase - 127, khi = 32 * (nbase + 1) + 31;
    const int m0 = 4096 + li - 8 * lh - 7;
    const unsigned sh = (unsigned)(m0 & 1) * 16u;
    const unsigned* fd0 = (const unsigned*)filt + (m0 >> 1);
    unsigned raw[10];
    hy_rawload(fd0 + 16 * klo, raw);
#pragma unroll 4
    for (int k = klo; k <= khi; ++k) {
        u32x4 ua, ub4;
        ua.x = __builtin_amdgcn_alignbit(raw[1], raw[0], sh); ua.y = __builtin_amdgcn_alignbit(raw[2], raw[1], sh); ua.z = __builtin_amdgcn_alignbit(raw[3], raw[2], sh); ua.w = __builtin_amdgcn_alignbit(raw[4], raw[3], sh);
        ub4.x = __builtin_amdgcn_alignbit(raw[6], raw[5], sh); ub4.y = __builtin_amdgcn_alignbit(raw[7], raw[6], sh); ub4.z = __builtin_amdgcn_alignbit(raw[8], raw[7], sh); ub4.w = __builtin_amdgcn_alignbit(raw[9], raw[8], sh);
        const bf16x8 a0 = __builtin_bit_cast(bf16x8, ua), a1 = __builtin_bit_cast(bf16x8, ub4);
        if (k < khi) hy_rawload(fd0 + 16 * (k + 1), raw);
        bf16x8 b0[2], b1[2]; bool use[2];
#pragma unroll
        for (int n = 0; n < 2; ++n) {
            const int nn = nbase + n; use[n] = (k >= 32 * nn - 127) && (k <= 32 * nn + 31);
            const int c = 32 * nn + li - k;
            const bf16_t* up = ub + c * 40 + 8 * lh;
            b0[n] = ld8(up); b1[n] = ld8(up + 16);
        }
#pragma unroll
        for (int n = 0; n < 2; ++n) if (use[n]) { acc[n] = MFMA(a0, b0[n], acc[n]); acc[n] = MFMA(a1, b1[n], acc[n]); }
    }
}
DI u32x4 rev8(u32x4 v) { u32x4 r; r.x = (v.w >> 16) | (v.w << 16); r.y = (v.z >> 16) | (v.z << 16); r.z = (v.y >> 16) | (v.y << 16); r.w = (v.x >> 16) | (v.x << 16); return r; }
DI void hyena_lat_item(const Params& p, int layer, int it, unsigned char* smem) {
    const int ch = it >> 1, bp = it & 1;
    const int tid = get_tid(), lane = tid & 63, wave = tid >> 6, li = lane & 31, lh = lane >> 5;
    const int bl = wave >> 1, nbase = 2 * (wave & 1), bg = 2 * bp + bl;
    constexpr int UB = 192 * 40;
    bf16_t* U = (bf16_t*)smem + 32 * 40;
    bf16_t* Fl = (bf16_t*)smem + 2 * UB;
    float* red = (float*)(Fl + 8192 + 16);
    const bf16_t* P = (const bf16_t*)(p.ws + WS_P); const bf16_t* FL = (const bf16_t*)(p.ws + WS_FL); const float* FP = (const float*)(p.ws + WS_FPL);
    __syncthreads();
    { const int lb = tid & 127, dir = tid >> 7;
      float v0 = wave_sum(FP[lb * 1024 + dir * 512 + ch]), v1 = wave_sum(FP[lb * 1024 + dir * 512 + 256 + ch]);
      if (lane == 0) { red[wave] = v0; red[4 + wave] = v1; } }
    { u32x4 su[4], sf[4];
#pragma unroll
      for (int j = 0; j < 4; ++j) su[j] = *(const u32x4*)(P + (size_t)ch * NT + (size_t)bp * 2 * SEQ + (tid + 256 * j) * 8);
#pragma unroll
      for (int j = 0; j < 4; ++j) sf[j] = *(const u32x4*)(FL + (size_t)(0 * 256 + ch) * 8192 + (tid + 256 * j) * 8);
#pragma unroll
      for (int j = 0; j < 4; ++j) { const int i = tid + 256 * j, b = i >> 9, r = i & 511, blk = r >> 2, q = r & 3; *(u32x4*)(U + b * UB + blk * 40 + q * 8) = rev8(su[j]); }
      { unsigned zz = 0u; asm volatile("" : "+v"(zz)); u32x4 z4; z4.x = zz; z4.y = zz; z4.z = zz; z4.w = zz;
#pragma unroll
        for (int j = 0; j < 3; ++j) { const int i = tid + 256 * j; if (i < 2 * 2 * 32 * 5) { const int b = i / 320, r = i - b * 320, side = r / 160, e = r - side * 160; *(u32x4*)(U + b * UB + (side ? 128 * 40 : -32 * 40) + e * 8) = z4; } } }
#pragma unroll
      for (int j = 0; j < 4; ++j) *(u32x4*)(Fl + (tid + 256 * j) * 8) = sf[j];
      if (tid < 8) ((unsigned*)(Fl + 8192))[tid] = 0u; }
    __syncthreads();
    const float inv0 = 1.f / (red[0] + red[1] + red[2] + red[3] + EPS), inv1 = 1.f / (red[4] + red[5] + red[6] + red[7] + EPS);
    const float d0 = p.in[I_DSH][layer * 512 + ch], d1 = p.in[I_DSH][layer * 512 + 256 + ch];
    bf16_t* ub = U + bl * UB;
    f32x16 acc[2];
    acc[0] = zero16(); acc[1] = zero16();
    hy_conv(ub, Fl, acc, nbase, li, lh);
    __syncthreads();
    { u32x4 sf[4];
#pragma unroll
      for (int j = 0; j < 4; ++j) sf[j] = *(const u32x4*)(FL + (size_t)(1 * 256 + ch) * 8192 + (tid + 256 * j) * 8);
#pragma unroll
      for (int n = 0; n < 2; ++n)
#pragma unroll
        for (int rg = 0; rg < 4; ++rg) {
            const int a = 32 * (nbase + n) + li, ii = 8 * rg + 4 * lh; bf16_t* up = ub + a * 40 + 8 * rg + 4 * (1 - lh);
            const u32x2 zz = *(const u32x2*)up; const u32x2 pp = *(const u32x2*)(P + (size_t)(256 + ch) * NT + bg * SEQ + 32 * a + ii);
            float z[4] = { bf2f((bf16_t)(zz.y >> 16)), bf2f((bf16_t)(zz.y & 0xffff)), bf2f((bf16_t)(zz.x >> 16)), bf2f((bf16_t)(zz.x & 0xffff)) };
            float q[4] = { bf2f((bf16_t)(pp.x & 0xffff)), bf2f((bf16_t)(pp.x >> 16)), bf2f((bf16_t)(pp.y & 0xffff)), bf2f((bf16_t)(pp.y >> 16)) };
            float o[4];
#pragma unroll
            for (int e = 0; e < 4; ++e) o[e] = q[e] * (acc[n][4 * rg + e] * inv0 + z[e] * d0);
            u32x2 w; w.x = pack2(o[3], o[2]); w.y = pack2(o[1], o[0]); *(u32x2*)up = w;
        }
#pragma unroll
      for (int j = 0; j < 4; ++j) *(u32x4*)(Fl + (tid + 256 * j) * 8) = sf[j]; }
    __syncthreads();
    acc[0] = zero16(); acc[1] = zero16();
    hy_conv(ub, Fl, acc, nbase, li, lh);
    bf16_t* HY = (bf16_t*)(p.ws + WS_HYOT);
#pragma unroll
    for (int n = 0; n < 2; ++n)
#pragma unroll
        for (int rg = 0; rg < 4; ++rg) {
            const int a = 32 * (nbase + n) + li, ii = 8 * rg + 4 * lh; const bf16_t* up = ub + a * 40 + 8 * rg + 4 * (1 - lh);
            const u32x2 zz = *(const u32x2*)up; const u32x2 pp = *(const u32x2*)(P + (size_t)(512 + ch) * NT + bg * SEQ + 32 * a + ii);
            float z[4] = { bf2f((bf16_t)(zz.y >> 16)), bf2f((bf16_t)(zz.y & 0xffff)), bf2f((bf16_t)(zz.x >> 16)), bf2f((bf16_t)(zz.x & 0xffff)) };
            float q[4] = { bf2f((bf16_t)(pp.x & 0xffff)), bf2f((bf16_t)(pp.x >> 16)), bf2f((bf16_t)(pp.y & 0xffff)), bf2f((bf16_t)(pp.y >> 16)) };
            float o[4];
#pragma unroll
            for (int e = 0; e < 4; ++e) o[e] = q[e] * (acc[n][4 * rg + e] * inv1 + z[e] * d1);
            u32x2 w; w.x = pack2(o[0], o[1]); w.y = pack2(o[2], o[3]); *(u32x2*)(HY + (size_t)ch * NT + bg * SEQ + 32 * a + ii) = w;
        }
}
DI void hyena_ctx_item(const Params& p, int layer, int ch, unsigned char* smem) {
    const int tid = get_tid();
    float* u = (float*)smem;
    float* f = u + 1024;
    const bf16_t* P = (const bf16_t*)(p.ws + WS_P); const bf16_t* FC = (const bf16_t*)(p.ws + WS_FC); const float* FP = (const float*)(p.ws + WS_FPC);
    bf16_t* HY = (bf16_t*)(p.ws + WS_HYOT);
    __syncthreads();
    float nrm[2] = { 0.f, 0.f };
#pragma unroll
    for (int o = 0; o < 2; ++o) for (int lb = 0; lb < 8; ++lb) nrm[o] += FP[lb * 1024 + o * 256 + ch] + FP[lb * 1024 + 512 + o * 256 + ch];
    for (int i = tid; i < 1024; i += 256) u[i] = bf2f(P[(size_t)ch * NT + NL + i]);
    float zprev[4];
    for (int o = 0; o < 2; ++o) {
        for (int i = tid; i < 512; i += 256) f[i] = bf2f(FC[(size_t)(o * 256 + ch) * 512 + i]);
        __syncthreads();
        float y[4] = { 0.f, 0.f, 0.f, 0.f };
        for (int s = 0; s < 256; ++s) { const float fv = f[256 + tid - s]; y[0] += fv * u[s]; y[1] += fv * u[256 + s]; y[2] += fv * u[512 + s]; y[3] += fv * u[768 + s]; }
        const float inv = 1.f / (nrm[o] + EPS), dsk = p.in[I_DSH][layer * 512 + o * 256 + ch];
#pragma unroll
        for (int b = 0; b < 4; ++b) { const float pv = bf2f(P[(size_t)((o + 1) * 256 + ch) * NT + NL + b * 256 + tid]); zprev[b] = pv * (y[b] * inv + u[b * 256 + tid] * dsk); }
        __syncthreads();
        if (o == 0) {
#pragma unroll
            for (int b = 0; b < 4; ++b) u[b * 256 + tid] = zprev[b]; }
        else {
#pragma unroll
            for (int b = 0; b < 4; ++b) HY[(size_t)ch * NT + NL + b * 256 + tid] = f2bf(zprev[b]); }
        __syncthreads();
    }
}

DI void ssd_scan(const Params& p, int layer) {
    float* ST = (float*)(p.ws + stbase(layer)); const float* DEC = (const float*)(p.ws + stbase(layer) + ST_BYTES);
    const int total = 2 * 4 * 6 * 4096;
    for (int i = blockIdx.x * 256 + get_tid(); i < total; i += gridDim.x * 256) {
        const int e = i & 4095, dbh = i >> 12, d = dbh / 24;
        float* st = ST + (size_t)dbh * NCHK * 4096 + e; const float* dec = DEC + dbh * NCHK;
        float x[NCHK], dc[NCHK];
#pragma unroll
        for (int c = 0; c < NCHK; ++c) { x[c] = st[(size_t)c * 4096]; dc[c] = dec[c]; }
        float s = 0.f;
        if (d == 0) {
#pragma unroll
            for (int c = 0; c < NCHK; ++c) { st[(size_t)c * 4096] = s; s = s * dc[c] + x[c]; } }
        else {
#pragma unroll
            for (int c = 1; c >= 0; --c) { st[(size_t)c * 4096] = s; s = s * dc[c] + x[c]; }
#pragma unroll
            for (int c = NCHK - 1; c >= 2; --c) { st[(size_t)c * 4096] = s; s = s * dc[c] + x[c]; } }
    }
}

DI void ssdC_item(const Params& p, int layer, int it, unsigned char* smem) {
    const int g = it & 1, cidx = (it >> 1) % NCHK, b = it / (2 * NCHK);
    const int tid = get_tid(), lane = tid & 63, wave = tid >> 6, li = lane & 31, lh = lane >> 5;
    constexpr int NS = 72, TS = 136;
    bf16_t* Bn = (bf16_t*)smem;
    bf16_t* Cn = Bn + 128 * NS;
    bf16_t* XT = Cn + 128 * NS;
    float* dtv = (float*)(XT + 64 * TS);
    float* av = dtv + 256;
    float* cum = av + 256;
    const int r0 = chunk_row0(b, cidx);
    const bf16_t* UZ = (const bf16_t*)(p.ws + WS_UZ); const float* DT = (const float*)(p.ws + WS_DT); const float* ST = (const float*)(p.ws + stbase(layer));
    __syncthreads();
    { u32x4 sb[4], sc[4];
#pragma unroll
      for (int q = 0; q < 4; ++q) { const int i = tid + 256 * q, t = i >> 3, c8 = i & 7;
        sb[q] = *(const u32x4*)(UZ + (size_t)(r0 + t) * 1024 + 384 + g * 64 + c8 * 8); sc[q] = *(const u32x4*)(UZ + (size_t)(r0 + t) * 1024 + 512 + g * 64 + c8 * 8); }
#pragma unroll
      for (int q = 0; q < 4; ++q) { const int i = tid + 256 * q, t = i >> 3, c8 = i & 7; *(u32x4*)(Bn + t * NS + c8 * 8) = sb[q]; *(u32x4*)(Cn + t * NS + c8 * 8) = sc[q]; } }
    const int itok = 32 * wave + li;
    float ssq = 0.f;
    bf16_t* orow = (bf16_t*)(p.ws + WS_MIX) + (size_t)(r0 + itok) * 1024 + 384 + g * 192;
#pragma unroll 1
    for (int hh = 0; hh < 3; ++hh) {
        const int hd = g * 3 + hh;
        __syncthreads();
        { const int t = tid & 127, d = tid >> 7; const float dt = DT[(size_t)(r0 + t) * 12 + d * 6 + hd]; const float a = -__expf(p.in[I_ALOG][layer * 12 + d * 6 + hd]); dtv[d * 128 + t] = dt; av[d * 128 + t] = dt * a; }
        { bf16x8 sv[4];
#pragma unroll
          for (int q = 0; q < 4; ++q) { const int i = tid + 256 * q, t = i >> 3, c8 = i & 7; sv[q] = ld8(UZ + (size_t)(r0 + t) * 1024 + hd * 64 + c8 * 8); }
#pragma unroll
          for (int q = 0; q < 4; ++q) { const int i = tid + 256 * q, t = i >> 3, c8 = i & 7;
#pragma unroll
            for (int j = 0; j < 8; ++j) XT[(c8 * 8 + j) * TS + t] = (bf16_t)sv[q][j]; } }
        __syncthreads();
        if (wave < 2) wave_scan128(av + wave * 128, cum + wave * 128, wave == 1, lane);
        __syncthreads();
        f32x16 y0 = zero16(), y1 = zero16();
#pragma unroll 1
        for (int d = 0; d < 2; ++d) {
            const float ci = cum[d * 128 + itok], ei = __expf(ci);
            {
                const float* prev = ST + ((((size_t)d * 4 + b) * 6 + hd) * NCHK + cidx) * 4096;
#pragma unroll
                for (int ks = 0; ks < 4; ++ks) {
                    const f32x4 pa = *(const f32x4*)(prev + (li) * 64 + 16 * ks + 8 * lh), pb = *(const f32x4*)(prev + (li) * 64 + 16 * ks + 8 * lh + 4);
                    const f32x4 pc = *(const f32x4*)(prev + (32 + li) * 64 + 16 * ks + 8 * lh), pd = *(const f32x4*)(prev + (32 + li) * 64 + 16 * ks + 8 * lh + 4);
                    const bf16x8 cr = ld8(Cn + itok * NS + 16 * ks + 8 * lh);
                    const bf16x8 cf = pack8(bf2f((bf16_t)cr[0]) * ei, bf2f((bf16_t)cr[1]) * ei, bf2f((bf16_t)cr[2]) * ei, bf2f((bf16_t)cr[3]) * ei,
                                            bf2f((bf16_t)cr[4]) * ei, bf2f((bf16_t)cr[5]) * ei, bf2f((bf16_t)cr[6]) * ei, bf2f((bf16_t)cr[7]) * ei);
                    y0 = MFMA(pack8(pa.x, pa.y, pa.z, pa.w, pb.x, pb.y, pb.z, pb.w), cf, y0);
                    y1 = MFMA(pack8(pc.x, pc.y, pc.z, pc.w, pd.x, pd.y, pd.z, pd.w), cf, y1);
                }
            }
#pragma unroll 1
            for (int jt = 0; jt < 4; ++jt) {
                if (d == 0 ? (jt > wave) : (jt < wave)) continue;
                f32x16 gt = zero16();
#pragma unroll
                for (int ks = 0; ks < 4; ++ks) gt = MFMA(ld8(Bn + (32 * jt + li) * NS + 16 * ks + 8 * lh), ld8(Cn + itok * NS + 16 * ks + 8 * lh), gt);
#pragma unroll
                for (int r = 0; r < 16; ++r) { const int j = 32 * jt + crow(r, lh); const bool valid = d == 0 ? (j <= itok) : (j >= itok);
                    const float df = fminf(ci - cum[d * 128 + j], 0.f);
                    gt[r] = valid ? gt[r] * __expf(df) * dtv[d * 128 + j] : 0.f; }
                const bf16x8 pf0 = pack8(gt[0], gt[1], gt[2], gt[3], gt[4], gt[5], gt[6], gt[7]), pf1 = pack8(gt[8], gt[9], gt[10], gt[11], gt[12], gt[13], gt[14], gt[15]);
                const bf16_t* xb = XT + li * TS + 32 * jt + 4 * lh;
                y0 = MFMA(ld4x2(xb, xb + 8), pf0, y0); y0 = MFMA(ld4x2(xb + 16, xb + 24), pf1, y0);
                y1 = MFMA(ld4x2(xb + 32 * TS, xb + 32 * TS + 8), pf0, y1); y1 = MFMA(ld4x2(xb + 32 * TS + 16, xb + 32 * TS + 24), pf1, y1);
            }
        }
        const float dsk = p.in[I_DSS][layer * 6 + hd];
        const bf16_t* zrow = UZ + (size_t)(r0 + itok) * 1024 + 640 + hd * 64;
#pragma unroll
        for (int pt = 0; pt < 2; ++pt)
#pragma unroll
            for (int rg = 0; rg < 4; ++rg) {
                const int p0 = 32 * pt + 8 * rg + 4 * lh;
                const u32x2 zz = *(const u32x2*)(zrow + p0);
                const float z[4] = { bf2f((bf16_t)(zz.x & 0xffff)), bf2f((bf16_t)(zz.x >> 16)), bf2f((bf16_t)(zz.y & 0xffff)), bf2f((bf16_t)(zz.y >> 16)) };
                float o[4];
#pragma unroll
                for (int e = 0; e < 4; ++e) { const float yv = (pt ? y1[4 * rg + e] : y0[4 * rg + e]) + bf2f(XT[(p0 + e) * TS + itok]) * dsk; o[e] = yv * silu(z[e]); ssq += o[e] * o[e]; }
                u32x2 w; w.x = pack2(o[0], o[1]); w.y = pack2(o[2], o[3]); *(u32x2*)(orow + hh * 64 + p0) = w;
            }
    }
    ssq += __shfl_xor(ssq, 32);
    const float rstd = 1.f / sqrtf(ssq * (1.f / 192.f) + EPS);
    const float* gn = p.in[I_GSO] + layer * 384 + g * 192;
#pragma unroll 1
    for (int q = 0; q < 24; ++q) {
        const int c = 8 * q + 4 * lh; const u32x2 w = *(const u32x2*)(orow + c); const f32x4 gg = *(const f32x4*)(gn + c);
        u32x2 o; o.x = pack2(bf2f((bf16_t)(w.x & 0xffff)) * rstd * gg.x, bf2f((bf16_t)(w.x >> 16)) * rstd * gg.y);
        o.y = pack2(bf2f((bf16_t)(w.y & 0xffff)) * rstd * gg.z, bf2f((bf16_t)(w.y >> 16)) * rstd * gg.w);
        *(u32x2*)(orow + c) = o;
    }
}

DI int dyn_next(const Params& p, unsigned char* smem, int word) {
    volatile LAS unsigned* st = (volatile LAS unsigned*)(smem + LDS_MAIN);
    __syncthreads();
    if (get_tid() == 0) st[2] = atomicAdd((unsigned*)(p.ws + WS_CTRL) + word, 1u);
    __syncthreads();
    const unsigned v = st[2];
    return v > 0x3fffffffu ? 0x3fffffff : (int)v;
}
#define XCD_TILE_LOOP(MT, NTN, m_, n_) for (int lt_ = (bid >> 3), m_ = 0, n_ = 0; (lt_ < ((MT) >> 3) * (NTN)) && ((m_ = (bid & 7) + 8 * (lt_ / (NTN))), (n_ = lt_ % (NTN)), true); lt_ += (G >> 3))
constexpr int NPHASE = 24, PPL = 12;
DI void run_phase(const Params& p, int ph, unsigned char* smem, int sub = 0) {
    const int layer = ph / PPL, k = ph % PPL, G = gridDim.x, bid = blockIdx.x;
    const float* MOD = (const float*)(p.ws + WS_MOD) + (size_t)layer * 5 * 6144;
    switch (k) {
    case 0: {
        if (layer != 0) break;
        const int n1 = 384, n4 = n1 + WT_IN;
        for (int it = dyn_next(p, smem, 20); it < n4; it = dyn_next(p, smem, 20)) {
            if (it < n1) mod_item(p, it, smem);
            else wprep_item(p, 0, it - n1, smem);
        }
    } break;
    case 1: {
        norm_rows(p, layer, 0, NT, layer == 0);
    } break;
    case 2: {
        bf16_t* PROJ = (bf16_t*)(p.ws + WS_PROJ);
        auto epi = [&](int r, int c, float v, float) { PROJ[(size_t)r * INP + c] = f2bf(v); };
        auto nocol = [&](int, int) { return 0.f; };
        XCD_TILE_LOOP(NT / 128, INP / 128, tm, tn) gemm_tile((const bf16_t*)(p.ws + WS_H), 1024, (const bf16_t*)(p.ws + wbase(layer) + W_IN), 1024, 1024, tm * 128, tn * 128, smem, epi, nocol);
        if (layer == 0) {
            const int n2 = 512, n3 = n2 + 32, n4 = n3 + (WT_TOTAL - WT_IN);
            for (int it = dyn_next(p, smem, 22); it < n4; it = dyn_next(p, smem, 22)) {
                if (it < n2) filt_item<SEQ>(p, 0, it, smem, (bf16_t*)(p.ws + WS_FL), (float*)(p.ws + WS_FPL));
                else if (it < n3) filt_item<CTX>(p, 0, it - n2, smem, (bf16_t*)(p.ws + WS_FC), (float*)(p.ws + WS_FPC));
                else wprep_item(p, 0, WT_IN + (it - n3), smem);
            }
        }
    } break;
    case 3: {
        const int n0 = NT / 128, n1 = n0 + (NT / 128) * 4, n3 = n1 + (NT / 64) * 12;
        for (int it = dyn_next(p, smem, 18 + layer); it < n3; it = dyn_next(p, smem, 18 + layer)) {
            if (it < n0) {
                if (sub == 0 || sub == 2) {
                    for (int q = 0; q < 4; ++q) ssmconv_item(p, layer, 4 * it + q);
                    __threadfence_block(); __syncthreads();
                    const int r0 = it * 128; int b, cidx;
                    if (r0 < NL) { b = r0 >> 12; cidx = 2 + ((r0 & 4095) >> 7); } else { b = (r0 - NL) >> 8; cidx = ((r0 - NL) & 255) >> 7; }
                    for (int hd = 0; hd < 6; ++hd) ssdA_item(p, layer, (b * 6 + hd) * NCHK + cidx, smem);
                }
            }
            else if (it < n1) { if (sub == 0 || sub == 1) qkv_item(p, layer, it - n0, smem); }
            else { if (sub == 0 || sub == 3) hyconv_item(p, layer, it - n1, smem); }
        }
    } break;
    case 4: break;
    case 5: ssd_scan(p, layer); break;
    case 6: {
        const int nH = 512, nA = 4 * 6 * 32, nS = 4 * NCHK * 2, nAc = (layer == 0) ? 4 * 6 * 2 : 0, nHc = (layer == 0) ? 256 : 0;
        const int n1 = nH, n2 = n1 + nA, n3 = n2 + nS, n4 = n3 + nAc, n5 = n4 + nHc;
        unsigned* ctr = (unsigned*)(p.ws + WS_CTRL) + 16 + layer;
        volatile LAS unsigned* st = (volatile LAS unsigned*)(smem + LDS_MAIN);
        for (;;) {
            __syncthreads();
            if (get_tid() == 0) st[2] = sub ? 0xffffffffu : atomicAdd(ctr, 1u);
            __syncthreads();
            const int it = (int)st[2];
            if (it < 0 || it >= n5) break;
            if (it < n1) hyena_lat_item(p, layer, it, smem);
            else if (it < n2) { const int j = it - n1, bh = j >> 5, qt = j & 31; attn_item(p, (const bf16_t*)(p.ws + WS_Q) + (size_t)bh * SEQ * 96, bh, qt * 128, NKEY, (bh / 6) * SEQ, smem); }
            else if (it < n3) { const int j = it - n2, cidx = (j >> 1) % NCHK; if (!(layer == 1 && cidx < 2)) ssdC_item(p, layer, j, smem); }
            else if (it < n4) { const int j = it - n3, bh = j >> 1, qt = j & 1; attn_item(p, (const bf16_t*)(p.ws + WS_QC) + (size_t)bh * CTX * 96, bh, qt * 128, CTX, NL + (bh / 6) * CTX, smem); }
            else hyena_ctx_item(p, layer, it - n4, smem);
        }
    } break;
    case 7: break;
    case 8: {
        const float* xin = p.in[I_X]; const float* cin = p.in[I_CTX]; float* out = p.out; float* XC = (float*)(p.ws + WS_XC);
        auto gate = [&](int m0_, int c) { return MOD[(m0_ < NL ? (m0_ >> 12) : 4) * 6144 + 2048 + c]; };
        auto epi = [&](int r, int c, float v, float ga) {
            if (r < NL) { const size_t o = (size_t)r * 1024 + c; out[o] = (layer == 0 ? xin[o] : out[o]) + ga * v; }
            else { const size_t o = (size_t)(r - NL) * 1024 + c; XC[o] = cin[o] + ga * v; } };
        XCD_TILE_LOOP((layer == 0 ? NT : NL) / 128, 8, tm, tn) gemm_tile((const bf16_t*)(p.ws + WS_MIX), 1024, (const bf16_t*)(p.ws + wbase(layer) + W_OUT), 1024, 1024, tm * 128, tn * 128, smem, epi, gate, (const bf16_t*)(p.ws + WS_HYOT));
        if (layer == 0) {
            const int n1 = 512, n2 = n1 + WT_TOTAL;
            for (int it = dyn_next(p, smem, 21); it < n2; it = dyn_next(p, smem, 21)) {
                if (it < n1) filt_item<SEQ>(p, 1, it, smem, (bf16_t*)(p.ws + WS_FL), (float*)(p.ws + WS_FPL));
                else wprep_item(p, 1, it - n1, smem);
            }
        }
    } break;
    case 9: norm_rows(p, layer, 1, layer == 0 ? NT : NL, false); break;
    case 10: {
        bf16_t* HID = (bf16_t*)(p.ws + WS_HID);
        auto epi = [&](int r, int c, float v, float) { const float a = fmaxf(v, 0.f); HID[(size_t)r * 4096 + c] = f2bf(a * a); };
        auto nocol = [&](int, int) { return 0.f; };
        XCD_TILE_LOOP((layer == 0 ? NT : NL) / 128, 32, tm, tn) gemm_tile((const bf16_t*)(p.ws + WS_H), 1024, (const bf16_t*)(p.ws + wbase(layer) + W_FF1), 1024, 1024, tm * 128, tn * 128, smem, epi, nocol);
    } break;
    case 11: {
        float* out = p.out; float* XC = (float*)(p.ws + WS_XC);
        auto gate = [&](int m0_, int c) { return MOD[(m0_ < NL ? (m0_ >> 12) : 4) * 6144 + 5120 + c]; };
        auto epi = [&](int r, int c, float v, float ga) {
            if (r < NL) out[(size_t)r * 1024 + c] += ga * v;
            else XC[(size_t)(r - NL) * 1024 + c] += ga * v; };
        XCD_TILE_LOOP(NL / 128, 8, tm, tn) gemm_tile((const bf16_t*)(p.ws + WS_HID), 4096, (const bf16_t*)(p.ws + wbase(layer) + W_FF2), 4096, 4096, tm * 128, tn * 128, smem, epi, gate);
        if (layer == 0) {
            auto epa = [&](int r, int c, float v, float ga) { atomicAdd(&XC[(size_t)(r - NL) * 1024 + c], ga * v); };
            for (int it = bid; it < 64 * 8; it += G) { const int tl = it >> 3, ks = it & 7;
                gemm_tile((const bf16_t*)(p.ws + WS_HID) + ks * 512, 4096, (const bf16_t*)(p.ws + wbase(layer) + W_FF2) + ks * 512, 4096, 512, NL + (tl / 8) * 128, (tl % 8) * 128, smem, epa, gate); }
        }
    } break;
    }
}

__global__ void __launch_bounds__(NTHREADS, 2) mega_fwd(Params p, int ph_lo, int ph_hi) {
    extern __shared__ __align__(16) unsigned char smem[];
    volatile LAS unsigned* st = (volatile LAS unsigned*)(smem + LDS_MAIN);
    if (__builtin_amdgcn_workitem_id_x() == 0) { st[0] = 0u; st[1] = 0u; }
    __syncthreads();
    const bool multi = ph_hi - ph_lo > 1;
    XcdBarrier xb; xb.bar = (unsigned*)(p.ws + WS_CTRL); xb.x = 0; xb.st = st;
    if (multi) xb = xcd_barrier_post((unsigned*)(p.ws + WS_CTRL), st);
    if (ph_hi < 0) cg::this_grid().sync();
    for (int ph = ph_lo; ph < ph_hi; ++ph) {
        if (ph == PPL || (ph % PPL) == 7 || (ph % PPL) == 4) continue;
        run_phase(p, ph, smem);
#if REP_MASK
        if ((REP_MASK >> (ph % PPL)) & 1) { xcd_barrier(xb); run_phase(p, ph, smem, PROBE_SUB); }
#endif
        if (ph + 1 < ph_hi) xcd_barrier(xb);
    }
}

extern "C" void kernel_launch(void* const* d_in, const int* in_sizes, int n_in, void* d_out, int out_size, void* d_ws, size_t ws_size, hipStream_t stream) {
    static int grid = 0;
    if (grid == 0) {
        if (n_in != 34 || ws_size < WS_TOTAL) { fprintf(stderr, "kernel_launch: unexpected n_in %d / ws %zu (need %zu)\n", n_in, ws_size, (size_t)WS_TOTAL); grid = -1; return; }
        int dev = 0, cus = 0, per_cu = 0;
        hipGetDevice(&dev);
        hipDeviceGetAttribute(&cus, hipDeviceAttributeMultiprocessorCount, dev);
        hipFuncSetAttribute((const void*)mega_fwd, hipFuncAttributeMaxDynamicSharedMemorySize, LDS_BYTES);
        hipOccupancyMaxActiveBlocksPerMultiprocessor(&per_cu, (const void*)mega_fwd, NTHREADS, LDS_BYTES);
        if (per_cu < 1) per_cu = 1;
        if (per_cu > 2) per_cu = 2;
        grid = cus * per_cu;
        fprintf(stderr, "kernel_launch: cus %d per_cu %d grid %d\n", cus, per_cu, grid);
    }
    if (grid < 0) return;
    Params p{};
    for (int i = 0; i < 34; ++i) p.in[i] = (const float*)d_in[i];
    p.out = (float*)d_out; p.ws = (unsigned char*)d_ws;
#if N_LAUNCH_MODE == 1
    hipMemsetAsync((unsigned char*)d_ws + WS_CTRL, 0, XCD_BAR_WORDS * 4, stream);
    int lo = 0, hi = NPHASE;
    void* args[] = { &p, &lo, &hi };
    hipError_t e = hipLaunchCooperativeKernel((const void*)mega_fwd, dim3(grid), dim3(NTHREADS), args, LDS_BYTES, stream);
    if (e != hipSuccess) fprintf(stderr, "cooperative launch failed: %s (grid %d)\n", hipGetErrorString(e), grid);
#else
    for (int ph = 0; ph < NPHASE; ++ph) { if (ph == PPL) continue; mega_fwd<<<dim3(grid), dim3(NTHREADS), LDS_BYTES, stream>>>(p, ph, ph + 1); }
#endif
}
```

```cpp
#include <hip/hip_runtime.h>
#include <hip/hip_cooperative_groups.h>
#include <cstdio>
#include <cstdint>
namespace cg = cooperative_groups;

#ifndef REP_MASK
#define REP_MASK 0
#endif
#define PROBE_SUB 0
#ifndef N_LAUNCH_MODE
#define N_LAUNCH_MODE 1
#endif

typedef unsigned short bf16_t;
typedef short bf16x8 __attribute__((ext_vector_type(8)));
typedef short s16x4 __attribute__((ext_vector_type(4)));
typedef float f32x16 __attribute__((ext_vector_type(16)));
typedef float f32x4 __attribute__((ext_vector_type(4)));
typedef unsigned u32x4 __attribute__((ext_vector_type(4)));
typedef unsigned u32x2 __attribute__((ext_vector_type(2)));
#define DI __device__ __forceinline__
#define MFMA(a, b, c) __builtin_amdgcn_mfma_f32_32x32x16_bf16((a), (b), (c), 0, 0, 0)

constexpr int D = 1024, NB = 4, SEQ = 4096, CTX = 256;
constexpr int NL = NB * SEQ, NC = NB * CTX, NT = NL + NC;
constexpr int INC = 2220, INP = 2304;
constexpr int O_CQ = 0, O_CKV = 256, O_KR = 384, O_Z = 416, O_XBC = 800, O_DT = 1440, O_HY = 1452;
constexpr int NKEY = CTX + SEQ;
constexpr int NCHK = 34;
constexpr float EPS = 1e-6f;
constexpr int LDS_MAIN = 73728;
constexpr int LDS_BYTES = LDS_MAIN + 16;
constexpr int NTHREADS = 256;

constexpr size_t WS_CTRL = 0;
constexpr size_t WS_MOD = 16384;
constexpr size_t WS_W = WS_MOD + 245760;
constexpr size_t W_IN = 0, W_OUT = W_IN + (size_t)INP * 1024 * 2, W_FF1 = W_OUT + 1024 * 1024 * 2, W_FF2 = W_FF1 + 4096 * 1024 * 2,
                 W_UQ = W_FF2 + 4096 * 1024 * 2, W_UKV = W_UQ + 576 * 256 * 2, W_END = W_UKV + 768 * 128 * 2;
constexpr size_t ST_BYTES = (size_t)2 * 4 * 6 * NCHK * 4096 * 4, WREG = ST_BYTES + 8192;
static_assert(W_END <= WREG, "weight region");
constexpr size_t WS_FL = WS_W + WREG;
constexpr size_t WS_FC = WS_FL + 2 * 256 * 8192 * 2;
constexpr size_t WS_FPL = WS_FC + 2 * 256 * 512 * 2;
constexpr size_t WS_FPC = WS_FPL + 128 * 1024 * 4;
constexpr size_t WS_XC = WS_FPC + 8 * 1024 * 4;
constexpr size_t WS_H = WS_XC + (size_t)NC * 1024 * 4;
constexpr size_t WS_Q = WS_H;
constexpr size_t WS_QC = WS_Q + (size_t)4 * 6 * 4096 * 96 * 2;
constexpr size_t WS_VT = WS_QC + (size_t)4 * 6 * 256 * 96 * 2;
constexpr size_t WS_PROJ = WS_H + (size_t)NT * 1024 * 2;
constexpr size_t WS_ST = WS_PROJ;
constexpr size_t WS_DEC = WS_ST + (size_t)2 * 4 * 6 * NCHK * 4096 * 4;
constexpr size_t WS_HYOT = WS_DEC + 8192;
constexpr size_t WS_MIX = WS_HYOT + (size_t)256 * NT * 2;
constexpr size_t WS_K = WS_PROJ + (size_t)NT * INP * 2;
constexpr size_t WS_UZ = WS_K + (size_t)4 * 6 * NKEY * 96 * 2;
constexpr size_t WS_DT = WS_UZ + (size_t)NT * 1024 * 2;
constexpr size_t WS_P = WS_DT + (size_t)NT * 12 * 4;
constexpr size_t WS_END = WS_P + (size_t)3 * 256 * NT * 2;
constexpr size_t WS_HID = WS_PROJ;
constexpr size_t WS_W2 = WS_END;
constexpr size_t WS_TOTAL = WS_W2 + WREG;
DI size_t wbase(int layer) { return layer ? WS_W2 : WS_W; }
DI size_t stbase(int layer) { return layer ? WS_W : WS_W2; }
static_assert(WS_MIX + (size_t)NT * 1024 * 2 <= WS_K, "alias overflow");
static_assert(WS_VT + (size_t)4 * 6 * 64 * NKEY * 2 <= WS_PROJ, "alias overflow");
static_assert(WS_HID + (size_t)NT * 4096 * 2 <= WS_END, "hid overflow");
static_assert(WS_TOTAL <= 268435456ull, "ws overflow");

struct Params { const float* in[34]; float* out; unsigned char* ws; };
enum { I_X = 0, I_C, I_CTX, I_CCTX, I_WMOD, I_BMOD, I_GMIX, I_GMLP, I_WIN, I_WOUT, I_GCQ, I_GCKV, I_WUQ, I_WUKV, I_GQH, I_GKH,
       I_WCS, I_BCS, I_ALOG, I_DTB, I_DSS, I_GSO, I_WCH, I_BCH, I_WF1, I_BF1, I_FQ1, I_WF2, I_BF2, I_FQ2, I_WF3, I_DSH, I_WFF1, I_WFF2 };

DI int get_tid() { int t = (int)__builtin_amdgcn_workitem_id_x(); asm volatile("" : "+v"(t)); return t; }
DI float bf2f(bf16_t v) { return __uint_as_float(((unsigned)v) << 16); }
DI unsigned pack2(float lo, float hi) { unsigned r; asm("v_cvt_pk_bf16_f32 %0, %1, %2" : "=v"(r) : "v"(lo), "v"(hi)); return r; }
DI bf16_t f2bf(float x) { unsigned r; asm("v_cvt_pk_bf16_f32 %0, %1, %1" : "=v"(r) : "v"(x)); return (bf16_t)r; }
DI int crow(int reg, int h) { return (reg & 3) + 8 * (reg >> 2) + 4 * h; }
DI f32x16 zero16() { f32x16 z; _Pragma("unroll") for (int i = 0; i < 16; ++i) z[i] = 0.f; return z; }
DI bf16x8 pack8(float a0, float a1, float a2, float a3, float a4, float a5, float a6, float a7) {
    u32x4 u; u.x = pack2(a0, a1); u.y = pack2(a2, a3); u.z = pack2(a4, a5); u.w = pack2(a6, a7); return __builtin_bit_cast(bf16x8, u);
}
DI bf16x8 ld8(const bf16_t* p) { return *(const bf16x8*)p; }
DI bf16x8 ld4x2(const bf16_t* p0, const bf16_t* p1) {
    u32x2 a = *(const u32x2*)p0, b = *(const u32x2*)p1; u32x4 u; u.x = a.x; u.y = a.y; u.z = b.x; u.w = b.y; return __builtin_bit_cast(bf16x8, u);
}
DI float xor_red32(float v) { v += __shfl_xor(v, 16); v += __shfl_xor(v, 8); v += __shfl_xor(v, 4); v += __shfl_xor(v, 2); v += __shfl_xor(v, 1); return v; }
DI float wave_sum(float v) { _Pragma("unroll") for (int o = 1; o < 64; o <<= 1) v += __shfl_xor(v, o); return v; }
DI float silu(float x) { return x / (1.f + __expf(-x)); }
DI float softplus(float x) { return fmaxf(x, 0.f) + log1pf(__expf(-fabsf(x))); }


#define XB_TMO      128
#define XB_XCNT(j)  (256  + 64 * (j))
#define XB_XSUB(j)  (1280 + 64 * (j))
#define XB_XGEN(j)  (2304 + 64 * (j))
#define XB_TOP      3328
#define XB_TOPGEN   3392
#define XCD_BAR_WORDS 3456
#define XB_SPIN_CAP (1u << 20)
#define LAS __attribute__((address_space(3)))
DI unsigned xb_ld(unsigned* p)              { return __hip_atomic_load(p, __ATOMIC_RELAXED, __HIP_MEMORY_SCOPE_AGENT); }
DI unsigned xb_add(unsigned* p, unsigned v) { return __hip_atomic_fetch_add(p, v, __ATOMIC_RELAXED, __HIP_MEMORY_SCOPE_AGENT); }
DI unsigned xb_xcc_id() { return (unsigned)__builtin_amdgcn_s_getreg((3 << 11) | 20) & 0xFu; }
#define XB_SPIN(cond, bar) do { unsigned _sp = 0; while (cond) { __builtin_amdgcn_s_sleep(1); \
    if ((++_sp & 255u) == 0u) { if (xb_ld(&(bar)[XB_TMO])) break; if (_sp > XB_SPIN_CAP) { atomicAdd(&(bar)[XB_TMO], 1u); break; } } } } while (0)
struct XcdBarrier { unsigned* bar; unsigned x; volatile LAS unsigned* st; };
DI XcdBarrier xcd_barrier_post(unsigned* bar, volatile LAS unsigned* st) {
    XcdBarrier b; b.bar = bar; b.x = xb_xcc_id(); b.st = st;
    if (__builtin_amdgcn_workitem_id_x() == 0) (void)xb_add(&bar[XB_XCNT(b.x)], 1u);
    return b;
}
DI void xcd_barrier_complete(unsigned* bar, unsigned x, unsigned& nloc, unsigned& nx) {
    const unsigned G = gridDim.x * gridDim.y * gridDim.z;
    unsigned sum, cnt, mine, sp = 0u;
    for (;;) {
        sum = 0u; cnt = 0u; mine = 0u;
#pragma unroll
        for (unsigned j = 0; j < 16; ++j) { const unsigned c = xb_ld(&bar[XB_XCNT(j)]); sum += c; cnt += (c > 0u) ? 1u : 0u; mine = (j == x) ? c : mine; }
        if (sum == G) break;
        __builtin_amdgcn_s_sleep(1);
        if ((++sp & 255u) == 0u) { if (xb_ld(&bar[XB_TMO])) break; if (sp > XB_SPIN_CAP) { atomicAdd(&bar[XB_TMO], 1u); break; } }
    }
    nloc = mine > 0u ? mine : 1u; nx = cnt > 0u ? cnt : 1u;
}
DI void xcd_barrier(const XcdBarrier& b) {
    asm volatile("s_waitcnt vmcnt(0)" ::: "memory");
    __syncthreads();
    if (__builtin_amdgcn_workitem_id_x() == 0) {
        unsigned* bar = b.bar;
        __builtin_amdgcn_s_waitcnt(0);
        unsigned nloc = b.st[0], nx = b.st[1];
        if (nloc == 0u) { xcd_barrier_complete(bar, b.x, nloc, nx); b.st[0] = nloc; b.st[1] = nx; }
        const unsigned old = xb_add(&bar[XB_XSUB(b.x)], 1u);
        const unsigned gen = old / nloc;
        if (old + 1u == (gen + 1u) * nloc) {
            __builtin_amdgcn_fence(__ATOMIC_RELEASE, "agent");
            asm volatile("s_waitcnt vmcnt(0)" ::: "memory");
            const unsigned og = xb_add(&bar[XB_TOP], 1u);
            const unsigned tg = og / nx;
            if (og + 1u == (tg + 1u) * nx) xb_add(&bar[XB_TOPGEN], 1u);
            else XB_SPIN(xb_ld(&bar[XB_TOPGEN]) == tg, bar);
            __builtin_amdgcn_fence(__ATOMIC_ACQUIRE, "agent");
            xb_add(&bar[XB_XGEN(b.x)], 1u);
            asm volatile("s_waitcnt vmcnt(0)" ::: "memory");
        } else {
            XB_SPIN(xb_ld(&bar[XB_XGEN(b.x)]) == gen, bar);
            __builtin_amdgcn_fence(__ATOMIC_ACQUIRE, "agent");
            asm volatile("s_waitcnt vmcnt(0)" ::: "memory");
        }
    }
    __syncthreads();
}

DI void row_info(int r, int& b, int& t, int& L) { if (r < NL) { b = r >> 12; t = r & 4095; L = SEQ; } else { int q = r - NL; b = q >> 8; t = q & 255; L = CTX; } }

template <class Epi, class ColV>
DI void gemm_tile(const bf16_t* __restrict__ A, int lda, const bf16_t* __restrict__ Bt, int ldb, int K, int m0, int n0, unsigned char* smem, Epi epi, ColV colv, const bf16_t* __restrict__ HYT = nullptr) {
    constexpr int LS = 72;
    bf16_t* As = (bf16_t*)smem;
    bf16_t* Bs = As + 2 * 128 * LS;
    const int tid = get_tid(), lane = tid & 63, wave = tid >> 6, wr = wave >> 1, wc = wave & 1, li = lane & 31, lh = lane >> 5;
    f32x16 acc[2][2];
#pragma unroll
    for (int a = 0; a < 2; ++a)
#pragma unroll
        for (int b = 0; b < 2; ++b) acc[a][b] = zero16();
    u32x4 R0[8], R1[8];
    const int nk = K >> 6;
    auto gload = [&](u32x4 (&r)[8], int kt) {
#pragma unroll
        for (int i = 0; i < 4; ++i) { int id = tid + 256 * i, row = id >> 3, kc = id & 7;
            if (HYT && kt >= 12) r[i] = *(const u32x4*)(HYT + (size_t)((kt - 12) * 64 + (id >> 4)) * NT + m0 + (id & 15) * 8);
            else r[i] = *(const u32x4*)(A + (size_t)(m0 + row) * lda + kt * 64 + kc * 8);
            r[4 + i] = *(const u32x4*)(Bt + (size_t)(n0 + row) * ldb + kt * 64 + kc * 8); }
    };
    auto sstore = [&](const u32x4 (&r)[8], int buf, int kt) {
#pragma unroll
        for (int i = 0; i < 4; ++i) { int id = tid + 256 * i, row = id >> 3, kc = id & 7;
            if (HYT && kt >= 12) { const int kk = id >> 4, rr = (id & 15) * 8; bf16_t* d = As + (buf * 128 + rr) * LS + kk; const bf16x8 v = __builtin_bit_cast(bf16x8, r[i]);
#pragma unroll
                for (int e = 0; e < 8; ++e) d[e * LS] = (bf16_t)v[e]; }
            else *(u32x4*)(As + (buf * 128 + row) * LS + kc * 8) = r[i];
            *(u32x4*)(Bs + (buf * 128 + row) * LS + kc * 8) = r[4 + i]; }
    };
    auto step = [&](int kt, u32x4 (&ldset)[8], const u32x4 (&stset)[8]) {
        const int buf = kt & 1;
        if (kt + 2 < nk) gload(ldset, kt + 2);
        const bf16_t* Ab = As + (buf * 128 + 64 * wr + li) * LS + 8 * lh;
        const bf16_t* Bb = Bs + (buf * 128 + 64 * wc + li) * LS + 8 * lh;
        bf16x8 fa[2][2], fb[2][2], ga[2][2], gb[2][2];
#pragma unroll
        for (int k2 = 0; k2 < 2; ++k2) { fa[k2][0] = ld8(Ab + 16 * k2); fa[k2][1] = ld8(Ab + 32 * LS + 16 * k2); fb[k2][0] = ld8(Bb + 16 * k2); fb[k2][1] = ld8(Bb + 32 * LS + 16 * k2); }
        __builtin_amdgcn_sched_barrier(0);
#pragma unroll
        for (int k2 = 0; k2 < 2; ++k2) {
            acc[0][0] = MFMA(fa[k2][0], fb[k2][0], acc[0][0]); acc[0][1] = MFMA(fa[k2][0], fb[k2][1], acc[0][1]);
            acc[1][0] = MFMA(fa[k2][1], fb[k2][0], acc[1][0]); acc[1][1] = MFMA(fa[k2][1], fb[k2][1], acc[1][1]);
        }
#pragma unroll
        for (int k2 = 0; k2 < 2; ++k2) { const int ks = 2 + k2; ga[k2][0] = ld8(Ab + 16 * ks); ga[k2][1] = ld8(Ab + 32 * LS + 16 * ks); gb[k2][0] = ld8(Bb + 16 * ks); gb[k2][1] = ld8(Bb + 32 * LS + 16 * ks); }
#pragma unroll
        for (int k2 = 0; k2 < 2; ++k2) {
            acc[0][0] = MFMA(ga[k2][0], gb[k2][0], acc[0][0]); acc[0][1] = MFMA(ga[k2][0], gb[k2][1], acc[0][1]);
            acc[1][0] = MFMA(ga[k2][1], gb[k2][0], acc[1][0]); acc[1][1] = MFMA(ga[k2][1], gb[k2][1], acc[1][1]);
        }
        if (kt + 1 < nk) sstore(stset, buf ^ 1, kt + 1);
#pragma unroll
        for (int i = 0; i < 8; ++i) { __builtin_amdgcn_sched_group_barrier(0x008, 1, 0); __builtin_amdgcn_sched_group_barrier(0x100, 1, 0); }
#pragma unroll
        for (int i = 0; i < 8; ++i) { __builtin_amdgcn_sched_group_barrier(0x008, 1, 0); __builtin_amdgcn_sched_group_barrier(0x200, 1, 0); }
        __builtin_amdgcn_sched_barrier(0);
        __syncthreads();
    };
    gload(R0, 0); gload(R1, 1);
    sstore(R0, 0, 0); __syncthreads();
    for (int kt = 0; kt < nk; kt += 2) {
        step(kt, R0, R1);
        if (kt + 1 < nk) step(kt + 1, R1, R0);
    }
    const float cv0 = colv(m0, n0 + 64 * wc + li), cv1 = colv(m0, n0 + 64 * wc + 32 + li);
#pragma unroll
    for (int mi = 0; mi < 2; ++mi)
#pragma unroll
        for (int ni = 0; ni < 2; ++ni)
#pragma unroll
            for (int reg = 0; reg < 16; ++reg)
                epi(m0 + 64 * wr + 32 * mi + crow(reg, lh), n0 + 64 * wc + 32 * ni + li, acc[mi][ni][reg], ni ? cv1 : cv0);
}

DI void transpose_f32(const float* __restrict__ src, int ld_src, int Cvalid, bf16_t* __restrict__ dst, int ld_dst, int r0, int c0, const float* rscale, float* tile) {
    const int tid = get_tid();
    float tv[16];
#pragma unroll
    for (int j = 0; j < 16; ++j) { const int i = tid + 256 * j, r = i >> 6, c = i & 63; tv[j] = (c0 + c < Cvalid) ? src[(size_t)(r0 + r) * ld_src + c0 + c] : 0.f; }
#pragma unroll
    for (int j = 0; j < 16; ++j) { const int i = tid + 256 * j, r = i >> 6, c = i & 63; float v = tv[j]; if (rscale) v *= rscale[r0 + r]; tile[r * 65 + c] = v; }
    __syncthreads();
#pragma unroll
    for (int j = 0; j < 16; ++j) { const int i = tid + 256 * j, c = i >> 6, r = i & 63; dst[(size_t)(c0 + c) * ld_dst + r0 + r] = f2bf(tile[r * 65 + c]); }
    __syncthreads();
}
DI void transpose_bf16(const bf16_t* __restrict__ src, int ld_src, bf16_t* __restrict__ dst, int ld_dst, int r0, int c0, float* tile) {
    const int tid = get_tid();
    bf16_t tv[16];
#pragma unroll
    for (int j = 0; j < 16; ++j) { const int i = tid + 256 * j, r = i >> 6, c = i & 63; tv[j] = src[(size_t)(r0 + r) * ld_src + c0 + c]; }
#pragma unroll
    for (int j = 0; j < 16; ++j) { const int i = tid + 256 * j, r = i >> 6, c = i & 63; tile[r * 65 + c] = bf2f(tv[j]); }
    __syncthreads();
#pragma unroll
    for (int j = 0; j < 16; ++j) { const int i = tid + 256 * j, c = i >> 6, r = i & 63; dst[(size_t)(c0 + c) * ld_dst + r0 + r] = f2bf(tile[r * 65 + c]); }
    __syncthreads();
}
constexpr int WT_IN = 16 * 36, WT_OUT = 16 * 16, WT_FF1 = 16 * 64, WT_FF2 = 64 * 16, WT_UQ = 4 * 9, WT_UKV = 2 * 12;
constexpr int WT_TOTAL = WT_IN + WT_OUT + WT_FF1 + WT_FF2 + WT_UQ + WT_UKV;
DI void wprep_item(const Params& p, int layer, int it, unsigned char* smem) {
    float* tile = (float*)smem; bf16_t* W = (bf16_t*)(p.ws + wbase(layer));
    if (it < WT_IN) { int kt = it / 36, nt = it % 36; transpose_f32(p.in[I_WIN] + (size_t)layer * 1024 * INC, INC, INC, (bf16_t*)((unsigned char*)W + W_IN), 1024, kt * 64, nt * 64, nullptr, tile); return; } it -= WT_IN;
    if (it < WT_OUT) { int kt = it / 16, nt = it % 16; transpose_f32(p.in[I_WOUT] + (size_t)layer * 1024 * 1024, 1024, 1024, (bf16_t*)((unsigned char*)W + W_OUT), 1024, kt * 64, nt * 64, nullptr, tile); return; } it -= WT_OUT;
    if (it < WT_FF1) { int kt = it / 64, nt = it % 64; transpose_f32(p.in[I_WFF1] + (size_t)layer * 1024 * 4096, 4096, 4096, (bf16_t*)((unsigned char*)W + W_FF1), 1024, kt * 64, nt * 64, nullptr, tile); return; } it -= WT_FF1;
    if (it < WT_FF2) { int kt = it / 16, nt = it % 16; transpose_f32(p.in[I_WFF2] + (size_t)layer * 4096 * 1024, 1024, 1024, (bf16_t*)((unsigned char*)W + W_FF2), 4096, kt * 64, nt * 64, nullptr, tile); return; } it -= WT_FF2;
    if (it < WT_UQ) { int kt = it / 9, nt = it % 9; transpose_f32(p.in[I_WUQ] + (size_t)layer * 256 * 576, 576, 576, (bf16_t*)((unsigned char*)W + W_UQ), 256, kt * 64, nt * 64, p.in[I_GCQ] + layer * 256, tile); return; } it -= WT_UQ;
    { int kt = it / 12, nt = it % 12; transpose_f32(p.in[I_WUKV] + (size_t)layer * 128 * 768, 768, 768, (bf16_t*)((unsigned char*)W + W_UKV), 128, kt * 64, nt * 64, p.in[I_GCKV] + layer * 128, tile); }
}
DI void mod_item(const Params& p, int it, unsigned char* smem) {
    const int layer = it / 192, c0 = (it % 192) * 32, tid = get_tid();
    float* sl = (float*)smem;
    float* red = sl + 5 * 1024;
#pragma unroll
    for (int j = 0; j < 20; ++j) { const int i = tid + 256 * j, b = i >> 10, k = i & 1023; float v = (b < 4) ? p.in[I_C][b * 1024 + k] : p.in[I_CCTX][k]; sl[i] = silu(v); }
    __syncthreads();
    const int col = tid & 31, kg = tid >> 5;
    const float* W = p.in[I_WMOD] + (size_t)layer * 1024 * 6144 + c0 + col;
    float a0 = 0, a1 = 0, a2 = 0, a3 = 0, a4 = 0;
#pragma unroll 8
    for (int k = kg * 128; k < kg * 128 + 128; ++k) { float w = W[(size_t)k * 6144]; a0 += sl[k] * w; a1 += sl[1024 + k] * w; a2 += sl[2048 + k] * w; a3 += sl[3072 + k] * w; a4 += sl[4096 + k] * w; }
    red[(kg * 5 + 0) * 32 + col] = a0; red[(kg * 5 + 1) * 32 + col] = a1; red[(kg * 5 + 2) * 32 + col] = a2; red[(kg * 5 + 3) * 32 + col] = a3; red[(kg * 5 + 4) * 32 + col] = a4;
    __syncthreads();
    if (tid < 160) { int b = tid >> 5, c = tid & 31; float s = p.in[I_BMOD][layer * 6144 + c0 + c];
#pragma unroll
        for (int g = 0; g < 8; ++g) s += red[(g * 5 + b) * 32 + c];
        ((float*)(p.ws + WS_MOD))[(size_t)(layer * 5 + b) * 6144 + c0 + c] = s; }
    __syncthreads();
}
template <int L>
DI void filt_item(const Params& p, int layer, int it, unsigned char* smem, bf16_t* Fout, float* Part) {
    const int lb = it >> 2, cb = it & 3, tid = get_tid();
    float* feats = (float*)smem;
    float* h1 = feats + 32 * 33;
    float* h2 = h1 + 32 * 64;
    float* w1s = h2 + 32 * 64;
    float* w2s = w1s + 33 * 64;
    {
        const float* w1g = p.in[I_WF1] + layer * 33 * 64; const float* w2g = p.in[I_WF2] + layer * 64 * 64;
        float t1[9], t2[16];
#pragma unroll
        for (int j = 0; j < 9; ++j) { const int i = tid + 256 * j; t1[j] = (i < 33 * 64) ? w1g[i] : 0.f; }
#pragma unroll
        for (int j = 0; j < 16; ++j) t2[j] = w2g[tid + 256 * j];
#pragma unroll
        for (int j = 0; j < 9; ++j) { const int i = tid + 256 * j; if (i < 33 * 64) w1s[i] = t1[j]; }
#pragma unroll
        for (int j = 0; j < 16; ++j) w2s[tid + 256 * j] = t2[j];
    }
    const float wstep = (float)(2.0 * 3.14159265358979323846 / (double)L);
#pragma unroll 1
    for (int i = tid; i < 32 * 33; i += 256) { int lg = i / 33, f = i % 33, lag = lb * 32 + lg; float v;
        if (f == 0) v = (float)lag / (float)(L - 1);
        else { int bi = (f - 1) & 15; float band = 1e-4f + (float)bi * ((15.f - 1e-4f) / 15.f); float ang = band * (wstep * (float)lag); v = (f <= 16) ? cosf(ang) : -sinf(ang); }
        feats[i] = v; }
    __syncthreads();
    const float* w1 = w1s; const float* w2 = w2s;
#pragma unroll 1
    for (int i = tid; i < 2048; i += 256) { int lg = i >> 6, j = i & 63; float s = p.in[I_BF1][layer * 64 + j];
#pragma unroll 3
        for (int f = 0; f < 33; ++f) s += feats[lg * 33 + f] * w1[f * 64 + j];
        h1[i] = sinf(p.in[I_FQ1][layer * 64 + j] * s); }
    __syncthreads();
#pragma unroll 1
    for (int i = tid; i < 2048; i += 256) { int lg = i >> 6, j = i & 63; float s = p.in[I_BF2][layer * 64 + j];
#pragma unroll 4
        for (int f = 0; f < 64; ++f) s += h1[lg * 64 + f] * w2[f * 64 + j];
        h2[i] = sinf(p.in[I_FQ2][layer * 64 + j] * s); }
    __syncthreads();
    const int col = cb * 256 + tid, dir = col >> 9, o = (col >> 8) & 1, ch = col & 255;
    const float* w3 = p.in[I_WF3] + (size_t)layer * 64 * 1024 + col;
    const float d0 = -4.605170185988091f / 1.5f, d1 = -4.605170185988091f / 0.3f;
    const float delta = fabsf(d0 + (float)ch * ((d1 - d0) / 255.f));
    bf16_t* F = Fout + (size_t)(o * 256 + ch) * (2 * L);
    float asum = 0.f;
    float wreg[64];
#pragma unroll
    for (int k = 0; k < 64; ++k) wreg[k] = w3[k * 1024];
#pragma unroll 1
    for (int lg = 0; lg < 32; ++lg) {
        float a0 = 0.f, a1 = 0.f;
#pragma unroll
        for (int k = 0; k < 64; k += 8) { const f32x4 hv = *(const f32x4*)(h2 + lg * 64 + k), hw = *(const f32x4*)(h2 + lg * 64 + k + 4);
            a0 += hv.x * wreg[k] + hv.y * wreg[k + 1] + hv.z * wreg[k + 2] + hv.w * wreg[k + 3];
            a1 += hw.x * wreg[k + 4] + hw.y * wreg[k + 5] + hw.z * wreg[k + 6] + hw.w * wreg[k + 7]; }
        const int lag = lb * 32 + lg; const float t01 = (float)lag / (float)(L - 1); const float v = (a0 + a1) * __expf(-t01 * delta);
        if (dir == 0) { F[L + lag] = f2bf(v); asum += fabsf(v); }
        else { if (lag == 0) F[0] = 0; else { F[L - lag] = f2bf(v); asum += fabsf(v); } }
    }
    Part[lb * 1024 + col] = asum;
    __syncthreads();
}

DI void norm_rows(const Params& p, int layer, int which  , int nrows, bool from_input) {
    const int lane = get_tid() & 63, gw = blockIdx.x * 4 + (get_tid() >> 6), NGW = gridDim.x * 4;
    const float* g = p.in[which ? I_GMLP : I_GMIX] + layer * 1024;
    const float* MOD = (const float*)(p.ws + WS_MOD) + (size_t)layer * 5 * 6144;
    bf16_t* H = (bf16_t*)(p.ws + WS_H);
    for (int r = gw; r < nrows; r += NGW) {
        const float* src; int mb;
        if (r < NL) { src = (from_input ? p.in[I_X] : p.out) + (size_t)r * 1024; mb = r >> 12; }
        else { src = (from_input ? p.in[I_CTX] : (const float*)(p.ws + WS_XC)) + (size_t)(r - NL) * 1024; mb = 4; }
        const float* sh = MOD + mb * 6144 + (which ? 3072 : 0); const float* sc = sh + 1024;
        f32x4 v[4]; float ss = 0.f;
#pragma unroll
        for (int j = 0; j < 4; ++j) { v[j] = *(const f32x4*)(src + 256 * j + 4 * lane); ss += v[j].x * v[j].x + v[j].y * v[j].y + v[j].z * v[j].z + v[j].w * v[j].w; }
        const float rstd = 1.f / sqrtf(wave_sum(ss) * (1.f / 1024.f) + EPS);
#pragma unroll
        for (int j = 0; j < 4; ++j) { const int c = 256 * j + 4 * lane; f32x4 gg = *(const f32x4*)(g + c), s1 = *(const f32x4*)(sc + c), s0 = *(const f32x4*)(sh + c);
            float o0 = v[j].x * rstd * gg.x * (1.f + s1.x) + s0.x, o1 = v[j].y * rstd * gg.y * (1.f + s1.y) + s0.y, o2 = v[j].z * rstd * gg.z * (1.f + s1.z) + s0.z, o3 = v[j].w * rstd * gg.w * (1.f + s1.w) + s0.w;
            u32x2 w; w.x = pack2(o0, o1); w.y = pack2(o2, o3); *(u32x2*)(H + (size_t)r * 1024 + c) = w; }
    }
}

DI void hyconv_item(const Params& p, int layer, int it, unsigned char* smem) {
    const int rt = it / 12, ct = it % 12, r0 = rt * 64, c0 = ct * 64, tid = get_tid();
    float* tile = (float*)smem;
    const bf16_t* PROJ = (const bf16_t*)(p.ws + WS_PROJ);
    int b, t, L; row_info(r0, b, t, L);
    u32x2 hv[5];
#pragma unroll
    for (int j = 0; j < 5; ++j) { const int i = tid + 256 * j, rr = i >> 4, c = (i & 15) * 4, tt = t + rr - 1; hv[j].x = 0u; hv[j].y = 0u;
        if (i < 66 * 16 && tt >= 0 && tt < L) hv[j] = *(const u32x2*)(PROJ + (size_t)(r0 + rr - 1) * INP + O_HY + c0 + c); }
#pragma unroll
    for (int j = 0; j < 5; ++j) { const int i = tid + 256 * j, rr = i >> 4, c = (i & 15) * 4; const u32x2 v = hv[j];
        if (i < 66 * 16) { float* tp = tile + rr * 65 + c; tp[0] = bf2f((bf16_t)(v.x & 0xffff)); tp[1] = bf2f((bf16_t)(v.x >> 16)); tp[2] = bf2f((bf16_t)(v.y & 0xffff)); tp[3] = bf2f((bf16_t)(v.y >> 16)); } }
    const float* w = p.in[I_WCH] + layer * 3 * 768; const float* bb = p.in[I_BCH] + layer * 768;
    bf16_t* P = (bf16_t*)(p.ws + WS_P);
    float* wl = tile + 66 * 65;
    { const int q = tid >> 6, c = tid & 63; wl[tid] = (q == 0) ? bb[c0 + c] : w[(q - 1) * 768 + c0 + c]; }
    __syncthreads();
#pragma unroll
    for (int j = 0; j < 8; ++j) { const int i = tid + 256 * j, c = i >> 5, rp = (i & 31) * 2, cc = c0 + c;
        const float t0 = tile[rp * 65 + c], t1 = tile[(rp + 1) * 65 + c], t2 = tile[(rp + 2) * 65 + c], t3 = tile[(rp + 3) * 65 + c];
        const float bq = wl[c], wa = wl[64 + c], wb = wl[128 + c], wc = wl[192 + c];
        const float v0 = bq + wa * t0 + wb * t1 + wc * t2, v1 = bq + wa * t1 + wb * t2 + wc * t3;
        *(unsigned*)(P + (size_t)cc * NT + r0 + rp) = pack2(v0, v1); }
    __syncthreads();
}
DI void ssmconv_item(const Params& p, int layer, int it, const float* w, const float* bb) {
    const int r0 = it * 32, tid = get_tid();
    const bf16_t* PROJ = (const bf16_t*)(p.ws + WS_PROJ); bf16_t* UZ = (bf16_t*)(p.ws + WS_UZ); float* DT = (float*)(p.ws + WS_DT);
    int b, t0, L; row_info(r0, b, t0, L);
#pragma unroll 1
    for (int j0 = 0; j0 < 10; j0 += 5) {
        bf16x8 xc[5], xp[5], xn[5];
#pragma unroll
        for (int j = 0; j < 5; ++j) { const int i = tid + 256 * (j0 + j), rl = i / 80, c = (i - rl * 80) * 8, t = t0 + rl; const size_t r = r0 + rl;
            const bf16_t* src = PROJ + r * INP + O_XBC + c;
            xc[j] = ld8(src); xp[j] = xc[j]; xn[j] = xc[j];
            if (t > 0) xp[j] = ld8(src - INP);
            if (t < L - 1) xn[j] = ld8(src + INP); }
#pragma unroll
        for (int j = 0; j < 5; ++j) { const int i = tid + 256 * (j0 + j), rl = i / 80, c = (i - rl * 80) * 8, t = t0 + rl; const size_t r = r0 + rl;
            const bool hp = t > 0, hn = t < L - 1;
            const f32x4 b0 = *(const f32x4*)(bb + c), b1 = *(const f32x4*)(bb + c + 4), wa0 = *(const f32x4*)(w + c), wa1 = *(const f32x4*)(w + c + 4),
                        wb0 = *(const f32x4*)(w + 640 + c), wb1 = *(const f32x4*)(w + 640 + c + 4), wc0 = *(const f32x4*)(w + 1280 + c), wc1 = *(const f32x4*)(w + 1280 + c + 4);
            const float bv[8] = { b0.x, b0.y, b0.z, b0.w, b1.x, b1.y, b1.z, b1.w }, w0v[8] = { wa0.x, wa0.y, wa0.z, wa0.w, wa1.x, wa1.y, wa1.z, wa1.w },
                        w1v[8] = { wb0.x, wb0.y, wb0.z, wb0.w, wb1.x, wb1.y, wb1.z, wb1.w }, w2v[8] = { wc0.x, wc0.y, wc0.z, wc0.w, wc1.x, wc1.y, wc1.z, wc1.w };
            float o[8];
#pragma unroll
            for (int e = 0; e < 8; ++e) { float v = bv[e] + w1v[e] * bf2f((bf16_t)xc[j][e]);
                if (hp) v += w0v[e] * bf2f((bf16_t)xp[j][e]);
                if (hn) v += w2v[e] * bf2f((bf16_t)xn[j][e]);
                o[e] = silu(v); }
            *(bf16x8*)(UZ + r * 1024 + c) = pack8(o[0], o[1], o[2], o[3], o[4], o[5], o[6], o[7]); }
    }
    { u32x4 zc[6];
#pragma unroll
      for (int j = 0; j < 6; ++j) { const int i = tid + 256 * j, rl = i / 48, c = (i - rl * 48) * 8; zc[j] = *(const u32x4*)(PROJ + (size_t)(r0 + rl) * INP + O_Z + c); }
#pragma unroll
      for (int j = 0; j < 6; ++j) { const int i = tid + 256 * j, rl = i / 48, c = (i - rl * 48) * 8; *(u32x4*)(UZ + (size_t)(r0 + rl) * 1024 + 640 + c) = zc[j]; } }
    for (int i = tid; i < 32 * 12; i += 256) { const int rl = i / 12, c = i - rl * 12; const size_t r = r0 + rl;
        DT[r * 12 + c] = softplus(bf2f(PROJ[r * INP + O_DT + c]) + p.in[I_DTB][layer * 12 + c]); }
}
DI void qkv_item(const Params& p, int layer, int it, unsigned char* smem) {
    const int tid = get_tid(), lane = tid & 63, wave = tid >> 6, li = lane & 31, lh = lane >> 5;
    const int ug = it & 3, hd0 = 3 * (ug & 1);
    const int rbase = (it >> 2) * 128 + 32 * wave;
    const bf16_t* PROJ = (const bf16_t*)(p.ws + WS_PROJ);
    bf16_t* Ws = (bf16_t*)smem;
    int b, t0, L; row_info(rbase, b, t0, L);
    const bool lat = rbase < NL;
    float cs[16], sn[16];
    {
        const int axis = li >> 4, f = li & 7; const float inv = exp2f(-(float)f * (13.287712379549449f / 8.f));
#pragma unroll
        for (int reg = 0; reg < 16; ++reg) { int t = t0 + crow(reg, lh); float pos = (float)(axis ? (t & 63) : (t >> 6)); const float ang = pos * inv; cs[reg] = __cosf(ang); sn[reg] = __sinf(ang); }
    }
    const bool second = (li >> 3) & 1;
    if (ug < 2) {
        const bf16_t* Wq = (const bf16_t*)(p.ws + wbase(layer) + W_UQ);
        const float* gq = p.in[I_GQH] + layer * 96;
        const bf16_t* arow = PROJ + (size_t)(rbase + li) * INP + O_CQ + 8 * lh;
        float ss = 0.f;
#pragma unroll 1
        for (int kh = 0; kh < 2; ++kh) { bf16x8 a[8];
#pragma unroll
            for (int ks = 0; ks < 8; ++ks) a[ks] = ld8(arow + 128 * kh + 16 * ks);
#pragma unroll
            for (int ks = 0; ks < 8; ++ks) {
#pragma unroll
                for (int j = 0; j < 8; ++j) { float x = bf2f((bf16_t)a[ks][j]); ss += x * x; } } }
        ss += __shfl_xor(ss, 32);
        const float alpha = 1.f / sqrtf(ss * (1.f / 256.f) + EPS);
        float al[16];
#pragma unroll
        for (int reg = 0; reg < 16; ++reg) al[reg] = __shfl(alpha, crow(reg, lh));
        const float g0 = gq[li], g1 = gq[32 + li], g2 = gq[64 + li];
#pragma unroll 1
        for (int hd = hd0; hd < hd0 + 3; ++hd) {
            __syncthreads();
#pragma unroll 1
            for (int jb = 0; jb < 12; jb += 6) { u32x4 sw[6];
#pragma unroll
              for (int j = 0; j < 6; ++j) { const int i = tid + 256 * (jb + j), n = i >> 5, kc = i & 31; sw[j] = *(const u32x4*)(Wq + (size_t)(hd * 96 + n) * 256 + kc * 8); }
#pragma unroll
              for (int j = 0; j < 6; ++j) { const int i = tid + 256 * (jb + j), n = i >> 5, kc = i & 31; *(u32x4*)(Ws + n * 264 + kc * 8) = sw[j]; } }
            __syncthreads();
            f32x16 c0 = zero16(), c1 = zero16(), c2 = zero16();
            const bf16_t* wb = Ws + li * 264 + 8 * lh;
#pragma unroll 1
            for (int kh = 0; kh < 4; ++kh) { bf16x8 a[4];
#pragma unroll
                for (int ks = 0; ks < 4; ++ks) a[ks] = ld8(arow + 64 * kh + 16 * ks);
                __builtin_amdgcn_sched_barrier(0);
#pragma unroll
                for (int ks = 0; ks < 4; ++ks) { const bf16_t* w_ = wb + 64 * kh + 16 * ks;
                    c0 = MFMA(a[ks], ld8(w_), c0); c1 = MFMA(a[ks], ld8(w_ + 32 * 264), c1); c2 = MFMA(a[ks], ld8(w_ + 64 * 264), c2);
                    if ((ks & 1) == 1) __builtin_amdgcn_sched_barrier(0);
                } }
            bf16_t* Qp = lat ? (bf16_t*)(p.ws + WS_Q) + ((size_t)(b * 6 + hd) * SEQ + t0) * 96 : (bf16_t*)(p.ws + WS_QC) + ((size_t)(b * 6 + hd) * CTX + t0) * 96;
#pragma unroll
            for (int reg = 0; reg < 16; ++reg) {
                float s2 = xor_red32(c0[reg] * c0[reg] + c1[reg] * c1[reg] + c2[reg] * c2[reg]);
                const float ar = al[reg], rs = 1.f / sqrtf(ar * ar * s2 * (1.f / 96.f) + EPS), sc = ar * rs;
                float v0 = c0[reg] * sc * g0, v1 = c1[reg] * sc * g1, v2 = c2[reg] * sc * g2;
                float pr = __shfl_xor(v2, 8);
                if (lat) v2 = second ? (v2 * cs[reg] + pr * sn[reg]) : (v2 * cs[reg] - pr * sn[reg]);
                bf16_t* q = Qp + (size_t)crow(reg, lh) * 96;
                q[li] = f2bf(v0); q[32 + li] = f2bf(v1); q[64 + li] = f2bf(v2);
                if ((reg & 3) == 3) __builtin_amdgcn_sched_barrier(0);
            }
        }
        __syncthreads();
    }
    else {
        const bf16_t* Wkv = (const bf16_t*)(p.ws + wbase(layer) + W_UKV);
        const float* gk = p.in[I_GKH] + layer * 96;
        const bf16_t* arow = PROJ + (size_t)(rbase + li) * INP + O_CKV + 8 * lh;
        float ss = 0.f;
        { bf16x8 a[8];
#pragma unroll
          for (int ks = 0; ks < 8; ++ks) a[ks] = ld8(arow + 16 * ks);
#pragma unroll
          for (int ks = 0; ks < 8; ++ks) {
#pragma unroll
            for (int j = 0; j < 8; ++j) { float x = bf2f((bf16_t)a[ks][j]); ss += x * x; } } }
        ss += __shfl_xor(ss, 32);
        const float alpha = 1.f / sqrtf(ss * (1.f / 128.f) + EPS);
        float al[16], krv[16];
#pragma unroll
        for (int reg = 0; reg < 16; ++reg) { al[reg] = __shfl(alpha, crow(reg, lh)); krv[reg] = bf2f(PROJ[(size_t)(rbase + crow(reg, lh)) * INP + O_KR + li]); }
        const float g0 = gk[li], g1 = gk[32 + li], g2 = gk[64 + li];
        const int kbase = lat ? (CTX + t0) : t0;
#pragma unroll 1
        for (int hd = hd0; hd < hd0 + 3; ++hd) {
            __syncthreads();
#pragma unroll 1
            for (int jb = 0; jb < 8; jb += 4) { u32x4 sw[4];
#pragma unroll
              for (int j = 0; j < 4; ++j) { const int i = tid + 256 * (jb + j), n = i >> 4, kc = i & 15; sw[j] = *(const u32x4*)(Wkv + (size_t)(hd * 128 + n) * 128 + kc * 8); }
#pragma unroll
              for (int j = 0; j < 4; ++j) { const int i = tid + 256 * (jb + j), n = i >> 4, kc = i & 15; *(u32x4*)(Ws + n * 136 + kc * 8) = sw[j]; } }
            __syncthreads();
            f32x16 c0 = zero16(), c1 = zero16(), c2 = zero16(), c3 = zero16();
            const bf16_t* wb = Ws + li * 136 + 8 * lh;
#pragma unroll 1
            for (int kh = 0; kh < 2; ++kh) { bf16x8 a[4];
#pragma unroll
                for (int ks = 0; ks < 4; ++ks) a[ks] = ld8(arow + 64 * kh + 16 * ks);
                __builtin_amdgcn_sched_barrier(0);
#pragma unroll
                for (int ks = 0; ks < 4; ++ks) { const bf16_t* w_ = wb + 64 * kh + 16 * ks;
                    c0 = MFMA(a[ks], ld8(w_), c0); c1 = MFMA(a[ks], ld8(w_ + 32 * 136), c1);
                    c2 = MFMA(a[ks], ld8(w_ + 64 * 136), c2); c3 = MFMA(a[ks], ld8(w_ + 96 * 136), c3);
                    __builtin_amdgcn_sched_barrier(0);
                } }
            bf16_t* Kp = (bf16_t*)(p.ws + WS_K) + ((size_t)(b * 6 + hd) * NKEY + kbase) * 96;
            bf16_t* Vp = (bf16_t*)(p.ws + WS_VT) + ((size_t)(b * 6 + hd) * 64) * NKEY + kbase;
#pragma unroll
            for (int reg = 0; reg < 16; ++reg) {
                const float ar = al[reg];
                float s2 = xor_red32(ar * ar * (c0[reg] * c0[reg] + c1[reg] * c1[reg]) + krv[reg] * krv[reg]);
                const float rs = 1.f / sqrtf(s2 * (1.f / 96.f) + EPS);
                float v0 = c0[reg] * ar * rs * g0, v1 = c1[reg] * ar * rs * g1, v2 = krv[reg] * rs * g2;
                float pr = __shfl_xor(v2, 8);
                if (lat) v2 = second ? (v2 * cs[reg] + pr * sn[reg]) : (v2 * cs[reg] - pr * sn[reg]);
                bf16_t* k = Kp + (size_t)crow(reg, lh) * 96;
                k[li] = f2bf(v0); k[32 + li] = f2bf(v1); k[64 + li] = f2bf(v2);
                if ((reg & 3) == 3) __builtin_amdgcn_sched_barrier(0);
            }
#pragma unroll
            for (int rg = 0; rg < 4; ++rg) {
                const int k0 = 8 * rg + 4 * lh;
                u32x2 w0, w1;
                w0.x = pack2(c2[4 * rg] * al[4 * rg], c2[4 * rg + 1] * al[4 * rg + 1]); w0.y = pack2(c2[4 * rg + 2] * al[4 * rg + 2], c2[4 * rg + 3] * al[4 * rg + 3]);
                w1.x = pack2(c3[4 * rg] * al[4 * rg], c3[4 * rg + 1] * al[4 * rg + 1]); w1.y = pack2(c3[4 * rg + 2] * al[4 * rg + 2], c3[4 * rg + 3] * al[4 * rg + 3]);
                *(u32x2*)(Vp + (size_t)li * NKEY + k0) = w0;
                *(u32x2*)(Vp + (size_t)(32 + li) * NKEY + k0) = w1;
            }
        }
        __syncthreads();
    }
}

DI void attn_item(const Params& p, const bf16_t* Qbase  , int bh, int q0, int nkeys, int out_row0, unsigned char* smem) {
    constexpr int KS = 104, VS = 68;
    bf16_t* Ks = (bf16_t*)smem;
    bf16_t* Vs = Ks + 2 * 64 * KS;
    const int tid = get_tid(), lane = tid & 63, wave = tid >> 6, li = lane & 31, lh = lane >> 5;
    const bf16_t* Kg = (const bf16_t*)(p.ws + WS_K) + (size_t)bh * NKEY * 96;
    const bf16_t* Vg = (const bf16_t*)(p.ws + WS_VT) + (size_t)bh * 64 * NKEY;
    bf16x8 qf[6];
#pragma unroll
    for (int ks = 0; ks < 6; ++ks) qf[ks] = ld8(Qbase + (size_t)(q0 + 32 * wave + li) * 96 + 16 * ks + 8 * lh);
    u32x4 rk[3], rv[2];
    auto gload = [&](int kt) {
#pragma unroll
        for (int i = 0; i < 3; ++i) { int id = tid + 256 * i; rk[i] = *(const u32x4*)(Kg + (size_t)kt * 64 * 96 + id * 8); }
#pragma unroll
        for (int i = 0; i < 2; ++i) { int id = tid + 256 * i, v = id >> 3, kc = id & 7; rv[i] = *(const u32x4*)(Vg + (size_t)v * NKEY + kt * 64 + kc * 8); }
    };
    auto sstore = [&](int buf) {
#pragma unroll
        for (int i = 0; i < 3; ++i) { int id = tid + 256 * i, key = id / 12, dc = id - key * 12; *(u32x4*)(Ks + (buf * 64 + key) * KS + dc * 8) = rk[i]; }
#pragma unroll
        for (int i = 0; i < 2; ++i) { int id = tid + 256 * i, v = id >> 3, kc = id & 7; bf16_t* d = Vs + (buf * 64 + v) * VS + kc * 8;
            u32x2 lo, hi; lo.x = rv[i].x; lo.y = rv[i].y; hi.x = rv[i].z; hi.y = rv[i].w; *(u32x2*)d = lo; *(u32x2*)(d + 4) = hi; }
    };
    const int nkt = nkeys >> 6;
    const float scl = 0.10206207261596577f * 1.4426950408889634f;
    f32x16 o0 = zero16(), o1 = zero16(); float m = -1e30f, l = 0.f;
    __syncthreads();
    gload(0); sstore(0); __syncthreads();
    for (int kt = 0; kt < nkt; ++kt) {
        const int buf = kt & 1;
        if (kt + 1 < nkt) gload(kt + 1);
        __builtin_amdgcn_sched_barrier(0);
        f32x16 s0 = zero16(), s1 = zero16();
        const bf16_t* kb = Ks + (buf * 64 + li) * KS + 8 * lh;
#pragma unroll
        for (int ks = 0; ks < 6; ++ks) { s0 = MFMA(ld8(kb + 16 * ks), qf[ks], s0); s1 = MFMA(ld8(kb + 32 * KS + 16 * ks), qf[ks], s1); }
        float mx = fmaxf(s0[0], s1[0]);
#pragma unroll
        for (int r = 1; r < 16; ++r) mx = fmaxf(fmaxf(mx, s0[r]), s1[r]);
        mx = fmaxf(mx, __shfl_xor(mx, 32));
        const float mn = fmaxf(m, mx);
        if (__any(mn > m)) {
            const float corr = __builtin_amdgcn_exp2f((m - mn) * scl);
            l *= corr;
#pragma unroll
            for (int r = 0; r < 16; ++r) { o0[r] *= corr; o1[r] *= corr; }
            m = mn;
        }
        const float nb = -m * scl;
        float sum0 = 0.f, sum1 = 0.f;
#pragma unroll
        for (int r = 0; r < 16; ++r) { s0[r] = __builtin_amdgcn_exp2f(fmaf(s0[r], scl, nb)); s1[r] = __builtin_amdgcn_exp2f(fmaf(s1[r], scl, nb)); sum0 += s0[r]; sum1 += s1[r]; }
        float sum = sum0 + sum1;
        sum += __shfl_xor(sum, 32);
        l += sum;
        bf16x8 pf[2][2];
        pf[0][0] = pack8(s0[0], s0[1], s0[2], s0[3], s0[4], s0[5], s0[6], s0[7]); pf[0][1] = pack8(s0[8], s0[9], s0[10], s0[11], s0[12], s0[13], s0[14], s0[15]);
        pf[1][0] = pack8(s1[0], s1[1], s1[2], s1[3], s1[4], s1[5], s1[6], s1[7]); pf[1][1] = pack8(s1[8], s1[9], s1[10], s1[11], s1[12], s1[13], s1[14], s1[15]);
        const bf16_t* vb = Vs + (buf * 64 + li) * VS + 4 * lh;
#pragma unroll
        for (int j = 0; j < 2; ++j)
#pragma unroll
            for (int s = 0; s < 2; ++s) {
                const int ko = 32 * j + 16 * s;
                o0 = MFMA(ld4x2(vb + ko, vb + ko + 8), pf[j][s], o0);
                o1 = MFMA(ld4x2(vb + 32 * VS + ko, vb + 32 * VS + ko + 8), pf[j][s], o1);
            }
        __builtin_amdgcn_sched_barrier(0);
        if (kt + 1 < nkt) sstore(buf ^ 1);
        __syncthreads();
    }
    const float inv = 1.f / l;
    bf16_t* MIX = (bf16_t*)(p.ws + WS_MIX);
    const int hd = bh % 6;
    bf16_t* orow = MIX + (size_t)(out_row0 + q0 + 32 * wave + li) * 1024 + hd * 64;
#pragma unroll
    for (int rg = 0; rg < 4; ++rg) {
        u32x2 w0, w1;
        w0.x = pack2(o0[4 * rg] * inv, o0[4 * rg + 1] * inv); w0.y = pack2(o0[4 * rg + 2] * inv, o0[4 * rg + 3] * inv);
        w1.x = pack2(o1[4 * rg] * inv, o1[4 * rg + 1] * inv); w1.y = pack2(o1[4 * rg + 2] * inv, o1[4 * rg + 3] * inv);
        *(u32x2*)(orow + 8 * rg + 4 * lh) = w0;
        *(u32x2*)(orow + 32 + 8 * rg + 4 * lh) = w1;
    }
}

DI void wave_scan128(const float* v, float* out, bool reverse, int lane) {
    const float v0 = v[2 * lane], v1 = v[2 * lane + 1];
    float s = v0 + v1;
#pragma unroll
    for (int o = 1; o < 64; o <<= 1) { float t = __shfl_up(s, o); if (lane >= o) s += t; }
    const float total = __shfl(s, 63);
    if (!reverse) { out[2 * lane] = s - v1; out[2 * lane + 1] = s; }
    else { out[2 * lane] = total - (s - v0 - v1); out[2 * lane + 1] = total - (s - v1); }
}
DI int chunk_row0(int b, int cidx) { return cidx < 2 ? NL + b * CTX + cidx * 128 : b * SEQ + (cidx - 2) * 128; }

DI void ssdA_item(const Params& p, int layer, int it, unsigned char* smem) {
    const int cidx = it % NCHK, hd = (it / NCHK) % 6, b = it / (NCHK * 6), g = hd / 3;
    const int tid = get_tid(), lane = tid & 63, wave = tid >> 6, li = lane & 31, lh = lane >> 5;
    constexpr int TS = 136;
    bf16_t* BT = (bf16_t*)smem;
    bf16_t* XT = BT + 64 * TS;
    float* dtv = (float*)(XT + 64 * TS);
    float* av = dtv + 256;
    float* cum = av + 256;
    const int r0 = chunk_row0(b, cidx);
    const bf16_t* UZ = (const bf16_t*)(p.ws + WS_UZ); const float* DT = (const float*)(p.ws + WS_DT);
    __syncthreads();
    { const int t = tid & 127, d = tid >> 7; const float dt = DT[(size_t)(r0 + t) * 12 + d * 6 + hd]; const float a = -__expf(p.in[I_ALOG][layer * 12 + d * 6 + hd]); dtv[d * 128 + t] = dt; av[d * 128 + t] = dt * a; }
    { bf16x8 sv[4];
#pragma unroll
      for (int q = 0; q < 4; ++q) { const int i = tid + 256 * q, t = i >> 3, c8 = i & 7; sv[q] = ld8(UZ + (size_t)(r0 + t) * 1024 + 384 + g * 64 + c8 * 8); }
#pragma unroll
      for (int q = 0; q < 4; ++q) { const int i = tid + 256 * q, t = i >> 3, c8 = i & 7;
#pragma unroll
        for (int j = 0; j < 8; ++j) BT[(c8 * 8 + j) * TS + t] = (bf16_t)sv[q][j]; } }
    __syncthreads();
    if (wave < 2) wave_scan128(av + wave * 128, cum + wave * 128, wave == 1, lane);
    __syncthreads();
    float* ST = (float*)(p.ws + stbase(layer)); float* DEC = (float*)(p.ws + stbase(layer) + ST_BYTES);
    for (int d = 0; d < 2; ++d) {
        const float total = d == 0 ? cum[127] : cum[128];
        { bf16x8 sv[4];
#pragma unroll
          for (int q = 0; q < 4; ++q) { const int i = tid + 256 * q, t = i >> 3, c8 = i & 7; sv[q] = ld8(UZ + (size_t)(r0 + t) * 1024 + hd * 64 + c8 * 8); }
#pragma unroll
          for (int q = 0; q < 4; ++q) { const int i = tid + 256 * q, t = i >> 3, c8 = i & 7;
            const float w = __expf(total - cum[d * 128 + t]) * dtv[d * 128 + t];
#pragma unroll
            for (int j = 0; j < 8; ++j) XT[(c8 * 8 + j) * TS + t] = f2bf(bf2f((bf16_t)sv[q][j]) * w); } }
        __syncthreads();
        const int pt = wave >> 1, nt = wave & 1;
        f32x16 acc = zero16();
#pragma unroll
        for (int ks = 0; ks < 8; ++ks) acc = MFMA(ld8(XT + (32 * pt + li) * TS + 16 * ks + 8 * lh), ld8(BT + (32 * nt + li) * TS + 16 * ks + 8 * lh), acc);
        float* st = ST + ((((size_t)d * 4 + b) * 6 + hd) * NCHK + cidx) * 4096;
#pragma unroll
        for (int reg = 0; reg < 16; ++reg) st[(32 * pt + crow(reg, lh)) * 64 + 32 * nt + li] = acc[reg];
        if (tid == 0) DEC[(((size_t)d * 4 + b) * 6 + hd) * NCHK + cidx] = __expf(total);
        __syncthreads();
    }
}
DI void hy_rawload(const unsigned* fd, unsigned (&raw)[10]) {
#pragma unroll
    for (int j = 0; j < 5; ++j) { raw[j] = fd[j]; raw[5 + j] = fd[j - 8]; }
}
DI void hy_conv(const bf16_t* ub, const bf16_t* filt, f32x16 (&acc)[2], int nbase, int li, int lh) {
    const int klo = 32 * nbase - 127, khi = 32 * (nbase + 1) + 31;
    const int m0 = 4096 + li - 8 * lh - 7;
    const unsigned sh = (unsigned)(m0 & 1) * 16u;
    const unsigned* fd0 = (const unsigned*)filt + (m0 >> 1);
    unsigned raw[10];
    hy_rawload(fd0 + 16 * klo, raw);
#pragma unroll 4
    for (int k = klo; k <= khi; ++k) {
        u32x4 ua, ub4;
        ua.x = __builtin_amdgcn_alignbit(raw[1], raw[0], sh); ua.y = __builtin_amdgcn_alignbit(raw[2], raw[1], sh); ua.z = __builtin_amdgcn_alignbit(raw[3], raw[2], sh); ua.w = __builtin_amdgcn_alignbit(raw[4], raw[3], sh);
        ub4.x = __builtin_amdgcn_alignbit(raw[6], raw[5], sh); ub4.y = __builtin_amdgcn_alignbit(raw[7], raw[6], sh); ub4.z = __builtin_amdgcn_alignbit(raw[8], raw[7], sh); ub4.w = __builtin_amdgcn_alignbit(raw[9], raw[8], sh);
        const bf16x8 a0 = __builtin_bit_cast(bf16x8, ua), a1 = __builtin_bit_cast(bf16x8, ub4);
        if (k < khi) hy_rawload(fd0 + 16 * (k + 1), raw);
        bf16x8 b0[2], b1[2]; bool use[2];
#pragma unroll
        for (int n = 0; n < 2; ++n) {
            const int nn = nbase + n; use[n] = (k >= 32 * nn - 127) && (k <= 32 * nn + 31);
            const int c = 32 * nn + li - k;
            const bf16_t* up = ub + c * 40 + 8 * lh;
            b0[n] = ld8(up); b1[n] = ld8(up + 16);
        }
#pragma unroll
        for (int n = 0; n < 2; ++n) if (use[n]) { acc[n] = MFMA(a0, b0[n], acc[n]); acc[n] = MFMA(a1, b1[n], acc[n]); }
    }
}
DI u32x4 rev8(u32x4 v) { u32x4 r; r.x = (v.w >> 16) | (v.w << 16); r.y = (v.z >> 16) | (v.z << 16); r.z = (v.y >> 16) | (v.y << 16); r.w = (v.x >> 16) | (v.x << 16); return r; }
DI void hyena_lat_item(const Params& p, int layer, int it, unsigned char* smem) {
    const int ch = it >> 1, bp = it & 1;
    const int tid = get_tid(), lane = tid & 63, wave = tid >> 6, li = lane & 31, lh = lane >> 5;
    const int bl = wave >> 1, nbase = 2 * (wave & 1), bg = 2 * bp + bl;
    constexpr int UB = 192 * 40;
    bf16_t* U = (bf16_t*)smem + 32 * 40;
    bf16_t* Fl = (bf16_t*)smem + 2 * UB;
    float* red = (float*)(Fl + 8192 + 16);
    const bf16_t* P = (const bf16_t*)(p.ws + WS_P); const bf16_t* FL = (const bf16_t*)(p.ws + WS_FL); const float* FP = (const float*)(p.ws + WS_FPL);
    __syncthreads();
    { const int lb = tid & 127, dir = tid >> 7;
      float v0 = wave_sum(FP[lb * 1024 + dir * 512 + ch]), v1 = wave_sum(FP[lb * 1024 + dir * 512 + 256 + ch]);
      if (lane == 0) { red[wave] = v0; red[4 + wave] = v1; } }
    { u32x4 su[4], sf[4];
#pragma unroll
      for (int j = 0; j < 4; ++j) su[j] = *(const u32x4*)(P + (size_t)ch * NT + (size_t)bp * 2 * SEQ + (tid + 256 * j) * 8);
#pragma unroll
      for (int j = 0; j < 4; ++j) sf[j] = *(const u32x4*)(FL + (size_t)(0 * 256 + ch) * 8192 + (tid + 256 * j) * 8);
#pragma unroll
      for (int j = 0; j < 4; ++j) { const int i = tid + 256 * j, b = i >> 9, r = i & 511, blk = r >> 2, q = r & 3; *(u32x4*)(U + b * UB + blk * 40 + q * 8) = rev8(su[j]); }
      { unsigned zz = 0u; asm volatile("" : "+v"(zz)); u32x4 z4; z4.x = zz; z4.y = zz; z4.z = zz; z4.w = zz;
#pragma unroll
        for (int j = 0; j < 3; ++j) { const int i = tid + 256 * j; if (i < 2 * 2 * 32 * 5) { const int b = i / 320, r = i - b * 320, side = r / 160, e = r - side * 160; *(u32x4*)(U + b * UB + (side ? 128 * 40 : -32 * 40) + e * 8) = z4; } } }
#pragma unroll
      for (int j = 0; j < 4; ++j) *(u32x4*)(Fl + (tid + 256 * j) * 8) = sf[j];
      if (tid < 8) ((unsigned*)(Fl + 8192))[tid] = 0u; }
    __syncthreads();
    const float inv0 = 1.f / (red[0] + red[1] + red[2] + red[3] + EPS), inv1 = 1.f / (red[4] + red[5] + red[6] + red[7] + EPS);
    const float d0 = p.in[I_DSH][layer * 512 + ch], d1 = p.in[I_DSH][layer * 512 + 256 + ch];
    bf16_t* ub = U + bl * UB;
    f32x16 acc[2];
    acc[0] = zero16(); acc[1] = zero16();
    hy_conv(ub, Fl, acc, nbase, li, lh);
    __syncthreads();
    { u32x4 sf[4];
#pragma unroll
      for (int j = 0; j < 4; ++j) sf[j] = *(const u32x4*)(FL + (size_t)(1 * 256 + ch) * 8192 + (tid + 256 * j) * 8);
#pragma unroll
      for (int n = 0; n < 2; ++n)
#pragma unroll
        for (int rg = 0; rg < 4; ++rg) {
            const int a = 32 * (nbase + n) + li, ii = 8 * rg + 4 * lh; bf16_t* up = ub + a * 40 + 8 * rg + 4 * (1 - lh);
            const u32x2 zz = *(const u32x2*)up; const u32x2 pp = *(const u32x2*)(P + (size_t)(256 + ch) * NT + bg * SEQ + 32 * a + ii);
            float z[4] = { bf2f((bf16_t)(zz.y >> 16)), bf2f((bf16_t)(zz.y & 0xffff)), bf2f((bf16_t)(zz.x >> 16)), bf2f((bf16_t)(zz.x & 0xffff)) };
            float q[4] = { bf2f((bf16_t)(pp.x & 0xffff)), bf2f((bf16_t)(pp.x >> 16)), bf2f((bf16_t)(pp.y & 0xffff)), bf2f((bf16_t)(pp.y >> 16)) };
            float o[4];
#pragma unroll
            for (int e = 0; e < 4; ++e) o[e] = q[e] * (acc[n][4 * rg + e] * inv0 + z[e] * d0);
            u32x2 w; w.x = pack2(o[3], o[2]); w.y = pack2(o[1], o[0]); *(u32x2*)up = w;
        }
#pragma unroll
      for (int j = 0; j < 4; ++j) *(u32x4*)(Fl + (tid + 256 * j) * 8) = sf[j]; }
    __syncthreads();
    acc[0] = zero16(); acc[1] = zero16();
    hy_conv(ub, Fl, acc, nbase, li, lh);
    bf16_t* HY = (bf16_t*)(p.ws + WS_HYOT);
#pragma unroll
    for (int n = 0; n < 2; ++n)
#pragma unroll
        for (int rg = 0; rg < 4; ++rg) {
            const int a = 32 * (nbase + n) + li, ii = 8 * rg + 4 * lh; const bf16_t* up = ub + a * 40 + 8 * rg + 4 * (1 - lh);
            const u32x2 zz = *(const u32x2*)up; const u32x2 pp = *(const u32x2*)(P + (size_t)(512 + ch) * NT + bg * SEQ + 32 * a + ii);
            float z[4] = { bf2f((bf16_t)(zz.y >> 16)), bf2f((bf16_t)(zz.y & 0xffff)), bf2f((bf16_t)(zz.x >> 16)), bf2f((bf16_t)(zz.x & 0xffff)) };
            float q[4] = { bf2f((bf16_t)(pp.x & 0xffff)), bf2f((bf16_t)(pp.x >> 16)), bf2f((bf16_t)(pp.y & 0xffff)), bf2f((bf16_t)(pp.y >> 16)) };
            float o[4];
#pragma unroll
            for (int e = 0; e < 4; ++e) o[e] = q[e] * (acc[n][4 * rg + e] * inv1 + z[e] * d1);
            u32x2 w; w.x = pack2(o[0], o[1]); w.y = pack2(o[2], o[3]); *(u32x2*)(HY + (size_t)ch * NT + bg * SEQ + 32 * a + ii) = w;
        }
}
DI void hyena_ctx_item(const Params& p, int layer, int ch, unsigned char* smem) {
    const int tid = get_tid();
    float* u = (float*)smem;
    float* f = u + 1024;
    const bf16_t* P = (const bf16_t*)(p.ws + WS_P); const bf16_t* FC = (const bf16_t*)(p.ws + WS_FC); const float* FP = (const float*)(p.ws + WS_FPC);
    bf16_t* HY = (bf16_t*)(p.ws + WS_HYOT);
    __syncthreads();
    float nrm[2] = { 0.f, 0.f };
#pragma unroll
    for (int o = 0; o < 2; ++o) for (int lb = 0; lb < 8; ++lb) nrm[o] += FP[lb * 1024 + o * 256 + ch] + FP[lb * 1024 + 512 + o * 256 + ch];
    for (int i = tid; i < 1024; i += 256) u[i] = bf2f(P[(size_t)ch * NT + NL + i]);
    float zprev[4];
    for (int o = 0; o < 2; ++o) {
        for (int i = tid; i < 512; i += 256) f[i] = bf2f(FC[(size_t)(o * 256 + ch) * 512 + i]);
        __syncthreads();
        float y[4] = { 0.f, 0.f, 0.f, 0.f };
        for (int s = 0; s < 256; ++s) { const float fv = f[256 + tid - s]; y[0] += fv * u[s]; y[1] += fv * u[256 + s]; y[2] += fv * u[512 + s]; y[3] += fv * u[768 + s]; }
        const float inv = 1.f / (nrm[o] + EPS), dsk = p.in[I_DSH][layer * 512 + o * 256 + ch];
#pragma unroll
        for (int b = 0; b < 4; ++b) { const float pv = bf2f(P[(size_t)((o + 1) * 256 + ch) * NT + NL + b * 256 + tid]); zprev[b] = pv * (y[b] * inv + u[b * 256 + tid] * dsk); }
        __syncthreads();
        if (o == 0) {
#pragma unroll
            for (int b = 0; b < 4; ++b) u[b * 256 + tid] = zprev[b]; }
        else {
#pragma unroll
            for (int b = 0; b < 4; ++b) HY[(size_t)ch * NT + NL + b * 256 + tid] = f2bf(zprev[b]); }
        __syncthreads();
    }
}

DI void ssd_scan(const Params& p, int layer) {
    float* ST = (float*)(p.ws + stbase(layer)); const float* DEC = (const float*)(p.ws + stbase(layer) + ST_BYTES);
    const int total = 2 * 4 * 6 * 4096;
    for (int i = blockIdx.x * 256 + get_tid(); i < total; i += gridDim.x * 256) {
        const int e = i & 4095, dbh = i >> 12, d = dbh / 24;
        float* st = ST + (size_t)dbh * NCHK * 4096 + e; const float* dec = DEC + dbh * NCHK;
        float x[NCHK], dc[NCHK];
#pragma unroll
        for (int c = 0; c < NCHK; ++c) { x[c] = st[(size_t)c * 4096]; dc[c] = dec[c]; }
        float s = 0.f;
        if (d == 0) {
#pragma unroll
            for (int c = 0; c < NCHK; ++c) { st[(size_t)c * 4096] = s; s = s * dc[c] + x[c]; } }
        else {
#pragma unroll
            for (int c = 1; c >= 0; --c) { st[(size_t)c * 4096] = s; s = s * dc[c] + x[c]; }
#pragma unroll
            for (int c = NCHK - 1; c >= 2; --c) { st[(size_t)c * 4096] = s; s = s * dc[c] + x[c]; } }
    }
}

DI void ssdC_item(const Params& p, int layer, int it, unsigned char* smem) {
    const int g = it & 1, cidx = (it >> 1) % NCHK, b = it / (2 * NCHK);
    const int tid = get_tid(), lane = tid & 63, wave = tid >> 6, li = lane & 31, lh = lane >> 5;
    constexpr int NS = 72, TS = 136;
    bf16_t* Bn = (bf16_t*)smem;
    bf16_t* Cn = Bn + 128 * NS;
    bf16_t* XT = Cn + 128 * NS;
    float* dtv = (float*)(XT + 64 * TS);
    float* av = dtv + 256;
    float* cum = av + 256;
    const int r0 = chunk_row0(b, cidx);
    const bf16_t* UZ = (const bf16_t*)(p.ws + WS_UZ); const float* DT = (const float*)(p.ws + WS_DT); const float* ST = (const float*)(p.ws + stbase(layer));
    __syncthreads();
    { u32x4 sb[4], sc[4];
#pragma unroll
      for (int q = 0; q < 4; ++q) { const int i = tid + 256 * q, t = i >> 3, c8 = i & 7;
        sb[q] = *(const u32x4*)(UZ + (size_t)(r0 + t) * 1024 + 384 + g * 64 + c8 * 8); sc[q] = *(const u32x4*)(UZ + (size_t)(r0 + t) * 1024 + 512 + g * 64 + c8 * 8); }
#pragma unroll
      for (int q = 0; q < 4; ++q) { const int i = tid + 256 * q, t = i >> 3, c8 = i & 7; *(u32x4*)(Bn + t * NS + c8 * 8) = sb[q]; *(u32x4*)(Cn + t * NS + c8 * 8) = sc[q]; } }
    const int itok = 32 * wave + li;
    float ssq = 0.f;
    bf16_t* orow = (bf16_t*)(p.ws + WS_MIX) + (size_t)(r0 + itok) * 1024 + 384 + g * 192;
#pragma unroll 1
    for (int hh = 0; hh < 3; ++hh) {
        const int hd = g * 3 + hh;
        __syncthreads();
        { const int t = tid & 127, d = tid >> 7; const float dt = DT[(size_t)(r0 + t) * 12 + d * 6 + hd]; const float a = -__expf(p.in[I_ALOG][layer * 12 + d * 6 + hd]); dtv[d * 128 + t] = dt; av[d * 128 + t] = dt * a; }
        { bf16x8 sv[4];
#pragma unroll
          for (int q = 0; q < 4; ++q) { const int i = tid + 256 * q, t = i >> 3, c8 = i & 7; sv[q] = ld8(UZ + (size_t)(r0 + t) * 1024 + hd * 64 + c8 * 8); }
#pragma unroll
          for (int q = 0; q < 4; ++q) { const int i = tid + 256 * q, t = i >> 3, c8 = i & 7;
#pragma unroll
            for (int j = 0; j < 8; ++j) XT[(c8 * 8 + j) * TS + t] = (bf16_t)sv[q][j]; } }
        __syncthreads();
        if (wave < 2) wave_scan128(av + wave * 128, cum + wave * 128, wave == 1, lane);
        __syncthreads();
        f32x16 y0 = zero16(), y1 = zero16();
#pragma unroll 1
        for (int d = 0; d < 2; ++d) {
            const float ci = cum[d * 128 + itok], ei = __expf(ci);
            {
                const float* prev = ST + ((((size_t)d * 4 + b) * 6 + hd) * NCHK + cidx) * 4096;
#pragma unroll
                for (int ks = 0; ks < 4; ++ks) {
                    const f32x4 pa = *(const f32x4*)(prev + (li) * 64 + 16 * ks + 8 * lh), pb = *(const f32x4*)(prev + (li) * 64 + 16 * ks + 8 * lh + 4);
                    const f32x4 pc = *(const f32x4*)(prev + (32 + li) * 64 + 16 * ks + 8 * lh), pd = *(const f32x4*)(prev + (32 + li) * 64 + 16 * ks + 8 * lh + 4);
                    const bf16x8 cr = ld8(Cn + itok * NS + 16 * ks + 8 * lh);
                    const bf16x8 cf = pack8(bf2f((bf16_t)cr[0]) * ei, bf2f((bf16_t)cr[1]) * ei, bf2f((bf16_t)cr[2]) * ei, bf2f((bf16_t)cr[3]) * ei,
                                            bf2f((bf16_t)cr[4]) * ei, bf2f((bf16_t)cr[5]) * ei, bf2f((bf16_t)cr[6]) * ei, bf2f((bf16_t)cr[7]) * ei);
                    y0 = MFMA(pack8(pa.x, pa.y, pa.z, pa.w, pb.x, pb.y, pb.z, pb.w), cf, y0);
                    y1 = MFMA(pack8(pc.x, pc.y, pc.z, pc.w, pd.x, pd.y, pd.z, pd.w), cf, y1);
                }
            }
#pragma unroll 1
            for (int jt = 0; jt < 4; ++jt) {
                if (d == 0 ? (jt > wave) : (jt < wave)) continue;
                f32x16 gt = zero16();
#pragma unroll
                for (int ks = 0; ks < 4; ++ks) gt = MFMA(ld8(Bn + (32 * jt + li) * NS + 16 * ks + 8 * lh), ld8(Cn + itok * NS + 16 * ks + 8 * lh), gt);
#pragma unroll
                for (int r = 0; r < 16; ++r) { const int j = 32 * jt + crow(r, lh); const bool valid = d == 0 ? (j <= itok) : (j >= itok);
                    const float df = fminf(ci - cum[d * 128 + j], 0.f);
                    gt[r] = valid ? gt[r] * __expf(df) * dtv[d * 128 + j] : 0.f; }
                const bf16x8 pf0 = pack8(gt[0], gt[1], gt[2], gt[3], gt[4], gt[5], gt[6], gt[7]), pf1 = pack8(gt[8], gt[9], gt[10], gt[11], gt[12], gt[13], gt[14], gt[15]);
                const bf16_t* xb = XT + li * TS + 32 * jt + 4 * lh;
                y0 = MFMA(ld4x2(xb, xb + 8), pf0, y0); y0 = MFMA(ld4x2(xb + 16, xb + 24), pf1, y0);
                y1 = MFMA(ld4x2(xb + 32 * TS, xb + 32 * TS + 8), pf0, y1); y1 = MFMA(ld4x2(xb + 32 * TS + 16, xb + 32 * TS + 24), pf1, y1);
            }
        }
        const float dsk = p.in[I_DSS][layer * 6 + hd];
        const bf16_t* zrow = UZ + (size_t)(r0 + itok) * 1024 + 640 + hd * 64;
#pragma unroll
        for (int pt = 0; pt < 2; ++pt)
#pragma unroll
            for (int rg = 0; rg < 4; ++rg) {
                const int p0 = 32 * pt + 8 * rg + 4 * lh;
                const u32x2 zz = *(const u32x2*)(zrow + p0);
                const float z[4] = { bf2f((bf16_t)(zz.x & 0xffff)), bf2f((bf16_t)(zz.x >> 16)), bf2f((bf16_t)(zz.y & 0xffff)), bf2f((bf16_t)(zz.y >> 16)) };
                float o[4];
#pragma unroll
                for (int e = 0; e < 4; ++e) { const float yv = (pt ? y1[4 * rg + e] : y0[4 * rg + e]) + bf2f(XT[(p0 + e) * TS + itok]) * dsk; o[e] = yv * silu(z[e]); ssq += o[e] * o[e]; }
                u32x2 w; w.x = pack2(o[0], o[1]); w.y = pack2(o[2], o[3]); *(u32x2*)(orow + hh * 64 + p0) = w;
            }
    }
    ssq += __shfl_xor(ssq, 32);
    const float rstd = 1.f / sqrtf(ssq * (1.f / 192.f) + EPS);
    const float* gn = p.in[I_GSO] + layer * 384 + g * 192;
#pragma unroll 1
    for (int q = 0; q < 24; ++q) {
        const int c = 8 * q + 4 * lh; const u32x2 w = *(const u32x2*)(orow + c); const f32x4 gg = *(const f32x4*)(gn + c);
        u32x2 o; o.x = pack2(bf2f((bf16_t)(w.x & 0xffff)) * rstd * gg.x, bf2f((bf16_t)(w.x >> 16)) * rstd * gg.y);
        o.y = pack2(bf2f((bf16_t)(w.y & 0xffff)) * rstd * gg.z, bf2f((bf16_t)(w.y >> 16)) * rstd * gg.w);
        *(u32x2*)(orow + c) = o;
    }
}

DI int dyn_next(const Params& p, unsigned char* smem, int word) {
    volatile LAS unsigned* st = (volatile LAS unsigned*)(smem + LDS_MAIN);
    __syncthreads();
    if (get_tid() == 0) st[2] = atomicAdd((unsigned*)(p.ws + WS_CTRL) + word, 1u);
    __syncthreads();
    const unsigned v = st[2];
    return v > 0x3fffffffu ? 0x3fffffff : (int)v;
}
#define XCD_TILE_LOOP(MT, NTN, m_, n_) for (int lt_ = (bid >> 3), m_ = 0, n_ = 0; (lt_ < ((MT) >> 3) * (NTN)) && ((m_ = (bid & 7) + 8 * (lt_ / (NTN))), (n_ = lt_ % (NTN)), true); lt_ += (G >> 3))
constexpr int NPHASE = 24, PPL = 12;
DI void run_phase(const Params& p, int ph, unsigned char* smem, int sub = 0) {
    const int layer = ph / PPL, k = ph % PPL, G = gridDim.x, bid = blockIdx.x;
    const float* MOD = (const float*)(p.ws + WS_MOD) + (size_t)layer * 5 * 6144;
    switch (k) {
    case 0: {
        if (layer != 0) break;
        const int n1 = 384, n4 = n1 + WT_IN;
        for (int it = dyn_next(p, smem, 20); it < n4; it = dyn_next(p, smem, 20)) {
            if (it < n1) mod_item(p, it, smem);
            else wprep_item(p, 0, it - n1, smem);
        }
    } break;
    case 1: {
        norm_rows(p, layer, 0, NT, layer == 0);
    } break;
    case 2: {
        bf16_t* PROJ = (bf16_t*)(p.ws + WS_PROJ);
        auto epi = [&](int r, int c, float v, float) { PROJ[(size_t)r * INP + c] = f2bf(v); };
        auto nocol = [&](int, int) { return 0.f; };
        XCD_TILE_LOOP(NT / 128, INP / 128, tm, tn) gemm_tile((const bf16_t*)(p.ws + WS_H), 1024, (const bf16_t*)(p.ws + wbase(layer) + W_IN), 1024, 1024, tm * 128, tn * 128, smem, epi, nocol);
        if (layer == 0) {
            const int n2 = 512, n3 = n2 + 32, n4 = n3 + (WT_TOTAL - WT_IN);
            for (int it = dyn_next(p, smem, 22); it < n4; it = dyn_next(p, smem, 22)) {
                if (it < n2) filt_item<SEQ>(p, 0, it, smem, (bf16_t*)(p.ws + WS_FL), (float*)(p.ws + WS_FPL));
                else if (it < n3) filt_item<CTX>(p, 0, it - n2, smem, (bf16_t*)(p.ws + WS_FC), (float*)(p.ws + WS_FPC));
                else wprep_item(p, 0, WT_IN + (it - n3), smem);
            }
        }
    } break;
    case 3: {
        const int n0 = NT / 128, n1 = n0 + (NT / 128) * 4, n3 = n1 + (NT / 64) * 12;
        for (int it = dyn_next(p, smem, 18 + layer); it < n3; it = dyn_next(p, smem, 18 + layer)) {
            if (it < n0) {
                if (sub == 0 || sub == 2) {
                    float* wl = (float*)smem;
                    __syncthreads();
                    { float tw[10];
#pragma unroll
                      for (int j = 0; j < 10; ++j) { const int i = get_tid() + 256 * j; tw[j] = (i < 1920) ? p.in[I_WCS][layer * 1920 + i] : p.in[I_BCS][layer * 640 + i - 1920]; }
#pragma unroll
                      for (int j = 0; j < 10; ++j) wl[get_tid() + 256 * j] = tw[j]; }
                    __syncthreads();
                    for (int q = 0; q < 4; ++q) ssmconv_item(p, layer, 4 * it + q, wl, wl + 1920);
                    __threadfence_block(); __syncthreads();
                    const int r0 = it * 128; int b, cidx;
                    if (r0 < NL) { b = r0 >> 12; cidx = 2 + ((r0 & 4095) >> 7); } else { b = (r0 - NL) >> 8; cidx = ((r0 - NL) & 255) >> 7; }
                    for (int hd = 0; hd < 6; ++hd) ssdA_item(p, layer, (b * 6 + hd) * NCHK + cidx, smem);
                }
            }
            else if (it < n1) { if (sub == 0 || sub == 1) qkv_item(p, layer, it - n0, smem); }
            else { if (sub == 0 || sub == 3) hyconv_item(p, layer, it - n1, smem); }
        }
    } break;
    case 4: break;
    case 5: ssd_scan(p, layer); break;
    case 6: {
        const int nH = 512, nA = 4 * 6 * 32, nS = 4 * NCHK * 2, nAc = (layer == 0) ? 4 * 6 * 2 : 0, nHc = (layer == 0) ? 256 : 0;
        const int n1 = nH, n2 = n1 + nA, n3 = n2 + nS, n4 = n3 + nAc, n5 = n4 + nHc;
        unsigned* ctr = (unsigned*)(p.ws + WS_CTRL) + 16 + layer;
        volatile LAS unsigned* st = (volatile LAS unsigned*)(smem + LDS_MAIN);
        for (;;) {
            __syncthreads();
            if (get_tid() == 0) st[2] = sub ? 0xffffffffu : atomicAdd(ctr, 1u);
            __syncthreads();
            const int it = (int)st[2];
            if (it < 0 || it >= n5) break;
            if (it < n1) hyena_lat_item(p, layer, it, smem);
            else if (it < n2) { const int j = it - n1, bh = j >> 5, qt = j & 31; attn_item(p, (const bf16_t*)(p.ws + WS_Q) + (size_t)bh * SEQ * 96, bh, qt * 128, NKEY, (bh / 6) * SEQ, smem); }
            else if (it < n3) { const int j = it - n2, cidx = (j >> 1) % NCHK; if (!(layer == 1 && cidx < 2)) ssdC_item(p, layer, j, smem); }
            else if (it < n4) { const int j = it - n3, bh = j >> 1, qt = j & 1; attn_item(p, (const bf16_t*)(p.ws + WS_QC) + (size_t)bh * CTX * 96, bh, qt * 128, CTX, NL + (bh / 6) * CTX, smem); }
            else hyena_ctx_item(p, layer, it - n4, smem);
        }
    } break;
    case 7: break;
    case 8: {
        const float* xin = p.in[I_X]; const float* cin = p.in[I_CTX]; float* out = p.out; float* XC = (float*)(p.ws + WS_XC);
        auto gate = [&](int m0_, int c) { return MOD[(m0_ < NL ? (m0_ >> 12) : 4) * 6144 + 2048 + c]; };
        auto epi = [&](int r, int c, float v, float ga) {
            if (r < NL) { const size_t o = (size_t)r * 1024 + c; out[o] = (layer == 0 ? xin[o] : out[o]) + ga * v; }
            else { const size_t o = (size_t)(r - NL) * 1024 + c; XC[o] = cin[o] + ga * v; } };
        XCD_TILE_LOOP((layer == 0 ? NT : NL) / 128, 8, tm, tn) gemm_tile((const bf16_t*)(p.ws + WS_MIX), 1024, (const bf16_t*)(p.ws + wbase(layer) + W_OUT), 1024, 1024, tm * 128, tn * 128, smem, epi, gate, (const bf16_t*)(p.ws + WS_HYOT));
        if (layer == 0) {
            const int n1 = 512, n2 = n1 + WT_TOTAL;
            for (int it = dyn_next(p, smem, 21); it < n2; it = dyn_next(p, smem, 21)) {
                if (it < n1) filt_item<SEQ>(p, 1, it, smem, (bf16_t*)(p.ws + WS_FL), (float*)(p.ws + WS_FPL));
                else wprep_item(p, 1, it - n1, smem);
            }
        }
    } break;
    case 9: norm_rows(p, layer, 1, layer == 0 ? NT : NL, false); break;
    case 10: {
        bf16_t* HID = (bf16_t*)(p.ws + WS_HID);
        auto epi = [&](int r, int c, float v, float) { const float a = fmaxf(v, 0.f); HID[(size_t)r * 4096 + c] = f2bf(a * a); };
        auto nocol = [&](int, int) { return 0.f; };
        XCD_TILE_LOOP((layer == 0 ? NT : NL) / 128, 32, tm, tn) gemm_tile((const bf16_t*)(p.ws + WS_H), 1024, (const bf16_t*)(p.ws + wbase(layer) + W_FF1), 1024, 1024, tm * 128, tn * 128, smem, epi, nocol);
    } break;
    case 11: {
        float* out = p.out; float* XC = (float*)(p.ws + WS_XC);
        auto gate = [&](int m0_, int c) { return MOD[(m0_ < NL ? (m0_ >> 12) : 4) * 6144 + 5120 + c]; };
        auto epi = [&](int r, int c, float v, float ga) {
            if (r < NL) out[(size_t)r * 1024 + c] += ga * v;
            else XC[(size_t)(r - NL) * 1024 + c] += ga * v; };
        XCD_TILE_LOOP(NL / 128, 8, tm, tn) gemm_tile((const bf16_t*)(p.ws + WS_HID), 4096, (const bf16_t*)(p.ws + wbase(layer) + W_FF2), 4096, 4096, tm * 128, tn * 128, smem, epi, gate);
        if (layer == 0) {
            auto epa = [&](int r, int c, float v, float ga) { atomicAdd(&XC[(size_t)(r - NL) * 1024 + c], ga * v); };
            for (int it = bid; it < 64 * 8; it += G) { const int tl = it >> 3, ks = it & 7;
                gemm_tile((const bf16_t*)(p.ws + WS_HID) + ks * 512, 4096, (const bf16_t*)(p.ws + wbase(layer) + W_FF2) + ks * 512, 4096, 512, NL + (tl / 8) * 128, (tl % 8) * 128, smem, epa, gate); }
        }
    } break;
    }
}

__global__ void __launch_bounds__(NTHREADS, 2) mega_fwd(Params p, int ph_lo, int ph_hi) {
    extern __shared__ __align__(16) unsigned char smem[];
    volatile LAS unsigned* st = (volatile LAS unsigned*)(smem + LDS_MAIN);
    if (__builtin_amdgcn_workitem_id_x() == 0) { st[0] = 0u; st[1] = 0u; }
    __syncthreads();
    const bool multi = ph_hi - ph_lo > 1;
    XcdBarrier xb; xb.bar = (unsigned*)(p.ws + WS_CTRL); xb.x = 0; xb.st = st;
    if (multi) xb = xcd_barrier_post((unsigned*)(p.ws + WS_CTRL), st);
    if (ph_hi < 0) cg::this_grid().sync();
    for (int ph = ph_lo; ph < ph_hi; ++ph) {
        if (ph == PPL || (ph % PPL) == 7 || (ph % PPL) == 4) continue;
        run_phase(p, ph, smem);
#if REP_MASK
        if ((REP_MASK >> (ph % PPL)) & 1) { xcd_barrier(xb); run_phase(p, ph, smem, PROBE_SUB); }
#endif
        if (ph + 1 < ph_hi) xcd_barrier(xb);
    }
}

extern "C" void kernel_launch(void* const* d_in, const int* in_sizes, int n_in, void* d_out, int out_size, void* d_ws, size_t ws_size, hipStream_t stream) {
    static int grid = 0;
    if (grid == 0) {
        if (n_in != 34 || ws_size < WS_TOTAL) { fprintf(stderr, "kernel_launch: unexpected n_in %d / ws %zu (need %zu)\n", n_in, ws_size, (size_t)WS_TOTAL); grid = -1; return; }
        int dev = 0, cus = 0, per_cu = 0;
        hipGetDevice(&dev);
        hipDeviceGetAttribute(&cus, hipDeviceAttributeMultiprocessorCount, dev);
        hipFuncSetAttribute((const void*)mega_fwd, hipFuncAttributeMaxDynamicSharedMemorySize, LDS_BYTES);
        hipOccupancyMaxActiveBlocksPerMultiprocessor(&per_cu, (const void*)mega_fwd, NTHREADS, LDS_BYTES);
        if (per_cu < 1) per_cu = 1;
        if (per_cu > 2) per_cu = 2;
        grid = cus * per_cu;
        fprintf(stderr, "kernel_launch: cus %d per_cu %d grid %d\n", cus, per_cu, grid);
    }
    if (grid < 0) return;
    Params p{};
    for (int i = 0; i < 34; ++i) p.in[i] = (const float*)d_in[i];
    p.out = (float*)d_out; p.ws = (unsigned char*)d_ws;
#if N_LAUNCH_MODE == 1
    hipMemsetAsync((unsigned char*)d_ws + WS_CTRL, 0, XCD_BAR_WORDS * 4, stream);
    int lo = 0, hi = NPHASE;
    void* args[] = { &p, &lo, &hi };
    hipError_t e = hipLaunchCooperativeKernel((const void*)mega_fwd, dim3(grid), dim3(NTHREADS), args, LDS_BYTES, stream);
    if (e != hipSuccess) fprintf(stderr, "cooperative launch failed: %s (grid %d)\n", hipGetErrorString(e), grid);
#else
    for (int ph = 0; ph < NPHASE; ++ph) { if (ph == PPL) continue; mega_fwd<<<dim3(grid), dim3(NTHREADS), LDS_BYTES, stream>>>(p, ph, ph + 1); }
#endif
}
```

```cpp
#include <hip/hip_runtime.h>
#include <hip/hip_cooperative_groups.h>
#include <cstdio>
#include <cstdint>
namespace cg = cooperative_groups;

#ifndef REP_MASK
#define REP_MASK 0
#endif
#define PROBE_SUB 0
#ifndef N_LAUNCH_MODE
#define N_LAUNCH_MODE 1
#endif

typedef unsigned short bf16_t;
typedef short bf16x8 __attribute__((ext_vector_type(8)));
typedef short s16x4 __attribute__((ext_vector_type(4)));
typedef float f32x16 __attribute__((ext_vector_type(16)));
typedef float f32x4 __attribute__((ext_vector_type(4)));
typedef unsigned u32x4 __attribute__((ext_vector_type(4)));
typedef unsigned u32x2 __attribute__((ext_vector_type(2)));
#define DI __device__ __forceinline__
#define MFMA(a, b, c) __builtin_amdgcn_mfma_f32_32x32x16_bf16((a), (b), (c), 0, 0, 0)

constexpr int D = 1024, NB = 4, SEQ = 4096, CTX = 256;
constexpr int NL = NB * SEQ, NC = NB * CTX, NT = NL + NC;
constexpr int INC = 2220, INP = 2304;
constexpr int O_CQ = 0, O_CKV = 256, O_KR = 384, O_Z = 416, O_XBC = 800, O_DT = 1440, O_HY = 1452;
constexpr int NKEY = CTX + SEQ;
constexpr int NCHK = 34;
constexpr float EPS = 1e-6f;
constexpr int LDS_MAIN = 73728;
constexpr int LDS_BYTES = LDS_MAIN + 16;
constexpr int NTHREADS = 256;

constexpr size_t WS_CTRL = 0;
constexpr size_t WS_MOD = 16384;
constexpr size_t WS_W = WS_MOD + 245760;
constexpr size_t W_IN = 0, W_OUT = W_IN + (size_t)INP * 1024 * 2, W_FF1 = W_OUT + 1024 * 1024 * 2, W_FF2 = W_FF1 + 4096 * 1024 * 2,
                 W_UQ = W_FF2 + 4096 * 1024 * 2, W_UKV = W_UQ + 576 * 256 * 2, W_END = W_UKV + 768 * 128 * 2;
constexpr size_t ST_BYTES = (size_t)2 * 4 * 6 * NCHK * 4096 * 4, WREG = ST_BYTES + 8192;
static_assert(W_END <= WREG, "weight region");
constexpr size_t WS_FL = WS_W + WREG;
constexpr size_t WS_FC = WS_FL + 2 * 256 * 8192 * 2;
constexpr size_t WS_FPL = WS_FC + 2 * 256 * 512 * 2;
constexpr size_t WS_FPC = WS_FPL + 128 * 1024 * 4;
constexpr size_t WS_XC = WS_FPC + 8 * 1024 * 4;
constexpr size_t WS_H = WS_XC + (size_t)NC * 1024 * 4;
constexpr size_t WS_Q = WS_H;
constexpr size_t WS_QC = WS_Q + (size_t)4 * 6 * 4096 * 96 * 2;
constexpr size_t WS_VT = WS_QC + (size_t)4 * 6 * 256 * 96 * 2;
constexpr size_t WS_PROJ = WS_H + (size_t)NT * 1024 * 2;
constexpr size_t WS_ST = WS_PROJ;
constexpr size_t WS_DEC = WS_ST + (size_t)2 * 4 * 6 * NCHK * 4096 * 4;
constexpr size_t WS_HYOT = WS_DEC + 8192;
constexpr size_t WS_MIX = WS_HYOT + (size_t)256 * NT * 2;
constexpr size_t WS_K = WS_PROJ + (size_t)NT * INP * 2;
constexpr size_t WS_UZ = WS_K + (size_t)4 * 6 * NKEY * 96 * 2;
constexpr size_t WS_DT = WS_UZ + (size_t)NT * 1024 * 2;
constexpr size_t WS_P = WS_DT + (size_t)NT * 12 * 4;
constexpr size_t WS_END = WS_P + (size_t)3 * 256 * NT * 2;
constexpr size_t WS_HID = WS_PROJ;
constexpr size_t WS_W2 = WS_END;
constexpr size_t WS_TOTAL = WS_W2 + WREG;
DI size_t wbase(int layer) { return layer ? WS_W2 : WS_W; }
DI size_t stbase(int layer) { return layer ? WS_W : WS_W2; }
static_assert(WS_MIX + (size_t)NT * 1024 * 2 <= WS_K, "alias overflow");
static_assert(WS_VT + (size_t)4 * 6 * 64 * NKEY * 2 <= WS_PROJ, "alias overflow");
static_assert(WS_HID + (size_t)NT * 4096 * 2 <= WS_END, "hid overflow");
static_assert(WS_TOTAL <= 268435456ull, "ws overflow");

struct Params { const float* in[34]; float* out; unsigned char* ws; };
enum { I_X = 0, I_C, I_CTX, I_CCTX, I_WMOD, I_BMOD, I_GMIX, I_GMLP, I_WIN, I_WOUT, I_GCQ, I_GCKV, I_WUQ, I_WUKV, I_GQH, I_GKH,
       I_WCS, I_BCS, I_ALOG, I_DTB, I_DSS, I_GSO, I_WCH, I_BCH, I_WF1, I_BF1, I_FQ1, I_WF2, I_BF2, I_FQ2, I_WF3, I_DSH, I_WFF1, I_WFF2 };

DI int get_tid() { int t = (int)__builtin_amdgcn_workitem_id_x(); asm volatile("" : "+v"(t)); return t; }
DI float bf2f(bf16_t v) { return __uint_as_float(((unsigned)v) << 16); }
DI unsigned pack2(float lo, float hi) { unsigned r; asm("v_cvt_pk_bf16_f32 %0, %1, %2" : "=v"(r) : "v"(lo), "v"(hi)); return r; }
DI bf16_t f2bf(float x) { unsigned r; asm("v_cvt_pk_bf16_f32 %0, %1, %1" : "=v"(r) : "v"(x)); return (bf16_t)r; }
DI int crow(int reg, int h) { return (reg & 3) + 8 * (reg >> 2) + 4 * h; }
DI f32x16 zero16() { f32x16 z; _Pragma("unroll") for (int i = 0; i < 16; ++i) z[i] = 0.f; return z; }
DI bf16x8 pack8(float a0, float a1, float a2, float a3, float a4, float a5, float a6, float a7) {
    u32x4 u; u.x = pack2(a0, a1); u.y = pack2(a2, a3); u.z = pack2(a4, a5); u.w = pack2(a6, a7); return __builtin_bit_cast(bf16x8, u);
}
DI bf16x8 ld8(const bf16_t* p) { return *(const bf16x8*)p; }
DI bf16x8 ld4x2(const bf16_t* p0, const bf16_t* p1) {
    u32x2 a = *(const u32x2*)p0, b = *(const u32x2*)p1; u32x4 u; u.x = a.x; u.y = a.y; u.z = b.x; u.w = b.y; return __builtin_bit_cast(bf16x8, u);
}
DI float xor_red32(float v) { v += __shfl_xor(v, 16); v += __shfl_xor(v, 8); v += __shfl_xor(v, 4); v += __shfl_xor(v, 2); v += __shfl_xor(v, 1); return v; }
DI float wave_sum(float v) { _Pragma("unroll") for (int o = 1; o < 64; o <<= 1) v += __shfl_xor(v, o); return v; }
DI float silu(float x) { return x / (1.f + __expf(-x)); }
DI float softplus(float x) { return fmaxf(x, 0.f) + log1pf(__expf(-fabsf(x))); }


#define XB_TMO      128
#define XB_XCNT(j)  (256  + 64 * (j))
#define XB_XSUB(j)  (1280 + 64 * (j))
#define XB_XGEN(j)  (2304 + 64 * (j))
#define XB_TOP      3328
#define XB_TOPGEN   3392
#define XCD_BAR_WORDS 3456
#define XB_SPIN_CAP (1u << 20)
#define LAS __attribute__((address_space(3)))
DI unsigned xb_ld(unsigned* p)              { return __hip_atomic_load(p, __ATOMIC_RELAXED, __HIP_MEMORY_SCOPE_AGENT); }
DI unsigned xb_add(unsigned* p, unsigned v) { return __hip_atomic_fetch_add(p, v, __ATOMIC_RELAXED, __HIP_MEMORY_SCOPE_AGENT); }
DI unsigned xb_xcc_id() { return (unsigned)__builtin_amdgcn_s_getreg((3 << 11) | 20) & 0xFu; }
#define XB_SPIN(cond, bar) do { unsigned _sp = 0; while (cond) { __builtin_amdgcn_s_sleep(1); \
    if ((++_sp & 255u) == 0u) { if (xb_ld(&(bar)[XB_TMO])) break; if (_sp > XB_SPIN_CAP) { atomicAdd(&(bar)[XB_TMO], 1u); break; } } } } while (0)
struct XcdBarrier { unsigned* bar; unsigned x; volatile LAS unsigned* st; };
DI XcdBarrier xcd_barrier_post(unsigned* bar, volatile LAS unsigned* st) {
    XcdBarrier b; b.bar = bar; b.x = xb_xcc_id(); b.st = st;
    if (__builtin_amdgcn_workitem_id_x() == 0) (void)xb_add(&bar[XB_XCNT(b.x)], 1u);
    return b;
}
DI void xcd_barrier_complete(unsigned* bar, unsigned x, unsigned& nloc, unsigned& nx) {
    const unsigned G = gridDim.x * gridDim.y * gridDim.z;
    unsigned sum, cnt, mine, sp = 0u;
    for (;;) {
        sum = 0u; cnt = 0u; mine = 0u;
#pragma unroll
        for (unsigned j = 0; j < 16; ++j) { const unsigned c = xb_ld(&bar[XB_XCNT(j)]); sum += c; cnt += (c > 0u) ? 1u : 0u; mine = (j == x) ? c : mine; }
        if (sum == G) break;
        __builtin_amdgcn_s_sleep(1);
        if ((++sp & 255u) == 0u) { if (xb_ld(&bar[XB_TMO])) break; if (sp > XB_SPIN_CAP) { atomicAdd(&bar[XB_TMO], 1u); break; } }
    }
    nloc = mine > 0u ? mine : 1u; nx = cnt > 0u ? cnt : 1u;
}
DI void xcd_barrier(const XcdBarrier& b) {
    asm volatile("s_waitcnt vmcnt(0)" ::: "memory");
    __syncthreads();
    if (__builtin_amdgcn_workitem_id_x() == 0) {
        unsigned* bar = b.bar;
        __builtin_amdgcn_s_waitcnt(0);
        unsigned nloc = b.st[0], nx = b.st[1];
        if (nloc == 0u) { xcd_barrier_complete(bar, b.x, nloc, nx); b.st[0] = nloc; b.st[1] = nx; }
        const unsigned old = xb_add(&bar[XB_XSUB(b.x)], 1u);
        const unsigned gen = old / nloc;
        if (old + 1u == (gen + 1u) * nloc) {
            __builtin_amdgcn_fence(__ATOMIC_RELEASE, "agent");
            asm volatile("s_waitcnt vmcnt(0)" ::: "memory");
            const unsigned og = xb_add(&bar[XB_TOP], 1u);
            const unsigned tg = og / nx;
            if (og + 1u == (tg + 1u) * nx) xb_add(&bar[XB_TOPGEN], 1u);
            else XB_SPIN(xb_ld(&bar[XB_TOPGEN]) == tg, bar);
            __builtin_amdgcn_fence(__ATOMIC_ACQUIRE, "agent");
            xb_add(&bar[XB_XGEN(b.x)], 1u);
            asm volatile("s_waitcnt vmcnt(0)" ::: "memory");
        } else {
            XB_SPIN(xb_ld(&bar[XB_XGEN(b.x)]) == gen, bar);
            __builtin_amdgcn_fence(__ATOMIC_ACQUIRE, "agent");
            asm volatile("s_waitcnt vmcnt(0)" ::: "memory");
        }
    }
    __syncthreads();
}

DI void row_info(int r, int& b, int& t, int& L) { if (r < NL) { b = r >> 12; t = r & 4095; L = SEQ; } else { int q = r - NL; b = q >> 8; t = q & 255; L = CTX; } }

template <class Epi, class ColV>
DI void gemm_tile(const bf16_t* __restrict__ A, int lda, const bf16_t* __restrict__ Bt, int ldb, int K, int m0, int n0, unsigned char* smem, Epi epi, ColV colv, const bf16_t* __restrict__ HYT = nullptr) {
    constexpr int LS = 72;
    bf16_t* As = (bf16_t*)smem;
    bf16_t* Bs = As + 2 * 128 * LS;
    const int tid = get_tid(), lane = tid & 63, wave = tid >> 6, wr = wave >> 1, wc = wave & 1, li = lane & 31, lh = lane >> 5;
    f32x16 acc[2][2];
#pragma unroll
    for (int a = 0; a < 2; ++a)
#pragma unroll
        for (int b = 0; b < 2; ++b) acc[a][b] = zero16();
    u32x4 R0[8], R1[8];
    const int nk = K >> 6;
    auto gload = [&](u32x4 (&r)[8], int kt) {
#pragma unroll
        for (int i = 0; i < 4; ++i) { int id = tid + 256 * i, row = id >> 3, kc = id & 7;
            if (HYT && kt >= 12) r[i] = *(const u32x4*)(HYT + (size_t)((kt - 12) * 64 + (id >> 4)) * NT + m0 + (id & 15) * 8);
            else r[i] = *(const u32x4*)(A + (size_t)(m0 + row) * lda + kt * 64 + kc * 8);
            r[4 + i] = *(const u32x4*)(Bt + (size_t)(n0 + row) * ldb + kt * 64 + kc * 8); }
    };
    auto sstore = [&](const u32x4 (&r)[8], int buf, int kt) {
#pragma unroll
        for (int i = 0; i < 4; ++i) { int id = tid + 256 * i, row = id >> 3, kc = id & 7;
            if (HYT && kt >= 12) { const int kk = id >> 4, rr = (id & 15) * 8; bf16_t* d = As + (buf * 128 + rr) * LS + kk; const bf16x8 v = __builtin_bit_cast(bf16x8, r[i]);
#pragma unroll
                for (int e = 0; e < 8; ++e) d[e * LS] = (bf16_t)v[e]; }
            else *(u32x4*)(As + (buf * 128 + row) * LS + kc * 8) = r[i];
            *(u32x4*)(Bs + (buf * 128 + row) * LS + kc * 8) = r[4 + i]; }
    };
    auto step = [&](int kt, u32x4 (&ldset)[8], const u32x4 (&stset)[8]) {
        const int buf = kt & 1;
        if (kt + 2 < nk) gload(ldset, kt + 2);
        const bf16_t* Ab = As + (buf * 128 + 64 * wr + li) * LS + 8 * lh;
        const bf16_t* Bb = Bs + (buf * 128 + 64 * wc + li) * LS + 8 * lh;
        bf16x8 fa[2][2], fb[2][2], ga[2][2], gb[2][2];
#pragma unroll
        for (int k2 = 0; k2 < 2; ++k2) { fa[k2][0] = ld8(Ab + 16 * k2); fa[k2][1] = ld8(Ab + 32 * LS + 16 * k2); fb[k2][0] = ld8(Bb + 16 * k2); fb[k2][1] = ld8(Bb + 32 * LS + 16 * k2); }
        __builtin_amdgcn_sched_barrier(0);
#pragma unroll
        for (int k2 = 0; k2 < 2; ++k2) {
            acc[0][0] = MFMA(fa[k2][0], fb[k2][0], acc[0][0]); acc[0][1] = MFMA(fa[k2][0], fb[k2][1], acc[0][1]);
            acc[1][0] = MFMA(fa[k2][1], fb[k2][0], acc[1][0]); acc[1][1] = MFMA(fa[k2][1], fb[k2][1], acc[1][1]);
        }
#pragma unroll
        for (int k2 = 0; k2 < 2; ++k2) { const int ks = 2 + k2; ga[k2][0] = ld8(Ab + 16 * ks); ga[k2][1] = ld8(Ab + 32 * LS + 16 * ks); gb[k2][0] = ld8(Bb + 16 * ks); gb[k2][1] = ld8(Bb + 32 * LS + 16 * ks); }
#pragma unroll
        for (int k2 = 0; k2 < 2; ++k2) {
            acc[0][0] = MFMA(ga[k2][0], gb[k2][0], acc[0][0]); acc[0][1] = MFMA(ga[k2][0], gb[k2][1], acc[0][1]);
            acc[1][0] = MFMA(ga[k2][1], gb[k2][0], acc[1][0]); acc[1][1] = MFMA(ga[k2][1], gb[k2][1], acc[1][1]);
        }
        if (kt + 1 < nk) sstore(stset, buf ^ 1, kt + 1);
#pragma unroll
        for (int i = 0; i < 8; ++i) { __builtin_amdgcn_sched_group_barrier(0x008, 1, 0); __builtin_amdgcn_sched_group_barrier(0x100, 1, 0); }
#pragma unroll
        for (int i = 0; i < 8; ++i) { __builtin_amdgcn_sched_group_barrier(0x008, 1, 0); __builtin_amdgcn_sched_group_barrier(0x200, 1, 0); }
        __builtin_amdgcn_sched_barrier(0);
        __syncthreads();
    };
    gload(R0, 0); gload(R1, 1);
    sstore(R0, 0, 0); __syncthreads();
    for (int kt = 0; kt < nk; kt += 2) {
        step(kt, R0, R1);
        if (kt + 1 < nk) step(kt + 1, R1, R0);
    }
    const float cv0 = colv(m0, n0 + 64 * wc + li), cv1 = colv(m0, n0 + 64 * wc + 32 + li);
#pragma unroll
    for (int mi = 0; mi < 2; ++mi)
#pragma unroll
        for (int ni = 0; ni < 2; ++ni)
#pragma unroll
            for (int reg = 0; reg < 16; ++reg)
                epi(m0 + 64 * wr + 32 * mi + crow(reg, lh), n0 + 64 * wc + 32 * ni + li, acc[mi][ni][reg], ni ? cv1 : cv0);
}

DI void transpose_f32(const float* __restrict__ src, int ld_src, int Cvalid, bf16_t* __restrict__ dst, int ld_dst, int r0, int c0, const float* rscale, float* tile) {
    const int tid = get_tid();
    float tv[16];
#pragma unroll
    for (int j = 0; j < 16; ++j) { const int i = tid + 256 * j, r = i >> 6, c = i & 63; tv[j] = (c0 + c < Cvalid) ? src[(size_t)(r0 + r) * ld_src + c0 + c] : 0.f; }
#pragma unroll
    for (int j = 0; j < 16; ++j) { const int i = tid + 256 * j, r = i >> 6, c = i & 63; float v = tv[j]; if (rscale) v *= rscale[r0 + r]; tile[r * 65 + c] = v; }
    __syncthreads();
#pragma unroll
    for (int j = 0; j < 16; ++j) { const int i = tid + 256 * j, c = i >> 6, r = i & 63; dst[(size_t)(c0 + c) * ld_dst + r0 + r] = f2bf(tile[r * 65 + c]); }
    __syncthreads();
}
DI void transpose_bf16(const bf16_t* __restrict__ src, int ld_src, bf16_t* __restrict__ dst, int ld_dst, int r0, int c0, float* tile) {
    const int tid = get_tid();
    bf16_t tv[16];
#pragma unroll
    for (int j = 0; j < 16; ++j) { const int i = tid + 256 * j, r = i >> 6, c = i & 63; tv[j] = src[(size_t)(r0 + r) * ld_src + c0 + c]; }
#pragma unroll
    for (int j = 0; j < 16; ++j) { const int i = tid + 256 * j, r = i >> 6, c = i & 63; tile[r * 65 + c] = bf2f(tv[j]); }
    __syncthreads();
#pragma unroll
    for (int j = 0; j < 16; ++j) { const int i = tid + 256 * j, c = i >> 6, r = i & 63; dst[(size_t)(c0 + c) * ld_dst + r0 + r] = f2bf(tile[r * 65 + c]); }
    __syncthreads();
}
constexpr int WT_IN = 16 * 36, WT_OUT = 16 * 16, WT_FF1 = 16 * 64, WT_FF2 = 64 * 16, WT_UQ = 4 * 9, WT_UKV = 2 * 12;
constexpr int WT_TOTAL = WT_IN + WT_OUT + WT_FF1 + WT_FF2 + WT_UQ + WT_UKV;
DI void wprep_item(const Params& p, int layer, int it, unsigned char* smem) {
    float* tile = (float*)smem; bf16_t* W = (bf16_t*)(p.ws + wbase(layer));
    if (it < WT_IN) { int kt = it / 36, nt = it % 36; transpose_f32(p.in[I_WIN] + (size_t)layer * 1024 * INC, INC, INC, (bf16_t*)((unsigned char*)W + W_IN), 1024, kt * 64, nt * 64, nullptr, tile); return; } it -= WT_IN;
    if (it < WT_OUT) { int kt = it / 16, nt = it % 16; transpose_f32(p.in[I_WOUT] + (size_t)layer * 1024 * 1024, 1024, 1024, (bf16_t*)((unsigned char*)W + W_OUT), 1024, kt * 64, nt * 64, nullptr, tile); return; } it -= WT_OUT;
    if (it < WT_FF1) { int kt = it / 64, nt = it % 64; transpose_f32(p.in[I_WFF1] + (size_t)layer * 1024 * 4096, 4096, 4096, (bf16_t*)((unsigned char*)W + W_FF1), 1024, kt * 64, nt * 64, nullptr, tile); return; } it -= WT_FF1;
    if (it < WT_FF2) { int kt = it / 16, nt = it % 16; transpose_f32(p.in[I_WFF2] + (size_t)layer * 4096 * 1024, 1024, 1024, (bf16_t*)((unsigned char*)W + W_FF2), 4096, kt * 64, nt * 64, nullptr, tile); return; } it -= WT_FF2;
    if (it < WT_UQ) { int kt = it / 9, nt = it % 9; transpose_f32(p.in[I_WUQ] + (size_t)layer * 256 * 576, 576, 576, (bf16_t*)((unsigned char*)W + W_UQ), 256, kt * 64, nt * 64, p.in[I_GCQ] + layer * 256, tile); return; } it -= WT_UQ;
    { int kt = it / 12, nt = it % 12; transpose_f32(p.in[I_WUKV] + (size_t)layer * 128 * 768, 768, 768, (bf16_t*)((unsigned char*)W + W_UKV), 128, kt * 64, nt * 64, p.in[I_GCKV] + layer * 128, tile); }
}
DI void mod_item(const Params& p, int it, unsigned char* smem) {
    const int layer = it / 192, c0 = (it % 192) * 32, tid = get_tid();
    float* sl = (float*)smem;
    float* red = sl + 5 * 1024;
#pragma unroll
    for (int j = 0; j < 20; ++j) { const int i = tid + 256 * j, b = i >> 10, k = i & 1023; float v = (b < 4) ? p.in[I_C][b * 1024 + k] : p.in[I_CCTX][k]; sl[i] = silu(v); }
    __syncthreads();
    const int col = tid & 31, kg = tid >> 5;
    const float* W = p.in[I_WMOD] + (size_t)layer * 1024 * 6144 + c0 + col;
    float a0 = 0, a1 = 0, a2 = 0, a3 = 0, a4 = 0;
#pragma unroll 8
    for (int k = kg * 128; k < kg * 128 + 128; ++k) { float w = W[(size_t)k * 6144]; a0 += sl[k] * w; a1 += sl[1024 + k] * w; a2 += sl[2048 + k] * w; a3 += sl[3072 + k] * w; a4 += sl[4096 + k] * w; }
    red[(kg * 5 + 0) * 32 + col] = a0; red[(kg * 5 + 1) * 32 + col] = a1; red[(kg * 5 + 2) * 32 + col] = a2; red[(kg * 5 + 3) * 32 + col] = a3; red[(kg * 5 + 4) * 32 + col] = a4;
    __syncthreads();
    if (tid < 160) { int b = tid >> 5, c = tid & 31; float s = p.in[I_BMOD][layer * 6144 + c0 + c];
#pragma unroll
        for (int g = 0; g < 8; ++g) s += red[(g * 5 + b) * 32 + c];
        ((float*)(p.ws + WS_MOD))[(size_t)(layer * 5 + b) * 6144 + c0 + c] = s; }
    __syncthreads();
}
template <int L>
DI void filt_item(const Params& p, int layer, int it, unsigned char* smem, bf16_t* Fout, float* Part) {
    const int lb = it >> 2, cb = it & 3, tid = get_tid();
    float* feats = (float*)smem;
    float* h1 = feats + 32 * 33;
    float* h2 = h1 + 32 * 64;
    float* w1s = h2 + 32 * 64;
    float* w2s = w1s + 33 * 64;
    {
        const float* w1g = p.in[I_WF1] + layer * 33 * 64; const float* w2g = p.in[I_WF2] + layer * 64 * 64;
        float t1[9], t2[16];
#pragma unroll
        for (int j = 0; j < 9; ++j) { const int i = tid + 256 * j; t1[j] = (i < 33 * 64) ? w1g[i] : 0.f; }
#pragma unroll
        for (int j = 0; j < 16; ++j) t2[j] = w2g[tid + 256 * j];
#pragma unroll
        for (int j = 0; j < 9; ++j) { const int i = tid + 256 * j; if (i < 33 * 64) w1s[i] = t1[j]; }
#pragma unroll
        for (int j = 0; j < 16; ++j) w2s[tid + 256 * j] = t2[j];
    }
    const float wstep = (float)(2.0 * 3.14159265358979323846 / (double)L);
#pragma unroll 1
    for (int i = tid; i < 32 * 33; i += 256) { int lg = i / 33, f = i % 33, lag = lb * 32 + lg; float v;
        if (f == 0) v = (float)lag / (float)(L - 1);
        else { int bi = (f - 1) & 15; float band = 1e-4f + (float)bi * ((15.f - 1e-4f) / 15.f); float ang = band * (wstep * (float)lag); v = (f <= 16) ? cosf(ang) : -sinf(ang); }
        feats[i] = v; }
    __syncthreads();
    const float* w1 = w1s; const float* w2 = w2s;
#pragma unroll 1
    for (int i = tid; i < 2048; i += 256) { int lg = i >> 6, j = i & 63; float s = p.in[I_BF1][layer * 64 + j];
#pragma unroll 3
        for (int f = 0; f < 33; ++f) s += feats[lg * 33 + f] * w1[f * 64 + j];
        h1[i] = sinf(p.in[I_FQ1][layer * 64 + j] * s); }
    __syncthreads();
#pragma unroll 1
    for (int i = tid; i < 2048; i += 256) { int lg = i >> 6, j = i & 63; float s = p.in[I_BF2][layer * 64 + j];
#pragma unroll 4
        for (int f = 0; f < 64; ++f) s += h1[lg * 64 + f] * w2[f * 64 + j];
        h2[i] = sinf(p.in[I_FQ2][layer * 64 + j] * s); }
    __syncthreads();
    const int col = cb * 256 + tid, dir = col >> 9, o = (col >> 8) & 1, ch = col & 255;
    const float* w3 = p.in[I_WF3] + (size_t)layer * 64 * 1024 + col;
    const float d0 = -4.605170185988091f / 1.5f, d1 = -4.605170185988091f / 0.3f;
    const float delta = fabsf(d0 + (float)ch * ((d1 - d0) / 255.f));
    bf16_t* F = Fout + (size_t)(o * 256 + ch) * (2 * L);
    float asum = 0.f;
    float wreg[64];
#pragma unroll
    for (int k = 0; k < 64; ++k) wreg[k] = w3[k * 1024];
#pragma unroll 1
    for (int lg = 0; lg < 32; ++lg) {
        float a0 = 0.f, a1 = 0.f;
#pragma unroll
        for (int k = 0; k < 64; k += 8) { const f32x4 hv = *(const f32x4*)(h2 + lg * 64 + k), hw = *(const f32x4*)(h2 + lg * 64 + k + 4);
            a0 += hv.x * wreg[k] + hv.y * wreg[k + 1] + hv.z * wreg[k + 2] + hv.w * wreg[k + 3];
            a1 += hw.x * wreg[k + 4] + hw.y * wreg[k + 5] + hw.z * wreg[k + 6] + hw.w * wreg[k + 7]; }
        const int lag = lb * 32 + lg; const float t01 = (float)lag / (float)(L - 1); const float v = (a0 + a1) * __expf(-t01 * delta);
        if (dir == 0) { F[L + lag] = f2bf(v); asum += fabsf(v); }
        else { if (lag == 0) F[0] = 0; else { F[L - lag] = f2bf(v); asum += fabsf(v); } }
    }
    Part[lb * 1024 + col] = asum;
    __syncthreads();
}

DI void norm_rows(const Params& p, int layer, int which  , int nrows, bool from_input) {
    const int lane = get_tid() & 63, gw = blockIdx.x * 4 + (get_tid() >> 6), NGW = gridDim.x * 4;
    const float* g = p.in[which ? I_GMLP : I_GMIX] + layer * 1024;
    const float* MOD = (const float*)(p.ws + WS_MOD) + (size_t)layer * 5 * 6144;
    bf16_t* H = (bf16_t*)(p.ws + WS_H);
    const int rpw = (nrows + NGW - 1) / NGW, rbeg = gw * rpw, rend = min(nrows, rbeg + rpw);
    f32x4 ga[4], sb[4]; int mb_cur = -1;
    for (int r = rbeg; r < rend; ++r) {
        const float* src; int mb;
        if (r < NL) { src = (from_input ? p.in[I_X] : p.out) + (size_t)r * 1024; mb = r >> 12; }
        else { src = (from_input ? p.in[I_CTX] : (const float*)(p.ws + WS_XC)) + (size_t)(r - NL) * 1024; mb = 4; }
        f32x4 v[4]; float ss = 0.f;
#pragma unroll
        for (int j = 0; j < 4; ++j) { v[j] = *(const f32x4*)(src + 256 * j + 4 * lane); ss += v[j].x * v[j].x + v[j].y * v[j].y + v[j].z * v[j].z + v[j].w * v[j].w; }
        if (mb != mb_cur) {
            const float* sh = MOD + mb * 6144 + (which ? 3072 : 0); const float* sc = sh + 1024;
#pragma unroll
            for (int j = 0; j < 4; ++j) { const int c = 256 * j + 4 * lane; const f32x4 gg = *(const f32x4*)(g + c), s1 = *(const f32x4*)(sc + c); sb[j] = *(const f32x4*)(sh + c);
                ga[j].x = gg.x * (1.f + s1.x); ga[j].y = gg.y * (1.f + s1.y); ga[j].z = gg.z * (1.f + s1.z); ga[j].w = gg.w * (1.f + s1.w); }
            mb_cur = mb;
        }
        const float rstd = 1.f / sqrtf(wave_sum(ss) * (1.f / 1024.f) + EPS);
#pragma unroll
        for (int j = 0; j < 4; ++j) { const int c = 256 * j + 4 * lane;
            const float o0 = v[j].x * rstd * ga[j].x + sb[j].x, o1 = v[j].y * rstd * ga[j].y + sb[j].y, o2 = v[j].z * rstd * ga[j].z + sb[j].z, o3 = v[j].w * rstd * ga[j].w + sb[j].w;
            u32x2 w; w.x = pack2(o0, o1); w.y = pack2(o2, o3); *(u32x2*)(H + (size_t)r * 1024 + c) = w; }
    }
}

DI void hyconv_item(const Params& p, int layer, int it, unsigned char* smem) {
    const int rt = it / 12, ct = it % 12, r0 = rt * 64, c0 = ct * 64, tid = get_tid();
    float* tile = (float*)smem;
    const bf16_t* PROJ = (const bf16_t*)(p.ws + WS_PROJ);
    int b, t, L; row_info(r0, b, t, L);
    u32x2 hv[5];
#pragma unroll
    for (int j = 0; j < 5; ++j) { const int i = tid + 256 * j, rr = i >> 4, c = (i & 15) * 4, tt = t + rr - 1; hv[j].x = 0u; hv[j].y = 0u;
        if (i < 66 * 16 && tt >= 0 && tt < L) hv[j] = *(const u32x2*)(PROJ + (size_t)(r0 + rr - 1) * INP + O_HY + c0 + c); }
#pragma unroll
    for (int j = 0; j < 5; ++j) { const int i = tid + 256 * j, rr = i >> 4, c = (i & 15) * 4; const u32x2 v = hv[j];
        if (i < 66 * 16) { float* tp = tile + rr * 65 + c; tp[0] = bf2f((bf16_t)(v.x & 0xffff)); tp[1] = bf2f((bf16_t)(v.x >> 16)); tp[2] = bf2f((bf16_t)(v.y & 0xffff)); tp[3] = bf2f((bf16_t)(v.y >> 16)); } }
    const float* w = p.in[I_WCH] + layer * 3 * 768; const float* bb = p.in[I_BCH] + layer * 768;
    bf16_t* P = (bf16_t*)(p.ws + WS_P);
    float* wl = tile + 66 * 65;
    { const int q = tid >> 6, c = tid & 63; wl[tid] = (q == 0) ? bb[c0 + c] : w[(q - 1) * 768 + c0 + c]; }
    __syncthreads();
#pragma unroll
    for (int j = 0; j < 8; ++j) { const int i = tid + 256 * j, c = i >> 5, rp = (i & 31) * 2, cc = c0 + c;
        const float t0 = tile[rp * 65 + c], t1 = tile[(rp + 1) * 65 + c], t2 = tile[(rp + 2) * 65 + c], t3 = tile[(rp + 3) * 65 + c];
        const float bq = wl[c], wa = wl[64 + c], wb = wl[128 + c], wc = wl[192 + c];
        const float v0 = bq + wa * t0 + wb * t1 + wc * t2, v1 = bq + wa * t1 + wb * t2 + wc * t3;
        *(unsigned*)(P + (size_t)cc * NT + r0 + rp) = pack2(v0, v1); }
    __syncthreads();
}
DI void ssmconv_item(const Params& p, int layer, int it, const float* w, const float* bb) {
    const int r0 = it * 32, tid = get_tid();
    const bf16_t* PROJ = (const bf16_t*)(p.ws + WS_PROJ); bf16_t* UZ = (bf16_t*)(p.ws + WS_UZ); float* DT = (float*)(p.ws + WS_DT);
    int b, t0, L; row_info(r0, b, t0, L);
#pragma unroll 1
    for (int j0 = 0; j0 < 10; j0 += 5) {
        bf16x8 xc[5], xp[5], xn[5];
#pragma unroll
        for (int j = 0; j < 5; ++j) { const int i = tid + 256 * (j0 + j), rl = i / 80, c = (i - rl * 80) * 8, t = t0 + rl; const size_t r = r0 + rl;
            const bf16_t* src = PROJ + r * INP + O_XBC + c;
            xc[j] = ld8(src); xp[j] = xc[j]; xn[j] = xc[j];
            if (t > 0) xp[j] = ld8(src - INP);
            if (t < L - 1) xn[j] = ld8(src + INP); }
#pragma unroll
        for (int j = 0; j < 5; ++j) { const int i = tid + 256 * (j0 + j), rl = i / 80, c = (i - rl * 80) * 8, t = t0 + rl; const size_t r = r0 + rl;
            const bool hp = t > 0, hn = t < L - 1;
            const f32x4 b0 = *(const f32x4*)(bb + c), b1 = *(const f32x4*)(bb + c + 4), wa0 = *(const f32x4*)(w + c), wa1 = *(const f32x4*)(w + c + 4),
                        wb0 = *(const f32x4*)(w + 640 + c), wb1 = *(const f32x4*)(w + 640 + c + 4), wc0 = *(const f32x4*)(w + 1280 + c), wc1 = *(const f32x4*)(w + 1280 + c + 4);
            const float bv[8] = { b0.x, b0.y, b0.z, b0.w, b1.x, b1.y, b1.z, b1.w }, w0v[8] = { wa0.x, wa0.y, wa0.z, wa0.w, wa1.x, wa1.y, wa1.z, wa1.w },
                        w1v[8] = { wb0.x, wb0.y, wb0.z, wb0.w, wb1.x, wb1.y, wb1.z, wb1.w }, w2v[8] = { wc0.x, wc0.y, wc0.z, wc0.w, wc1.x, wc1.y, wc1.z, wc1.w };
            float o[8];
#pragma unroll
            for (int e = 0; e < 8; ++e) { float v = bv[e] + w1v[e] * bf2f((bf16_t)xc[j][e]);
                if (hp) v += w0v[e] * bf2f((bf16_t)xp[j][e]);
                if (hn) v += w2v[e] * bf2f((bf16_t)xn[j][e]);
                o[e] = silu(v); }
            *(bf16x8*)(UZ + r * 1024 + c) = pack8(o[0], o[1], o[2], o[3], o[4], o[5], o[6], o[7]); }
    }
    { u32x4 zc[6];
#pragma unroll
      for (int j = 0; j < 6; ++j) { const int i = tid + 256 * j, rl = i / 48, c = (i - rl * 48) * 8; zc[j] = *(const u32x4*)(PROJ + (size_t)(r0 + rl) * INP + O_Z + c); }
#pragma unroll
      for (int j = 0; j < 6; ++j) { const int i = tid + 256 * j, rl = i / 48, c = (i - rl * 48) * 8; *(u32x4*)(UZ + (size_t)(r0 + rl) * 1024 + 640 + c) = zc[j]; } }
    for (int i = tid; i < 32 * 12; i += 256) { const int rl = i / 12, c = i - rl * 12; const size_t r = r0 + rl;
        DT[r * 12 + c] = softplus(bf2f(PROJ[r * INP + O_DT + c]) + p.in[I_DTB][layer * 12 + c]); }
}
DI void qkv_item(const Params& p, int layer, int it, unsigned char* smem) {
    const int tid = get_tid(), lane = tid & 63, wave = tid >> 6, li = lane & 31, lh = lane >> 5;
    const int ug = it & 3, hd0 = 3 * (ug & 1);
    const int rbase = (it >> 2) * 128 + 32 * wave;
    const bf16_t* PROJ = (const bf16_t*)(p.ws + WS_PROJ);
    bf16_t* Ws = (bf16_t*)smem;
    int b, t0, L; row_info(rbase, b, t0, L);
    const bool lat = rbase < NL;
    float cs[16], sn[16];
    {
        const int axis = li >> 4, f = li & 7; const float inv = exp2f(-(float)f * (13.287712379549449f / 8.f));
#pragma unroll
        for (int reg = 0; reg < 16; ++reg) { int t = t0 + crow(reg, lh); float pos = (float)(axis ? (t & 63) : (t >> 6)); const float ang = pos * inv; cs[reg] = __cosf(ang); sn[reg] = __sinf(ang); }
    }
    const bool second = (li >> 3) & 1;
    if (ug < 2) {
        const bf16_t* Wq = (const bf16_t*)(p.ws + wbase(layer) + W_UQ);
        const float* gq = p.in[I_GQH] + layer * 96;
        const bf16_t* arow = PROJ + (size_t)(rbase + li) * INP + O_CQ + 8 * lh;
        float ss = 0.f;
#pragma unroll 1
        for (int kh = 0; kh < 2; ++kh) { bf16x8 a[8];
#pragma unroll
            for (int ks = 0; ks < 8; ++ks) a[ks] = ld8(arow + 128 * kh + 16 * ks);
#pragma unroll
            for (int ks = 0; ks < 8; ++ks) {
#pragma unroll
                for (int j = 0; j < 8; ++j) { float x = bf2f((bf16_t)a[ks][j]); ss += x * x; } } }
        ss += __shfl_xor(ss, 32);
        const float alpha = 1.f / sqrtf(ss * (1.f / 256.f) + EPS);
        float al[16];
#pragma unroll
        for (int reg = 0; reg < 16; ++reg) al[reg] = __shfl(alpha, crow(reg, lh));
        const float g0 = gq[li], g1 = gq[32 + li], g2 = gq[64 + li];
#pragma unroll 1
        for (int hd = hd0; hd < hd0 + 3; ++hd) {
            __syncthreads();
#pragma unroll 1
            for (int jb = 0; jb < 12; jb += 6) { u32x4 sw[6];
#pragma unroll
              for (int j = 0; j < 6; ++j) { const int i = tid + 256 * (jb + j), n = i >> 5, kc = i & 31; sw[j] = *(const u32x4*)(Wq + (size_t)(hd * 96 + n) * 256 + kc * 8); }
#pragma unroll
              for (int j = 0; j < 6; ++j) { const int i = tid + 256 * (jb + j), n = i >> 5, kc = i & 31; *(u32x4*)(Ws + n * 264 + kc * 8) = sw[j]; } }
            __syncthreads();
            f32x16 c0 = zero16(), c1 = zero16(), c2 = zero16();
            const bf16_t* wb = Ws + li * 264 + 8 * lh;
#pragma unroll 1
            for (int kh = 0; kh < 4; ++kh) { bf16x8 a[4];
#pragma unroll
                for (int ks = 0; ks < 4; ++ks) a[ks] = ld8(arow + 64 * kh + 16 * ks);
                __builtin_amdgcn_sched_barrier(0);
#pragma unroll
                for (int ks = 0; ks < 4; ++ks) { const bf16_t* w_ = wb + 64 * kh + 16 * ks;
                    c0 = MFMA(a[ks], ld8(w_), c0); c1 = MFMA(a[ks], ld8(w_ + 32 * 264), c1); c2 = MFMA(a[ks], ld8(w_ + 64 * 264), c2);
                    if ((ks & 1) == 1) __builtin_amdgcn_sched_barrier(0);
                } }
            bf16_t* Qp = lat ? (bf16_t*)(p.ws + WS_Q) + ((size_t)(b * 6 + hd) * SEQ + t0) * 96 : (bf16_t*)(p.ws + WS_QC) + ((size_t)(b * 6 + hd) * CTX + t0) * 96;
#pragma unroll
            for (int reg = 0; reg < 16; ++reg) {
                float s2 = xor_red32(c0[reg] * c0[reg] + c1[reg] * c1[reg] + c2[reg] * c2[reg]);
                const float ar = al[reg], rs = 1.f / sqrtf(ar * ar * s2 * (1.f / 96.f) + EPS), sc = ar * rs;
                float v0 = c0[reg] * sc * g0, v1 = c1[reg] * sc * g1, v2 = c2[reg] * sc * g2;
                float pr = __shfl_xor(v2, 8);
                if (lat) v2 = second ? (v2 * cs[reg] + pr * sn[reg]) : (v2 * cs[reg] - pr * sn[reg]);
                bf16_t* q = Qp + (size_t)crow(reg, lh) * 96;
                q[li] = f2bf(v0); q[32 + li] = f2bf(v1); q[64 + li] = f2bf(v2);
                if ((reg & 3) == 3) __builtin_amdgcn_sched_barrier(0);
            }
        }
        __syncthreads();
    }
    else {
        const bf16_t* Wkv = (const bf16_t*)(p.ws + wbase(layer) + W_UKV);
        const float* gk = p.in[I_GKH] + layer * 96;
        const bf16_t* arow = PROJ + (size_t)(rbase + li) * INP + O_CKV + 8 * lh;
        float ss = 0.f;
        { bf16x8 a[8];
#pragma unroll
          for (int ks = 0; ks < 8; ++ks) a[ks] = ld8(arow + 16 * ks);
#pragma unroll
          for (int ks = 0; ks < 8; ++ks) {
#pragma unroll
            for (int j = 0; j < 8; ++j) { float x = bf2f((bf16_t)a[ks][j]); ss += x * x; } } }
        ss += __shfl_xor(ss, 32);
        const float alpha = 1.f / sqrtf(ss * (1.f / 128.f) + EPS);
        float al[16], krv[16];
#pragma unroll
        for (int reg = 0; reg < 16; ++reg) { al[reg] = __shfl(alpha, crow(reg, lh)); krv[reg] = bf2f(PROJ[(size_t)(rbase + crow(reg, lh)) * INP + O_KR + li]); }
        const float g0 = gk[li], g1 = gk[32 + li], g2 = gk[64 + li];
        const int kbase = lat ? (CTX + t0) : t0;
#pragma unroll 1
        for (int hd = hd0; hd < hd0 + 3; ++hd) {
            __syncthreads();
#pragma unroll 1
            for (int jb = 0; jb < 8; jb += 4) { u32x4 sw[4];
#pragma unroll
              for (int j = 0; j < 4; ++j) { const int i = tid + 256 * (jb + j), n = i >> 4, kc = i & 15; sw[j] = *(const u32x4*)(Wkv + (size_t)(hd * 128 + n) * 128 + kc * 8); }
#pragma unroll
              for (int j = 0; j < 4; ++j) { const int i = tid + 256 * (jb + j), n = i >> 4, kc = i & 15; *(u32x4*)(Ws + n * 136 + kc * 8) = sw[j]; } }
            __syncthreads();
            f32x16 c0 = zero16(), c1 = zero16(), c2 = zero16(), c3 = zero16();
            const bf16_t* wb = Ws + li * 136 + 8 * lh;
#pragma unroll 1
            for (int kh = 0; kh < 2; ++kh) { bf16x8 a[4];
#pragma unroll
                for (int ks = 0; ks < 4; ++ks) a[ks] = ld8(arow + 64 * kh + 16 * ks);
                __builtin_amdgcn_sched_barrier(0);
#pragma unroll
                for (int ks = 0; ks < 4; ++ks) { const bf16_t* w_ = wb + 64 * kh + 16 * ks;
                    c0 = MFMA(a[ks], ld8(w_), c0); c1 = MFMA(a[ks], ld8(w_ + 32 * 136), c1);
                    c2 = MFMA(a[ks], ld8(w_ + 64 * 136), c2); c3 = MFMA(a[ks], ld8(w_ + 96 * 136), c3);
                    __builtin_amdgcn_sched_barrier(0);
                } }
            bf16_t* Kp = (bf16_t*)(p.ws + WS_K) + ((size_t)(b * 6 + hd) * NKEY + kbase) * 96;
            bf16_t* Vp = (bf16_t*)(p.ws + WS_VT) + ((size_t)(b * 6 + hd) * 64) * NKEY + kbase;
#pragma unroll
            for (int reg = 0; reg < 16; ++reg) {
                const float ar = al[reg];
                float s2 = xor_red32(ar * ar * (c0[reg] * c0[reg] + c1[reg] * c1[reg]) + krv[reg] * krv[reg]);
                const float rs = 1.f / sqrtf(s2 * (1.f / 96.f) + EPS);
                float v0 = c0[reg] * ar * rs * g0, v1 = c1[reg] * ar * rs * g1, v2 = krv[reg] * rs * g2;
                float pr = __shfl_xor(v2, 8);
                if (lat) v2 = second ? (v2 * cs[reg] + pr * sn[reg]) : (v2 * cs[reg] - pr * sn[reg]);
                bf16_t* k = Kp + (size_t)crow(reg, lh) * 96;
                k[li] = f2bf(v0); k[32 + li] = f2bf(v1); k[64 + li] = f2bf(v2);
                if ((reg & 3) == 3) __builtin_amdgcn_sched_barrier(0);
            }
#pragma unroll
            for (int rg = 0; rg < 4; ++rg) {
                const int k0 = 8 * rg + 4 * lh;
                u32x2 w0, w1;
                w0.x = pack2(c2[4 * rg] * al[4 * rg], c2[4 * rg + 1] * al[4 * rg + 1]); w0.y = pack2(c2[4 * rg + 2] * al[4 * rg + 2], c2[4 * rg + 3] * al[4 * rg + 3]);
                w1.x = pack2(c3[4 * rg] * al[4 * rg], c3[4 * rg + 1] * al[4 * rg + 1]); w1.y = pack2(c3[4 * rg + 2] * al[4 * rg + 2], c3[4 * rg + 3] * al[4 * rg + 3]);
                *(u32x2*)(Vp + (size_t)li * NKEY + k0) = w0;
                *(u32x2*)(Vp + (size_t)(32 + li) * NKEY + k0) = w1;
            }
        }
        __syncthreads();
    }
}

DI void attn_item(const Params& p, const bf16_t* Qbase  , int bh, int q0, int nkeys, int out_row0, unsigned char* smem) {
    constexpr int KS = 104, VS = 68;
    bf16_t* Ks = (bf16_t*)smem;
    bf16_t* Vs = Ks + 2 * 64 * KS;
    const int tid = get_tid(), lane = tid & 63, wave = tid >> 6, li = lane & 31, lh = lane >> 5;
    const bf16_t* Kg = (const bf16_t*)(p.ws + WS_K) + (size_t)bh * NKEY * 96;
    const bf16_t* Vg = (const bf16_t*)(p.ws + WS_VT) + (size_t)bh * 64 * NKEY;
    bf16x8 qf[6];
#pragma unroll
    for (int ks = 0; ks < 6; ++ks) qf[ks] = ld8(Qbase + (size_t)(q0 + 32 * wave + li) * 96 + 16 * ks + 8 * lh);
    u32x4 rk[3], rv[2];
    auto gload = [&](int kt) {
#pragma unroll
        for (int i = 0; i < 3; ++i) { int id = tid + 256 * i; rk[i] = *(const u32x4*)(Kg + (size_t)kt * 64 * 96 + id * 8); }
#pragma unroll
        for (int i = 0; i < 2; ++i) { int id = tid + 256 * i, v = id >> 3, kc = id & 7; rv[i] = *(const u32x4*)(Vg + (size_t)v * NKEY + kt * 64 + kc * 8); }
    };
    auto sstore = [&](int buf) {
#pragma unroll
        for (int i = 0; i < 3; ++i) { int id = tid + 256 * i, key = id / 12, dc = id - key * 12; *(u32x4*)(Ks + (buf * 64 + key) * KS + dc * 8) = rk[i]; }
#pragma unroll
        for (int i = 0; i < 2; ++i) { int id = tid + 256 * i, v = id >> 3, kc = id & 7; bf16_t* d = Vs + (buf * 64 + v) * VS + kc * 8;
            u32x2 lo, hi; lo.x = rv[i].x; lo.y = rv[i].y; hi.x = rv[i].z; hi.y = rv[i].w; *(u32x2*)d = lo; *(u32x2*)(d + 4) = hi; }
    };
    const int nkt = nkeys >> 6;
    const float scl = 0.10206207261596577f * 1.4426950408889634f;
    f32x16 o0 = zero16(), o1 = zero16(); float m = -1e30f, l = 0.f;
    __syncthreads();
    gload(0); sstore(0); __syncthreads();
    for (int kt = 0; kt < nkt; ++kt) {
        const int buf = kt & 1;
        if (kt + 1 < nkt) gload(kt + 1);
        __builtin_amdgcn_sched_barrier(0);
        f32x16 s0 = zero16(), s1 = zero16();
        const bf16_t* kb = Ks + (buf * 64 + li) * KS + 8 * lh;
#pragma unroll
        for (int ks = 0; ks < 6; ++ks) { s0 = MFMA(ld8(kb + 16 * ks), qf[ks], s0); s1 = MFMA(ld8(kb + 32 * KS + 16 * ks), qf[ks], s1); }
        float mx = fmaxf(s0[0], s1[0]);
#pragma unroll
        for (int r = 1; r < 16; ++r) mx = fmaxf(fmaxf(mx, s0[r]), s1[r]);
        mx = fmaxf(mx, __shfl_xor(mx, 32));
        const float mn = fmaxf(m, mx);
        if (__any(mn > m)) {
            const float corr = __builtin_amdgcn_exp2f((m - mn) * scl);
            l *= corr;
#pragma unroll
            for (int r = 0; r < 16; ++r) { o0[r] *= corr; o1[r] *= corr; }
            m = mn;
        }
        const float nb = -m * scl;
        float sum0 = 0.f, sum1 = 0.f;
#pragma unroll
        for (int r = 0; r < 16; ++r) { s0[r] = __builtin_amdgcn_exp2f(fmaf(s0[r], scl, nb)); s1[r] = __builtin_amdgcn_exp2f(fmaf(s1[r], scl, nb)); sum0 += s0[r]; sum1 += s1[r]; }
        float sum = sum0 + sum1;
        sum += __shfl_xor(sum, 32);
        l += sum;
        bf16x8 pf[2][2];
        pf[0][0] = pack8(s0[0], s0[1], s0[2], s0[3], s0[4], s0[5], s0[6], s0[7]); pf[0][1] = pack8(s0[8], s0[9], s0[10], s0[11], s0[12], s0[13], s0[14], s0[15]);
        pf[1][0] = pack8(s1[0], s1[1], s1[2], s1[3], s1[4], s1[5], s1[6], s1[7]); pf[1][1] = pack8(s1[8], s1[9], s1[10], s1[11], s1[12], s1[13], s1[14], s1[15]);
        const bf16_t* vb = Vs + (buf * 64 + li) * VS + 4 * lh;
#pragma unroll
        for (int j = 0; j < 2; ++j)
#pragma unroll
            for (int s = 0; s < 2; ++s) {
                const int ko = 32 * j + 16 * s;
                o0 = MFMA(ld4x2(vb + ko, vb + ko + 8), pf[j][s], o0);
                o1 = MFMA(ld4x2(vb + 32 * VS + ko, vb + 32 * VS + ko + 8), pf[j][s], o1);
            }
        __builtin_amdgcn_sched_barrier(0);
        if (kt + 1 < nkt) sstore(buf ^ 1);
        __syncthreads();
    }
    const float inv = 1.f / l;
    bf16_t* MIX = (bf16_t*)(p.ws + WS_MIX);
    const int hd = bh % 6;
    bf16_t* orow = MIX + (size_t)(out_row0 + q0 + 32 * wave + li) * 1024 + hd * 64;
#pragma unroll
    for (int rg = 0; rg < 4; ++rg) {
        u32x2 w0, w1;
        w0.x = pack2(o0[4 * rg] * inv, o0[4 * rg + 1] * inv); w0.y = pack2(o0[4 * rg + 2] * inv, o0[4 * rg + 3] * inv);
        w1.x = pack2(o1[4 * rg] * inv, o1[4 * rg + 1] * inv); w1.y = pack2(o1[4 * rg + 2] * inv, o1[4 * rg + 3] * inv);
        *(u32x2*)(orow + 8 * rg + 4 * lh) = w0;
        *(u32x2*)(orow + 32 + 8 * rg + 4 * lh) = w1;
    }
}

DI void wave_scan128(const float* v, float* out, bool reverse, int lane) {
    const float v0 = v[2 * lane], v1 = v[2 * lane + 1];
    float s = v0 + v1;
#pragma unroll
    for (int o = 1; o < 64; o <<= 1) { float t = __shfl_up(s, o); if (lane >= o) s += t; }
    const float total = __shfl(s, 63);
    if (!reverse) { out[2 * lane] = s - v1; out[2 * lane + 1] = s; }
    else { out[2 * lane] = total - (s - v0 - v1); out[2 * lane + 1] = total - (s - v1); }
}
DI int chunk_row0(int b, int cidx) { return cidx < 2 ? NL + b * CTX + cidx * 128 : b * SEQ + (cidx - 2) * 128; }

DI void ssdA_item(const Params& p, int layer, int it, unsigned char* smem) {
    const int cidx = it % NCHK, hd = (it / NCHK) % 6, b = it / (NCHK * 6), g = hd / 3;
    const int tid = get_tid(), lane = tid & 63, wave = tid >> 6, li = lane & 31, lh = lane >> 5;
    constexpr int TS = 136;
    bf16_t* BT = (bf16_t*)smem;
    bf16_t* XT = BT + 64 * TS;
    float* dtv = (float*)(XT + 64 * TS);
    float* av = dtv + 256;
    float* cum = av + 256;
    const int r0 = chunk_row0(b, cidx);
    const bf16_t* UZ = (const bf16_t*)(p.ws + WS_UZ); const float* DT = (const float*)(p.ws + WS_DT);
    __syncthreads();
    { const int t = tid & 127, d = tid >> 7; const float dt = DT[(size_t)(r0 + t) * 12 + d * 6 + hd]; const float a = -__expf(p.in[I_ALOG][layer * 12 + d * 6 + hd]); dtv[d * 128 + t] = dt; av[d * 128 + t] = dt * a; }
    { bf16x8 sv[4];
#pragma unroll
      for (int q = 0; q < 4; ++q) { const int i = tid + 256 * q, t = i >> 3, c8 = i & 7; sv[q] = ld8(UZ + (size_t)(r0 + t) * 1024 + 384 + g * 64 + c8 * 8); }
#pragma unroll
      for (int q = 0; q < 4; ++q) { const int i = tid + 256 * q, t = i >> 3, c8 = i & 7;
#pragma unroll
        for (int j = 0; j < 8; ++j) BT[(c8 * 8 + j) * TS + t] = (bf16_t)sv[q][j]; } }
    __syncthreads();
    if (wave < 2) wave_scan128(av + wave * 128, cum + wave * 128, wave == 1, lane);
    __syncthreads();
    float* ST = (float*)(p.ws + stbase(layer)); float* DEC = (float*)(p.ws + stbase(layer) + ST_BYTES);
    for (int d = 0; d < 2; ++d) {
        const float total = d == 0 ? cum[127] : cum[128];
        { bf16x8 sv[4];
#pragma unroll
          for (int q = 0; q < 4; ++q) { const int i = tid + 256 * q, t = i >> 3, c8 = i & 7; sv[q] = ld8(UZ + (size_t)(r0 + t) * 1024 + hd * 64 + c8 * 8); }
#pragma unroll
          for (int q = 0; q < 4; ++q) { const int i = tid + 256 * q, t = i >> 3, c8 = i & 7;
            const float w = __expf(total - cum[d * 128 + t]) * dtv[d * 128 + t];
#pragma unroll
            for (int j = 0; j < 8; ++j) XT[(c8 * 8 + j) * TS + t] = f2bf(bf2f((bf16_t)sv[q][j]) * w); } }
        __syncthreads();
        const int pt = wave >> 1, nt = wave & 1;
        f32x16 acc = zero16();
#pragma unroll
        for (int ks = 0; ks < 8; ++ks) acc = MFMA(ld8(XT + (32 * pt + li) * TS + 16 * ks + 8 * lh), ld8(BT + (32 * nt + li) * TS + 16 * ks + 8 * lh), acc);
        float* st = ST + ((((size_t)d * 4 + b) * 6 + hd) * NCHK + cidx) * 4096;
#pragma unroll
        for (int reg = 0; reg < 16; ++reg) st[(32 * pt + crow(reg, lh)) * 64 + 32 * nt + li] = acc[reg];
        if (tid == 0) DEC[(((size_t)d * 4 + b) * 6 + hd) * NCHK + cidx] = __expf(total);
        __syncthreads();
    }
}
DI void hy_rawload(const unsigned* fd, unsigned (&raw)[10]) {
#pragma unroll
    for (int j = 0; j < 5; ++j) { raw[j] = fd[j]; raw[5 + j] = fd[j - 8]; }
}
DI void hy_conv(const bf16_t* ub, const bf16_t* filt, f32x16 (&acc)[2], int nbase, int li, int lh) {
    const int klo = 32 * nbase - 127, khi = 32 * (nbase + 1) + 31;
    const int m0 = 4096 + li - 8 * lh - 7;
    const unsigned sh = (unsigned)(m0 & 1) * 16u;
    const unsigned* fd0 = (const unsigned*)filt + (m0 >> 1);
    unsigned raw[10];
    hy_rawload(fd0 + 16 * klo, raw);
#pragma unroll 4
    for (int k = klo; k <= khi; ++k) {
        u32x4 ua, ub4;
        ua.x = __builtin_amdgcn_alignbit(raw[1], raw[0], sh); ua.y = __builtin_amdgcn_alignbit(raw[2], raw[1], sh); ua.z = __builtin_amdgcn_alignbit(raw[3], raw[2], sh); ua.w = __builtin_amdgcn_alignbit(raw[4], raw[3], sh);
        ub4.x = __builtin_amdgcn_alignbit(raw[6], raw[5], sh); ub4.y = __builtin_amdgcn_alignbit(raw[7], raw[6], sh); ub4.z = __builtin_amdgcn_alignbit(raw[8], raw[7], sh); ub4.w = __builtin_amdgcn_alignbit(raw[9], raw[8], sh);
        const bf16x8 a0 = __builtin_bit_cast(bf16x8, ua), a1 = __builtin_bit_cast(bf16x8, ub4);
        if (k < khi) hy_rawload(fd0 + 16 * (k + 1), raw);
        bf16x8 b0[2], b1[2]; bool use[2];
#pragma unroll
        for (int n = 0; n < 2; ++n) {
            const int nn = nbase + n; use[n] = (k >= 32 * nn - 127) && (k <= 32 * nn + 31);
            const int c = 32 * nn + li - k;
            const bf16_t* up = ub + c * 40 + 8 * lh;
            b0[n] = ld8(up); b1[n] = ld8(up + 16);
        }
#pragma unroll
        for (int n = 0; n < 2; ++n) if (use[n]) { acc[n] = MFMA(a0, b0[n], acc[n]); acc[n] = MFMA(a1, b1[n], acc[n]); }
    }
}
DI u32x4 rev8(u32x4 v) { u32x4 r; r.x = (v.w >> 16) | (v.w << 16); r.y = (v.z >> 16) | (v.z << 16); r.z = (v.y >> 16) | (v.y << 16); r.w = (v.x >> 16) | (v.x << 16); return r; }
DI void hyena_lat_item(const Params& p, int layer, int it, unsigned char* smem) {
    const int ch = it >> 1, bp = it & 1;
    const int tid = get_tid(), lane = tid & 63, wave = tid >> 6, li = lane & 31, lh = lane >> 5;
    const int bl = wave >> 1, nbase = 2 * (wave & 1), bg = 2 * bp + bl;
    constexpr int UB = 192 * 40;
    bf16_t* U = (bf16_t*)smem + 32 * 40;
    bf16_t* Fl = (bf16_t*)smem + 2 * UB;
    float* red = (float*)(Fl + 8192 + 16);
    const bf16_t* P = (const bf16_t*)(p.ws + WS_P); const bf16_t* FL = (const bf16_t*)(p.ws + WS_FL); const float* FP = (const float*)(p.ws + WS_FPL);
    __syncthreads();
    { const int lb = tid & 127, dir = tid >> 7;
      float v0 = wave_sum(FP[lb * 1024 + dir * 512 + ch]), v1 = wave_sum(FP[lb * 1024 + dir * 512 + 256 + ch]);
      if (lane == 0) { red[wave] = v0; red[4 + wave] = v1; } }
    { u32x4 su[4], sf[4];
#pragma unroll
      for (int j = 0; j < 4; ++j) su[j] = *(const u32x4*)(P + (size_t)ch * NT + (size_t)bp * 2 * SEQ + (tid + 256 * j) * 8);
#pragma unroll
      for (int j = 0; j < 4; ++j) sf[j] = *(const u32x4*)(FL + (size_t)(0 * 256 + ch) * 8192 + (tid + 256 * j) * 8);
#pragma unroll
      for (int j = 0; j < 4; ++j) { const int i = tid + 256 * j, b = i >> 9, r = i & 511, blk = r >> 2, q = r & 3; *(u32x4*)(U + b * UB + blk * 40 + q * 8) = rev8(su[j]); }
      { unsigned zz = 0u; asm volatile("" : "+v"(zz)); u32x4 z4; z4.x = zz; z4.y = zz; z4.z = zz; z4.w = zz;
#pragma unroll
        for (int j = 0; j < 3; ++j) { const int i = tid + 256 * j; if (i < 2 * 2 * 32 * 5) { const int b = i / 320, r = i - b * 320, side = r / 160, e = r - side * 160; *(u32x4*)(U + b * UB + (side ? 128 * 40 : -32 * 40) + e * 8) = z4; } } }
#pragma unroll
      for (int j = 0; j < 4; ++j) *(u32x4*)(Fl + (tid + 256 * j) * 8) = sf[j];
      if (tid < 8) ((unsigned*)(Fl + 8192))[tid] = 0u; }
    __syncthreads();
    const float inv0 = 1.f / (red[0] + red[1] + red[2] + red[3] + EPS), inv1 = 1.f / (red[4] + red[5] + red[6] + red[7] + EPS);
    const float d0 = p.in[I_DSH][layer * 512 + ch], d1 = p.in[I_DSH][layer * 512 + 256 + ch];
    bf16_t* ub = U + bl * UB;
    f32x16 acc[2];
    acc[0] = zero16(); acc[1] = zero16();
    hy_conv(ub, Fl, acc, nbase, li, lh);
    __syncthreads();
    { u32x4 sf[4];
#pragma unroll
      for (int j = 0; j < 4; ++j) sf[j] = *(const u32x4*)(FL + (size_t)(1 * 256 + ch) * 8192 + (tid + 256 * j) * 8);
#pragma unroll
      for (int n = 0; n < 2; ++n)
#pragma unroll
        for (int rg = 0; rg < 4; ++rg) {
            const int a = 32 * (nbase + n) + li, ii = 8 * rg + 4 * lh; bf16_t* up = ub + a * 40 + 8 * rg + 4 * (1 - lh);
            const u32x2 zz = *(const u32x2*)up; const u32x2 pp = *(const u32x2*)(P + (size_t)(256 + ch) * NT + bg * SEQ + 32 * a + ii);
            float z[4] = { bf2f((bf16_t)(zz.y >> 16)), bf2f((bf16_t)(zz.y & 0xffff)), bf2f((bf16_t)(zz.x >> 16)), bf2f((bf16_t)(zz.x & 0xffff)) };
            float q[4] = { bf2f((bf16_t)(pp.x & 0xffff)), bf2f((bf16_t)(pp.x >> 16)), bf2f((bf16_t)(pp.y & 0xffff)), bf2f((bf16_t)(pp.y >> 16)) };
            float o[4];
#pragma unroll
            for (int e = 0; e < 4; ++e) o[e] = q[e] * (acc[n][4 * rg + e] * inv0 + z[e] * d0);
            u32x2 w; w.x = pack2(o[3], o[2]); w.y = pack2(o[1], o[0]); *(u32x2*)up = w;
        }
#pragma unroll
      for (int j = 0; j < 4; ++j) *(u32x4*)(Fl + (tid + 256 * j) * 8) = sf[j]; }
    __syncthreads();
    acc[0] = zero16(); acc[1] = zero16();
    hy_conv(ub, Fl, acc, nbase, li, lh);
    bf16_t* HY = (bf16_t*)(p.ws + WS_HYOT);
#pragma unroll
    for (int n = 0; n < 2; ++n)
#pragma unroll
        for (int rg = 0; rg < 4; ++rg) {
            const int a = 32 * (nbase + n) + li, ii = 8 * rg + 4 * lh; const bf16_t* up = ub + a * 40 + 8 * rg + 4 * (1 - lh);
            const u32x2 zz = *(const u32x2*)up; const u32x2 pp = *(const u32x2*)(P + (size_t)(512 + ch) * NT + bg * SEQ + 32 * a + ii);
            float z[4] = { bf2f((bf16_t)(zz.y >> 16)), bf2f((bf16_t)(zz.y & 0xffff)), bf2f((bf16_t)(zz.x >> 16)), bf2f((bf16_t)(zz.x & 0xffff)) };
            float q[4] = { bf2f((bf16_t)(pp.x & 0xffff)), bf2f((bf16_t)(pp.x >> 16)), bf2f((bf16_t)(pp.y & 0xffff)), bf2f((bf16_t)(pp.y >> 16)) };
            float o[4];
#pragma unroll
            for (int e = 0; e < 4; ++e) o[e] = q[e] * (acc[n][4 * rg + e] * inv1 + z[e] * d1);
            u32x2 w; w.x = pack2(o[0], o[1]); w.y = pack2(o[2], o[3]); *(u32x2*)(HY + (size_t)ch * NT + bg * SEQ + 32 * a + ii) = w;
        }
}
DI void hyena_ctx_item(const Params& p, int layer, int ch, unsigned char* smem) {
    const int tid = get_tid();
    float* u = (float*)smem;
    float* f = u + 1024;
    const bf16_t* P = (const bf16_t*)(p.ws + WS_P); const bf16_t* FC = (const bf16_t*)(p.ws + WS_FC); const float* FP = (const float*)(p.ws + WS_FPC);
    bf16_t* HY = (bf16_t*)(p.ws + WS_HYOT);
    __syncthreads();
    float nrm[2] = { 0.f, 0.f };
#pragma unroll
    for (int o = 0; o < 2; ++o) for (int lb = 0; lb < 8; ++lb) nrm[o] += FP[lb * 1024 + o * 256 + ch] + FP[lb * 1024 + 512 + o * 256 + ch];
    for (int i = tid; i < 1024; i += 256) u[i] = bf2f(P[(size_t)ch * NT + NL + i]);
    float zprev[4];
    for (int o = 0; o < 2; ++o) {
        for (int i = tid; i < 512; i += 256) f[i] = bf2f(FC[(size_t)(o * 256 + ch) * 512 + i]);
        __syncthreads();
        float y[4] = { 0.f, 0.f, 0.f, 0.f };
        for (int s = 0; s < 256; ++s) { const float fv = f[256 + tid - s]; y[0] += fv * u[s]; y[1] += fv * u[256 + s]; y[2] += fv * u[512 + s]; y[3] += fv * u[768 + s]; }
        const float inv = 1.f / (nrm[o] + EPS), dsk = p.in[I_DSH][layer * 512 + o * 256 + ch];
#pragma unroll
        for (int b = 0; b < 4; ++b) { const float pv = bf2f(P[(size_t)((o + 1) * 256 + ch) * NT + NL + b * 256 + tid]); zprev[b] = pv * (y[b] * inv + u[b * 256 + tid] * dsk); }
        __syncthreads();
        if (o == 0) {
#pragma unroll
            for (int b = 0; b < 4; ++b) u[b * 256 + tid] = zprev[b]; }
        else {
#pragma unroll
            for (int b = 0; b < 4; ++b) HY[(size_t)ch * NT + NL + b * 256 + tid] = f2bf(zprev[b]); }
        __syncthreads();
    }
}

DI void ssd_scan(const Params& p, int layer) {
    float* ST = (float*)(p.ws + stbase(layer)); const float* DEC = (const float*)(p.ws + stbase(layer) + ST_BYTES);
    const int total = 2 * 4 * 6 * 4096;
    for (int i = blockIdx.x * 256 + get_tid(); i < total; i += gridDim.x * 256) {
        const int e = i & 4095, dbh = i >> 12, d = dbh / 24;
        float* st = ST + (size_t)dbh * NCHK * 4096 + e; const float* dec = DEC + dbh * NCHK;
        float x[NCHK], dc[NCHK];
#pragma unroll
        for (int c = 0; c < NCHK; ++c) { x[c] = st[(size_t)c * 4096]; dc[c] = dec[c]; }
        float s = 0.f;
        if (d == 0) {
#pragma unroll
            for (int c = 0; c < NCHK; ++c) { st[(size_t)c * 4096] = s; s = s * dc[c] + x[c]; } }
        else {
#pragma unroll
            for (int c = 1; c >= 0; --c) { st[(size_t)c * 4096] = s; s = s * dc[c] + x[c]; }
#pragma unroll
            for (int c = NCHK - 1; c >= 2; --c) { st[(size_t)c * 4096] = s; s = s * dc[c] + x[c]; } }
    }
}

DI void ssdC_item(const Params& p, int layer, int it, unsigned char* smem) {
    const int g = it & 1, cidx = (it >> 1) % NCHK, b = it / (2 * NCHK);
    const int tid = get_tid(), lane = tid & 63, wave = tid >> 6, li = lane & 31, lh = lane >> 5;
    constexpr int NS = 72, TS = 136;
    bf16_t* Bn = (bf16_t*)smem;
    bf16_t* Cn = Bn + 128 * NS;
    bf16_t* XT = Cn + 128 * NS;
    float* dtv = (float*)(XT + 64 * TS);
    float* av = dtv + 256;
    float* cum = av + 256;
    const int r0 = chunk_row0(b, cidx);
    const bf16_t* UZ = (const bf16_t*)(p.ws + WS_UZ); const float* DT = (const float*)(p.ws + WS_DT); const float* ST = (const float*)(p.ws + stbase(layer));
    __syncthreads();
    { u32x4 sb[4], sc[4];
#pragma unroll
      for (int q = 0; q < 4; ++q) { const int i = tid + 256 * q, t = i >> 3, c8 = i & 7;
        sb[q] = *(const u32x4*)(UZ + (size_t)(r0 + t) * 1024 + 384 + g * 64 + c8 * 8); sc[q] = *(const u32x4*)(UZ + (size_t)(r0 + t) * 1024 + 512 + g * 64 + c8 * 8); }
#pragma unroll
      for (int q = 0; q < 4; ++q) { const int i = tid + 256 * q, t = i >> 3, c8 = i & 7; *(u32x4*)(Bn + t * NS + c8 * 8) = sb[q]; *(u32x4*)(Cn + t * NS + c8 * 8) = sc[q]; } }
    const int itok = 32 * wave + li;
    float ssq = 0.f;
    bf16_t* orow = (bf16_t*)(p.ws + WS_MIX) + (size_t)(r0 + itok) * 1024 + 384 + g * 192;
#pragma unroll 1
    for (int hh = 0; hh < 3; ++hh) {
        const int hd = g * 3 + hh;
        __syncthreads();
        { const int t = tid & 127, d = tid >> 7; const float dt = DT[(size_t)(r0 + t) * 12 + d * 6 + hd]; const float a = -__expf(p.in[I_ALOG][layer * 12 + d * 6 + hd]); dtv[d * 128 + t] = dt; av[d * 128 + t] = dt * a; }
        { bf16x8 sv[4];
#pragma unroll
          for (int q = 0; q < 4; ++q) { const int i = tid + 256 * q, t = i >> 3, c8 = i & 7; sv[q] = ld8(UZ + (size_t)(r0 + t) * 1024 + hd * 64 + c8 * 8); }
#pragma unroll
          for (int q = 0; q < 4; ++q) { const int i = tid + 256 * q, t = i >> 3, c8 = i & 7;
#pragma unroll
            for (int j = 0; j < 8; ++j) XT[(c8 * 8 + j) * TS + t] = (bf16_t)sv[q][j]; } }
        __syncthreads();
        if (wave < 2) wave_scan128(av + wave * 128, cum + wave * 128, wave == 1, lane);
        __syncthreads();
        f32x16 y0 = zero16(), y1 = zero16();
#pragma unroll 1
        for (int d = 0; d < 2; ++d) {
            const float ci = cum[d * 128 + itok], ei = __expf(ci);
            {
                const float* prev = ST + ((((size_t)d * 4 + b) * 6 + hd) * NCHK + cidx) * 4096;
#pragma unroll
                for (int ks = 0; ks < 4; ++ks) {
                    const f32x4 pa = *(const f32x4*)(prev + (li) * 64 + 16 * ks + 8 * lh), pb = *(const f32x4*)(prev + (li) * 64 + 16 * ks + 8 * lh + 4);
                    const f32x4 pc = *(const f32x4*)(prev + (32 + li) * 64 + 16 * ks + 8 * lh), pd = *(const f32x4*)(prev + (32 + li) * 64 + 16 * ks + 8 * lh + 4);
                    const bf16x8 cr = ld8(Cn + itok * NS + 16 * ks + 8 * lh);
                    const bf16x8 cf = pack8(bf2f((bf16_t)cr[0]) * ei, bf2f((bf16_t)cr[1]) * ei, bf2f((bf16_t)cr[2]) * ei, bf2f((bf16_t)cr[3]) * ei,
                                            bf2f((bf16_t)cr[4]) * ei, bf2f((bf16_t)cr[5]) * ei, bf2f((bf16_t)cr[6]) * ei, bf2f((bf16_t)cr[7]) * ei);
                    y0 = MFMA(pack8(pa.x, pa.y, pa.z, pa.w, pb.x, pb.y, pb.z, pb.w), cf, y0);
                    y1 = MFMA(pack8(pc.x, pc.y, pc.z, pc.w, pd.x, pd.y, pd.z, pd.w), cf, y1);
                }
            }
#pragma unroll 1
            for (int jt = 0; jt < 4; ++jt) {
                if (d == 0 ? (jt > wave) : (jt < wave)) continue;
                f32x16 gt = zero16();
#pragma unroll
                for (int ks = 0; ks < 4; ++ks) gt = MFMA(ld8(Bn + (32 * jt + li) * NS + 16 * ks + 8 * lh), ld8(Cn + itok * NS + 16 * ks + 8 * lh), gt);
#pragma unroll
                for (int r = 0; r < 16; ++r) { const int j = 32 * jt + crow(r, lh); const bool valid = d == 0 ? (j <= itok) : (j >= itok);
                    const float df = fminf(ci - cum[d * 128 + j], 0.f);
                    gt[r] = valid ? gt[r] * __expf(df) * dtv[d * 128 + j] : 0.f; }
                const bf16x8 pf0 = pack8(gt[0], gt[1], gt[2], gt[3], gt[4], gt[5], gt[6], gt[7]), pf1 = pack8(gt[8], gt[9], gt[10], gt[11], gt[12], gt[13], gt[14], gt[15]);
                const bf16_t* xb = XT + li * TS + 32 * jt + 4 * lh;
                y0 = MFMA(ld4x2(xb, xb + 8), pf0, y0); y0 = MFMA(ld4x2(xb + 16, xb + 24), pf1, y0);
                y1 = MFMA(ld4x2(xb + 32 * TS, xb + 32 * TS + 8), pf0, y1); y1 = MFMA(ld4x2(xb + 32 * TS + 16, xb + 32 * TS + 24), pf1, y1);
            }
        }
        const float dsk = p.in[I_DSS][layer * 6 + hd];
        const bf16_t* zrow = UZ + (size_t)(r0 + itok) * 1024 + 640 + hd * 64;
#pragma unroll
        for (int pt = 0; pt < 2; ++pt)
#pragma unroll
            for (int rg = 0; rg < 4; ++rg) {
                const int p0 = 32 * pt + 8 * rg + 4 * lh;
                const u32x2 zz = *(const u32x2*)(zrow + p0);
                const float z[4] = { bf2f((bf16_t)(zz.x & 0xffff)), bf2f((bf16_t)(zz.x >> 16)), bf2f((bf16_t)(zz.y & 0xffff)), bf2f((bf16_t)(zz.y >> 16)) };
                float o[4];
#pragma unroll
                for (int e = 0; e < 4; ++e) { const float yv = (pt ? y1[4 * rg + e] : y0[4 * rg + e]) + bf2f(XT[(p0 + e) * TS + itok]) * dsk; o[e] = yv * silu(z[e]); ssq += o[e] * o[e]; }
                u32x2 w; w.x = pack2(o[0], o[1]); w.y = pack2(o[2], o[3]); *(u32x2*)(orow + hh * 64 + p0) = w;
            }
    }
    ssq += __shfl_xor(ssq, 32);
    const float rstd = 1.f / sqrtf(ssq * (1.f / 192.f) + EPS);
    const float* gn = p.in[I_GSO] + layer * 384 + g * 192;
#pragma unroll 1
    for (int q = 0; q < 24; ++q) {
        const int c = 8 * q + 4 * lh; const u32x2 w = *(const u32x2*)(orow + c); const f32x4 gg = *(const f32x4*)(gn + c);
        u32x2 o; o.x = pack2(bf2f((bf16_t)(w.x & 0xffff)) * rstd * gg.x, bf2f((bf16_t)(w.x >> 16)) * rstd * gg.y);
        o.y = pack2(bf2f((bf16_t)(w.y & 0xffff)) * rstd * gg.z, bf2f((bf16_t)(w.y >> 16)) * rstd * gg.w);
        *(u32x2*)(orow + c) = o;
    }
}

DI int dyn_next(const Params& p, unsigned char* smem, int word) {
    volatile LAS unsigned* st = (volatile LAS unsigned*)(smem + LDS_MAIN);
    __syncthreads();
    if (get_tid() == 0) st[2] = atomicAdd((unsigned*)(p.ws + WS_CTRL) + word, 1u);
    __syncthreads();
    const unsigned v = st[2];
    return v > 0x3fffffffu ? 0x3fffffff : (int)v;
}
#define XCD_TILE_LOOP(MT, NTN, m_, n_) for (int lt_ = (bid >> 3), m_ = 0, n_ = 0; (lt_ < ((MT) >> 3) * (NTN)) && ((m_ = (bid & 7) + 8 * (lt_ / (NTN))), (n_ = lt_ % (NTN)), true); lt_ += (G >> 3))
constexpr int NPHASE = 24, PPL = 12;
DI void run_phase(const Params& p, int ph, unsigned char* smem, int sub = 0) {
    const int layer = ph / PPL, k = ph % PPL, G = gridDim.x, bid = blockIdx.x;
    const float* MOD = (const float*)(p.ws + WS_MOD) + (size_t)layer * 5 * 6144;
    switch (k) {
    case 0: {
        if (layer != 0) break;
        const int n1 = 384, n4 = n1 + WT_IN;
        for (int it = dyn_next(p, smem, 20); it < n4; it = dyn_next(p, smem, 20)) {
            if (it < n1) mod_item(p, it, smem);
            else wprep_item(p, 0, it - n1, smem);
        }
    } break;
    case 1: {
        norm_rows(p, layer, 0, NT, layer == 0);
    } break;
    case 2: {
        bf16_t* PROJ = (bf16_t*)(p.ws + WS_PROJ);
        auto epi = [&](int r, int c, float v, float) { PROJ[(size_t)r * INP + c] = f2bf(v); };
        auto nocol = [&](int, int) { return 0.f; };
        XCD_TILE_LOOP(NT / 128, INP / 128, tm, tn) gemm_tile((const bf16_t*)(p.ws + WS_H), 1024, (const bf16_t*)(p.ws + wbase(layer) + W_IN), 1024, 1024, tm * 128, tn * 128, smem, epi, nocol);
        if (layer == 0) {
            const int n2 = 512, n3 = n2 + 32, n4 = n3 + (WT_TOTAL - WT_IN);
            for (int it = dyn_next(p, smem, 22); it < n4; it = dyn_next(p, smem, 22)) {
                if (it < n2) filt_item<SEQ>(p, 0, it, smem, (bf16_t*)(p.ws + WS_FL), (float*)(p.ws + WS_FPL));
                else if (it < n3) filt_item<CTX>(p, 0, it - n2, smem, (bf16_t*)(p.ws + WS_FC), (float*)(p.ws + WS_FPC));
                else wprep_item(p, 0, WT_IN + (it - n3), smem);
            }
        }
    } break;
    case 3: {
        const int n0 = NT / 128, n1 = n0 + (NT / 128) * 4, n3 = n1 + (NT / 64) * 12;
        for (int it = dyn_next(p, smem, 18 + layer); it < n3; it = dyn_next(p, smem, 18 + layer)) {
            if (it < n0) {
                if (sub == 0 || sub == 2) {
                    float* wl = (float*)smem;
                    __syncthreads();
                    { float tw[10];
#pragma unroll
                      for (int j = 0; j < 10; ++j) { const int i = get_tid() + 256 * j; tw[j] = (i < 1920) ? p.in[I_WCS][layer * 1920 + i] : p.in[I_BCS][layer * 640 + i - 1920]; }
#pragma unroll
                      for (int j = 0; j < 10; ++j) wl[get_tid() + 256 * j] = tw[j]; }
                    __syncthreads();
                    for (int q = 0; q < 4; ++q) ssmconv_item(p, layer, 4 * it + q, wl, wl + 1920);
                    __threadfence_block(); __syncthreads();
                    const int r0 = it * 128; int b, cidx;
                    if (r0 < NL) { b = r0 >> 12; cidx = 2 + ((r0 & 4095) >> 7); } else { b = (r0 - NL) >> 8; cidx = ((r0 - NL) & 255) >> 7; }
                    for (int hd = 0; hd < 6; ++hd) ssdA_item(p, layer, (b * 6 + hd) * NCHK + cidx, smem);
                }
            }
            else if (it < n1) { if (sub == 0 || sub == 1) qkv_item(p, layer, it - n0, smem); }
            else { if (sub == 0 || sub == 3) hyconv_item(p, layer, it - n1, smem); }
        }
    } break;
    case 4: break;
    case 5: ssd_scan(p, layer); break;
    case 6: {
        const int nH = 512, nA = 4 * 6 * 32, nS = 4 * NCHK * 2, nAc = (layer == 0) ? 4 * 6 * 2 : 0, nHc = (layer == 0) ? 256 : 0;
        const int n1 = nH, n2 = n1 + nA, n3 = n2 + nS, n4 = n3 + nAc, n5 = n4 + nHc;
        unsigned* ctr = (unsigned*)(p.ws + WS_CTRL) + 16 + layer;
        volatile LAS unsigned* st = (volatile LAS unsigned*)(smem + LDS_MAIN);
        for (;;) {
            __syncthreads();
            if (get_tid() == 0) st[2] = sub ? 0xffffffffu : atomicAdd(ctr, 1u);
            __syncthreads();
            const int it = (int)st[2];
            if (it < 0 || it >= n5) break;
            if (it < n1) hyena_lat_item(p, layer, it, smem);
            else if (it < n2) { const int j = it - n1, bh = j >> 5, qt = j & 31; attn_item(p, (const bf16_t*)(p.ws + WS_Q) + (size_t)bh * SEQ * 96, bh, qt * 128, NKEY, (bh / 6) * SEQ, smem); }
            else if (it < n3) { const int j = it - n2, cidx = (j >> 1) % NCHK; if (!(layer == 1 && cidx < 2)) ssdC_item(p, layer, j, smem); }
            else if (it < n4) { const int j = it - n3, bh = j >> 1, qt = j & 1; attn_item(p, (const bf16_t*)(p.ws + WS_QC) + (size_t)bh * CTX * 96, bh, qt * 128, CTX, NL + (bh / 6) * CTX, smem); }
            else hyena_ctx_item(p, layer, it - n4, smem);
        }
    } break;
    case 7: break;
    case 8: {
        const float* xin = p.in[I_X]; const float* cin = p.in[I_CTX]; float* out = p.out; float* XC = (float*)(p.ws + WS_XC);
        auto gate = [&](int m0_, int c) { return MOD[(m0_ < NL ? (m0_ >> 12) : 4) * 6144 + 2048 + c]; };
        auto epi = [&](int r, int c, float v, float ga) {
            if (r < NL) { const size_t o = (size_t)r * 1024 + c; out[o] = (layer == 0 ? xin[o] : out[o]) + ga * v; }
            else { const size_t o = (size_t)(r - NL) * 1024 + c; XC[o] = cin[o] + ga * v; } };
        XCD_TILE_LOOP((layer == 0 ? NT : NL) / 128, 8, tm, tn) gemm_tile((const bf16_t*)(p.ws + WS_MIX), 1024, (const bf16_t*)(p.ws + wbase(layer) + W_OUT), 1024, 1024, tm * 128, tn * 128, smem, epi, gate, (const bf16_t*)(p.ws + WS_HYOT));
        if (layer == 0) {
            const int n1 = 512, n2 = n1 + WT_TOTAL;
            for (int it = dyn_next(p, smem, 21); it < n2; it = dyn_next(p, smem, 21)) {
                if (it < n1) filt_item<SEQ>(p, 1, it, smem, (bf16_t*)(p.ws + WS_FL), (float*)(p.ws + WS_FPL));
                else wprep_item(p, 1, it - n1, smem);
            }
        }
    } break;
    case 9: norm_rows(p, layer, 1, layer == 0 ? NT : NL, false); break;
    case 10: {
        bf16_t* HID = (bf16_t*)(p.ws + WS_HID);
        auto epi = [&](int r, int c, float v, float) { const float a = fmaxf(v, 0.f); HID[(size_t)r * 4096 + c] = f2bf(a * a); };
        auto nocol = [&](int, int) { return 0.f; };
        XCD_TILE_LOOP((layer == 0 ? NT : NL) / 128, 32, tm, tn) gemm_tile((const bf16_t*)(p.ws + WS_H), 1024, (const bf16_t*)(p.ws + wbase(layer) + W_FF1), 1024, 1024, tm * 128, tn * 128, smem, epi, nocol);
    } break;
    case 11: {
        float* out = p.out; float* XC = (float*)(p.ws + WS_XC);
        auto gate = [&](int m0_, int c) { return MOD[(m0_ < NL ? (m0_ >> 12) : 4) * 6144 + 5120 + c]; };
        auto epi = [&](int r, int c, float v, float ga) {
            if (r < NL) out[(size_t)r * 1024 + c] += ga * v;
            else XC[(size_t)(r - NL) * 1024 + c] += ga * v; };
        XCD_TILE_LOOP(NL / 128, 8, tm, tn) gemm_tile((const bf16_t*)(p.ws + WS_HID), 4096, (const bf16_t*)(p.ws + wbase(layer) + W_FF2), 4096, 4096, tm * 128, tn * 128, smem, epi, gate);
        if (layer == 0) {
            auto epa = [&](int r, int c, float v, float ga) { atomicAdd(&XC[(size_t)(r - NL) * 1024 + c], ga * v); };
            for (int it = bid; it < 64 * 8; it += G) { const int tl = it >> 3, ks = it & 7;
                gemm_tile((const bf16_t*)(p.ws + WS_HID) + ks * 512, 4096, (const bf16_t*)(p.ws + wbase(layer) + W_FF2) + ks * 512, 4096, 512, NL + (tl / 8) * 128, (tl % 8) * 128, smem, epa, gate); }
        }
    } break;
    }
}

__global__ void __launch_bounds__(NTHREADS, 2) mega_fwd(Params p, int ph_lo, int ph_hi) {
    extern __shared__ __align__(16) unsigned char smem[];
    volatile LAS unsigned* st = (volatile LAS unsigned*)(smem + LDS_MAIN);
    if (__builtin_amdgcn_workitem_id_x() == 0) { st[0] = 0u; st[1] = 0u; }
    __syncthreads();
    const bool multi = ph_hi - ph_lo > 1;
    XcdBarrier xb; xb.bar = (unsigned*)(p.ws + WS_CTRL); xb.x = 0; xb.st = st;
    if (multi) xb = xcd_barrier_post((unsigned*)(p.ws + WS_CTRL), st);
    if (ph_hi < 0) cg::this_grid().sync();
    for (int ph = ph_lo; ph < ph_hi; ++ph) {
        if (ph == PPL || (ph % PPL) == 7 || (ph % PPL) == 4) continue;
        run_phase(p, ph, smem);
#if REP_MASK
        if ((REP_MASK >> (ph % PPL)) & 1) { xcd_barrier(xb); run_phase(p, ph, smem, PROBE_SUB); }
#endif
        if (ph + 1 < ph_hi) xcd_barrier(xb);
    }
}

extern "C" void kernel_launch(void* const* d_in, const int* in_sizes, int n_in, void* d_out, int out_size, void* d_ws, size_t ws_size, hipStream_t stream) {
    static int grid = 0;
    if (grid == 0) {
        if (n_in != 34 || ws_size < WS_TOTAL) { fprintf(stderr, "kernel_launch: unexpected n_in %d / ws %zu (need %zu)\n", n_in, ws_size, (size_t)WS_TOTAL); grid = -1; return; }
        int dev = 0, cus = 0, per_cu = 0;
        hipGetDevice(&dev);
        hipDeviceGetAttribute(&cus, hipDeviceAttributeMultiprocessorCount, dev);
        hipFuncSetAttribute((const void*)mega_fwd, hipFuncAttributeMaxDynamicSharedMemorySize, LDS_BYTES);
        hipOccupancyMaxActiveBlocksPerMultiprocessor(&per_cu, (const void*)mega_fwd, NTHREADS, LDS_BYTES);
        if (per_cu < 1) per_cu = 1;
        if (per_cu > 2) per_cu = 2;
        grid = cus * per_cu;
        fprintf(stderr, "kernel_launch: cus %d per_cu %d grid %d\n", cus, per_cu, grid);
    }
    if (grid < 0) return;
    Params p{};
    for (int i = 0; i < 34; ++i) p.in[i] = (const float*)d_in[i];
    p.out = (float*)d_out; p.ws = (unsigned char*)d_ws;
#if N_LAUNCH_MODE == 1
    hipMemsetAsync((unsigned char*)d_ws + WS_CTRL, 0, XCD_BAR_WORDS * 4, stream);
    int lo = 0, hi = NPHASE;
    void* args[] = { &p, &lo, &hi };
    hipError_t e = hipLaunchCooperativeKernel((const void*)mega_fwd, dim3(grid), dim3(NTHREADS), args, LDS_BYTES, stream);
    if (e != hipSuccess) fprintf(stderr, "cooperative launch failed: %s (grid %d)\n", hipGetErrorString(e), grid);
#else
    for (int ph = 0; ph < NPHASE; ++ph) { if (ph == PPL) continue; mega_fwd<<<dim3(grid), dim3(NTHREADS), LDS_BYTES, stream>>>(p, ph, ph + 1); }
#endif
}
```

```cpp
#include <hip/hip_runtime.h>
#include <hip/hip_cooperative_groups.h>
#include <cstdio>
#include <cstdint>
namespace cg = cooperative_groups;

#ifndef REP_MASK
#define REP_MASK 0
#endif
#define PROBE_SUB 0
#ifndef N_LAUNCH_MODE
#define N_LAUNCH_MODE 1
#endif

typedef unsigned short bf16_t;
typedef short bf16x8 __attribute__((ext_vector_type(8)));
typedef short s16x4 __attribute__((ext_vector_type(4)));
typedef float f32x16 __attribute__((ext_vector_type(16)));
typedef float f32x4 __attribute__((ext_vector_type(4)));
typedef unsigned u32x4 __attribute__((ext_vector_type(4)));
typedef unsigned u32x2 __attribute__((ext_vector_type(2)));
#define DI __device__ __forceinline__
#define MFMA(a, b, c) __builtin_amdgcn_mfma_f32_32x32x16_bf16((a), (b), (c), 0, 0, 0)

constexpr int D = 1024, NB = 4, SEQ = 4096, CTX = 256;
constexpr int NL = NB * SEQ, NC = NB * CTX, NT = NL + NC;
constexpr int INC = 2220, INP = 2304;
constexpr int O_CQ = 0, O_CKV = 256, O_KR = 384, O_Z = 416, O_XBC = 800, O_DT = 1440, O_HY = 1452;
constexpr int NKEY = CTX + SEQ;
constexpr int NCHK = 34;
constexpr float EPS = 1e-6f;
constexpr int LDS_MAIN = 73728;
constexpr int LDS_BYTES = LDS_MAIN + 16;
constexpr int NTHREADS = 256;

constexpr size_t WS_CTRL = 0;
constexpr size_t WS_MOD = 16384;
constexpr size_t WS_W = WS_MOD + 245760;
constexpr size_t W_IN = 0, W_OUT = W_IN + (size_t)INP * 1024 * 2, W_FF1 = W_OUT + 1024 * 1024 * 2, W_FF2 = W_FF1 + 4096 * 1024 * 2,
                 W_UQ = W_FF2 + 4096 * 1024 * 2, W_UKV = W_UQ + 576 * 256 * 2, W_END = W_UKV + 768 * 128 * 2;
constexpr size_t ST_BYTES = (size_t)2 * 4 * 6 * NCHK * 4096 * 4, WREG = ST_BYTES + 8192;
static_assert(W_END <= WREG, "weight region");
constexpr size_t WS_FL = WS_W + WREG;
constexpr size_t WS_FC = WS_FL + 2 * 256 * 8192 * 2;
constexpr size_t WS_FPL = WS_FC + 2 * 256 * 512 * 2;
constexpr size_t WS_FPC = WS_FPL + 128 * 1024 * 4;
constexpr size_t WS_XC = WS_FPC + 8 * 1024 * 4;
constexpr size_t WS_H = WS_XC + (size_t)NC * 1024 * 4;
constexpr size_t WS_Q = WS_H;
constexpr size_t WS_QC = WS_Q + (size_t)4 * 6 * 4096 * 96 * 2;
constexpr size_t WS_VT = WS_QC + (size_t)4 * 6 * 256 * 96 * 2;
constexpr size_t WS_PROJ = WS_H + (size_t)NT * 1024 * 2;
constexpr size_t WS_ST = WS_PROJ;
constexpr size_t WS_DEC = WS_ST + (size_t)2 * 4 * 6 * NCHK * 4096 * 4;
constexpr size_t WS_HYOT = WS_DEC + 8192;
constexpr size_t WS_MIX = WS_HYOT + (size_t)256 * NT * 2;
constexpr size_t WS_K = WS_PROJ + (size_t)NT * INP * 2;
constexpr size_t WS_UZ = WS_K + (size_t)4 * 6 * NKEY * 96 * 2;
constexpr size_t WS_DT = WS_UZ + (size_t)NT * 1024 * 2;
constexpr size_t WS_P = WS_DT + (size_t)NT * 12 * 4;
constexpr size_t WS_END = WS_P + (size_t)3 * 256 * NT * 2;
constexpr size_t WS_HID = WS_PROJ;
constexpr size_t WS_W2 = WS_END;
constexpr size_t WS_TOTAL = WS_W2 + WREG;
DI size_t wbase(int layer) { return layer ? WS_W2 : WS_W; }
DI size_t stbase(int layer) { return layer ? WS_W : WS_W2; }
static_assert(WS_MIX + (size_t)NT * 1024 * 2 <= WS_K, "alias overflow");
static_assert(WS_VT + (size_t)4 * 6 * 64 * NKEY * 2 <= WS_PROJ, "alias overflow");
static_assert(WS_HID + (size_t)NT * 4096 * 2 <= WS_END, "hid overflow");
static_assert(WS_TOTAL <= 268435456ull, "ws overflow");

struct Params { const float* in[34]; float* out; unsigned char* ws; };
enum { I_X = 0, I_C, I_CTX, I_CCTX, I_WMOD, I_BMOD, I_GMIX, I_GMLP, I_WIN, I_WOUT, I_GCQ, I_GCKV, I_WUQ, I_WUKV, I_GQH, I_GKH,
       I_WCS, I_BCS, I_ALOG, I_DTB, I_DSS, I_GSO, I_WCH, I_BCH, I_WF1, I_BF1, I_FQ1, I_WF2, I_BF2, I_FQ2, I_WF3, I_DSH, I_WFF1, I_WFF2 };

DI int get_tid() { int t = (int)__builtin_amdgcn_workitem_id_x(); asm volatile("" : "+v"(t)); return t; }
DI float bf2f(bf16_t v) { return __uint_as_float(((unsigned)v) << 16); }
DI unsigned pack2(float lo, float hi) { unsigned r; asm("v_cvt_pk_bf16_f32 %0, %1, %2" : "=v"(r) : "v"(lo), "v"(hi)); return r; }
DI bf16_t f2bf(float x) { unsigned r; asm("v_cvt_pk_bf16_f32 %0, %1, %1" : "=v"(r) : "v"(x)); return (bf16_t)r; }
DI int crow(int reg, int h) { return (reg & 3) + 8 * (reg >> 2) + 4 * h; }
DI f32x16 zero16() { f32x16 z; _Pragma("unroll") for (int i = 0; i < 16; ++i) z[i] = 0.f; return z; }
DI bf16x8 pack8(float a0, float a1, float a2, float a3, float a4, float a5, float a6, float a7) {
    u32x4 u; u.x = pack2(a0, a1); u.y = pack2(a2, a3); u.z = pack2(a4, a5); u.w = pack2(a6, a7); return __builtin_bit_cast(bf16x8, u);
}
DI bf16x8 ld8(const bf16_t* p) { return *(const bf16x8*)p; }
DI bf16x8 ld4x2(const bf16_t* p0, const bf16_t* p1) {
    u32x2 a = *(const u32x2*)p0, b = *(const u32x2*)p1; u32x4 u; u.x = a.x; u.y = a.y; u.z = b.x; u.w = b.y; return __builtin_bit_cast(bf16x8, u);
}
DI float xor_red32(float v) { v += __shfl_xor(v, 16); v += __shfl_xor(v, 8); v += __shfl_xor(v, 4); v += __shfl_xor(v, 2); v += __shfl_xor(v, 1); return v; }
DI float wave_sum(float v) { _Pragma("unroll") for (int o = 1; o < 64; o <<= 1) v += __shfl_xor(v, o); return v; }
DI float silu(float x) { return x / (1.f + __expf(-x)); }
DI float softplus(float x) { return fmaxf(x, 0.f) + log1pf(__expf(-fabsf(x))); }


#define XB_TMO      128
#define XB_XCNT(j)  (256  + 64 * (j))
#define XB_XSUB(j)  (1280 + 64 * (j))
#define XB_XGEN(j)  (2304 + 64 * (j))
#define XB_TOP      3328
#define XB_TOPGEN   3392
#define XCD_BAR_WORDS 3456
#define XB_SPIN_CAP (1u << 20)
#define LAS __attribute__((address_space(3)))
DI unsigned xb_ld(unsigned* p)              { return __hip_atomic_load(p, __ATOMIC_RELAXED, __HIP_MEMORY_SCOPE_AGENT); }
DI unsigned xb_add(unsigned* p, unsigned v) { return __hip_atomic_fetch_add(p, v, __ATOMIC_RELAXED, __HIP_MEMORY_SCOPE_AGENT); }
DI unsigned xb_xcc_id() { return (unsigned)__builtin_amdgcn_s_getreg((3 << 11) | 20) & 0xFu; }
#define XB_SPIN(cond, bar) do { unsigned _sp = 0; while (cond) { __builtin_amdgcn_s_sleep(1); \
    if ((++_sp & 255u) == 0u) { if (xb_ld(&(bar)[XB_TMO])) break; if (_sp > XB_SPIN_CAP) { atomicAdd(&(bar)[XB_TMO], 1u); break; } } } } while (0)
struct XcdBarrier { unsigned* bar; unsigned x; volatile LAS unsigned* st; };
DI XcdBarrier xcd_barrier_post(unsigned* bar, volatile LAS unsigned* st) {
    XcdBarrier b; b.bar = bar; b.x = xb_xcc_id(); b.st = st;
    if (__builtin_amdgcn_workitem_id_x() == 0) (void)xb_add(&bar[XB_XCNT(b.x)], 1u);
    return b;
}
DI void xcd_barrier_complete(unsigned* bar, unsigned x, unsigned& nloc, unsigned& nx) {
    const unsigned G = gridDim.x * gridDim.y * gridDim.z;
    unsigned sum, cnt, mine, sp = 0u;
    for (;;) {
        sum = 0u; cnt = 0u; mine = 0u;
#pragma unroll
        for (unsigned j = 0; j < 16; ++j) { const unsigned c = xb_ld(&bar[XB_XCNT(j)]); sum += c; cnt += (c > 0u) ? 1u : 0u; mine = (j == x) ? c : mine; }
        if (sum == G) break;
        __builtin_amdgcn_s_sleep(1);
        if ((++sp & 255u) == 0u) { if (xb_ld(&bar[XB_TMO])) break; if (sp > XB_SPIN_CAP) { atomicAdd(&bar[XB_TMO], 1u); break; } }
    }
    nloc = mine > 0u ? mine : 1u; nx = cnt > 0u ? cnt : 1u;
}
DI void xcd_barrier(const XcdBarrier& b) {
    asm volatile("s_waitcnt vmcnt(0)" ::: "memory");
    __syncthreads();
    if (__builtin_amdgcn_workitem_id_x() == 0) {
        unsigned* bar = b.bar;
        __builtin_amdgcn_s_waitcnt(0);
        unsigned nloc = b.st[0], nx = b.st[1];
        if (nloc == 0u) { xcd_barrier_complete(bar, b.x, nloc, nx); b.st[0] = nloc; b.st[1] = nx; }
        const unsigned old = xb_add(&bar[XB_XSUB(b.x)], 1u);
        const unsigned gen = old / nloc;
        if (old + 1u == (gen + 1u) * nloc) {
            __builtin_amdgcn_fence(__ATOMIC_RELEASE, "agent");
            asm volatile("s_waitcnt vmcnt(0)" ::: "memory");
            const unsigned og = xb_add(&bar[XB_TOP], 1u);
            const unsigned tg = og / nx;
            if (og + 1u == (tg + 1u) * nx) xb_add(&bar[XB_TOPGEN], 1u);
            else XB_SPIN(xb_ld(&bar[XB_TOPGEN]) == tg, bar);
            __builtin_amdgcn_fence(__ATOMIC_ACQUIRE, "agent");
            xb_add(&bar[XB_XGEN(b.x)], 1u);
            asm volatile("s_waitcnt vmcnt(0)" ::: "memory");
        } else {
            XB_SPIN(xb_ld(&bar[XB_XGEN(b.x)]) == gen, bar);
            __builtin_amdgcn_fence(__ATOMIC_ACQUIRE, "agent");
            asm volatile("s_waitcnt vmcnt(0)" ::: "memory");
        }
    }
    __syncthreads();
}

DI void row_info(int r, int& b, int& t, int& L) { if (r < NL) { b = r >> 12; t = r & 4095; L = SEQ; } else { int q = r - NL; b = q >> 8; t = q & 255; L = CTX; } }

template <class Epi, class ColV>
DI void gemm_tile(const bf16_t* __restrict__ A, int lda, const bf16_t* __restrict__ Bt, int ldb, int K, int m0, int n0, unsigned char* smem, Epi epi, ColV colv, const bf16_t* __restrict__ HYT = nullptr) {
    constexpr int LS = 72;
    bf16_t* As = (bf16_t*)smem;
    bf16_t* Bs = As + 2 * 128 * LS;
    const int tid = get_tid(), lane = tid & 63, wave = tid >> 6, wr = wave >> 1, wc = wave & 1, li = lane & 31, lh = lane >> 5;
    f32x16 acc[2][2];
#pragma unroll
    for (int a = 0; a < 2; ++a)
#pragma unroll
        for (int b = 0; b < 2; ++b) acc[a][b] = zero16();
    u32x4 R0[8], R1[8];
    const int nk = K >> 6;
    auto gload = [&](u32x4 (&r)[8], int kt) {
#pragma unroll
        for (int i = 0; i < 4; ++i) { int id = tid + 256 * i, row = id >> 3, kc = id & 7;
            if (HYT && kt >= 12) r[i] = *(const u32x4*)(HYT + (size_t)((kt - 12) * 64 + (id >> 4)) * NT + m0 + (id & 15) * 8);
            else r[i] = *(const u32x4*)(A + (size_t)(m0 + row) * lda + kt * 64 + kc * 8);
            r[4 + i] = *(const u32x4*)(Bt + (size_t)(n0 + row) * ldb + kt * 64 + kc * 8); }
    };
    auto sstore = [&](const u32x4 (&r)[8], int buf, int kt) {
#pragma unroll
        for (int i = 0; i < 4; ++i) { int id = tid + 256 * i, row = id >> 3, kc = id & 7;
            if (HYT && kt >= 12) { const int kk = id >> 4, rr = (id & 15) * 8; bf16_t* d = As + (buf * 128 + rr) * LS + kk; const bf16x8 v = __builtin_bit_cast(bf16x8, r[i]);
#pragma unroll
                for (int e = 0; e < 8; ++e) d[e * LS] = (bf16_t)v[e]; }
            else *(u32x4*)(As + (buf * 128 + row) * LS + kc * 8) = r[i];
            *(u32x4*)(Bs + (buf * 128 + row) * LS + kc * 8) = r[4 + i]; }
    };
    auto step = [&](int kt, u32x4 (&ldset)[8], const u32x4 (&stset)[8]) {
        const int buf = kt & 1;
        if (kt + 2 < nk) gload(ldset, kt + 2);
        const bf16_t* Ab = As + (buf * 128 + 64 * wr + li) * LS + 8 * lh;
        const bf16_t* Bb = Bs + (buf * 128 + 64 * wc + li) * LS + 8 * lh;
        bf16x8 fa[2][2], fb[2][2], ga[2][2], gb[2][2];
#pragma unroll
        for (int k2 = 0; k2 < 2; ++k2) { fa[k2][0] = ld8(Ab + 16 * k2); fa[k2][1] = ld8(Ab + 32 * LS + 16 * k2); fb[k2][0] = ld8(Bb + 16 * k2); fb[k2][1] = ld8(Bb + 32 * LS + 16 * k2); }
        __builtin_amdgcn_sched_barrier(0);
#pragma unroll
        for (int k2 = 0; k2 < 2; ++k2) {
            acc[0][0] = MFMA(fa[k2][0], fb[k2][0], acc[0][0]); acc[0][1] = MFMA(fa[k2][0], fb[k2][1], acc[0][1]);
            acc[1][0] = MFMA(fa[k2][1], fb[k2][0], acc[1][0]); acc[1][1] = MFMA(fa[k2][1], fb[k2][1], acc[1][1]);
        }
#pragma unroll
        for (int k2 = 0; k2 < 2; ++k2) { const int ks = 2 + k2; ga[k2][0] = ld8(Ab + 16 * ks); ga[k2][1] = ld8(Ab + 32 * LS + 16 * ks); gb[k2][0] = ld8(Bb + 16 * ks); gb[k2][1] = ld8(Bb + 32 * LS + 16 * ks); }
#pragma unroll
        for (int k2 = 0; k2 < 2; ++k2) {
            acc[0][0] = MFMA(ga[k2][0], gb[k2][0], acc[0][0]); acc[0][1] = MFMA(ga[k2][0], gb[k2][1], acc[0][1]);
            acc[1][0] = MFMA(ga[k2][1], gb[k2][0], acc[1][0]); acc[1][1] = MFMA(ga[k2][1], gb[k2][1], acc[1][1]);
        }
        if (kt + 1 < nk) sstore(stset, buf ^ 1, kt + 1);
#pragma unroll
        for (int i = 0; i < 8; ++i) { __builtin_amdgcn_sched_group_barrier(0x008, 1, 0); __builtin_amdgcn_sched_group_barrier(0x100, 1, 0); }
#pragma unroll
        for (int i = 0; i < 8; ++i) { __builtin_amdgcn_sched_group_barrier(0x008, 1, 0); __builtin_amdgcn_sched_group_barrier(0x200, 1, 0); }
        __builtin_amdgcn_sched_barrier(0);
        __syncthreads();
    };
    gload(R0, 0); gload(R1, 1);
    sstore(R0, 0, 0); __syncthreads();
    for (int kt = 0; kt < nk; kt += 2) {
        step(kt, R0, R1);
        if (kt + 1 < nk) step(kt + 1, R1, R0);
    }
    const float cv0 = colv(m0, n0 + 64 * wc + li), cv1 = colv(m0, n0 + 64 * wc + 32 + li);
#pragma unroll
    for (int mi = 0; mi < 2; ++mi)
#pragma unroll
        for (int ni = 0; ni < 2; ++ni)
#pragma unroll
            for (int reg = 0; reg < 16; ++reg)
                epi(m0 + 64 * wr + 32 * mi + crow(reg, lh), n0 + 64 * wc + 32 * ni + li, acc[mi][ni][reg], ni ? cv1 : cv0);
}

DI void transpose_f32(const float* __restrict__ src, int ld_src, int Cvalid, bf16_t* __restrict__ dst, int ld_dst, int r0, int c0, const float* rscale, float* tile) {
    const int tid = get_tid();
    float tv[16];
#pragma unroll
    for (int j = 0; j < 16; ++j) { const int i = tid + 256 * j, r = i >> 6, c = i & 63; tv[j] = (c0 + c < Cvalid) ? src[(size_t)(r0 + r) * ld_src + c0 + c] : 0.f; }
#pragma unroll
    for (int j = 0; j < 16; ++j) { const int i = tid + 256 * j, r = i >> 6, c = i & 63; float v = tv[j]; if (rscale) v *= rscale[r0 + r]; tile[r * 65 + c] = v; }
    __syncthreads();
#pragma unroll
    for (int j = 0; j < 16; ++j) { const int i = tid + 256 * j, c = i >> 6, r = i & 63; dst[(size_t)(c0 + c) * ld_dst + r0 + r] = f2bf(tile[r * 65 + c]); }
    __syncthreads();
}
DI void transpose_bf16(const bf16_t* __restrict__ src, int ld_src, bf16_t* __restrict__ dst, int ld_dst, int r0, int c0, float* tile) {
    const int tid = get_tid();
    bf16_t tv[16];
#pragma unroll
    for (int j = 0; j < 16; ++j) { const int i = tid + 256 * j, r = i >> 6, c = i & 63; tv[j] = src[(size_t)(r0 + r) * ld_src + c0 + c]; }
#pragma unroll
    for (int j = 0; j < 16; ++j) { const int i = tid + 256 * j, r = i >> 6, c = i & 63; tile[r * 65 + c] = bf2f(tv[j]); }
    __syncthreads();
#pragma unroll
    for (int j = 0; j < 16; ++j) { const int i = tid + 256 * j, c = i >> 6, r = i & 63; dst[(size_t)(c0 + c) * ld_dst + r0 + r] = f2bf(tile[r * 65 + c]); }
    __syncthreads();
}
constexpr int WT_IN = 16 * 36, WT_OUT = 16 * 16, WT_FF1 = 16 * 64, WT_FF2 = 64 * 16, WT_UQ = 4 * 9, WT_UKV = 2 * 12;
constexpr int WT_TOTAL = WT_IN + WT_OUT + WT_FF1 + WT_FF2 + WT_UQ + WT_UKV;
DI void wprep_item(const Params& p, int layer, int it, unsigned char* smem) {
    float* tile = (float*)smem; bf16_t* W = (bf16_t*)(p.ws + wbase(layer));
    if (it < WT_IN) { int kt = it / 36, nt = it % 36; transpose_f32(p.in[I_WIN] + (size_t)layer * 1024 * INC, INC, INC, (bf16_t*)((unsigned char*)W + W_IN), 1024, kt * 64, nt * 64, nullptr, tile); return; } it -= WT_IN;
    if (it < WT_OUT) { int kt = it / 16, nt = it % 16; transpose_f32(p.in[I_WOUT] + (size_t)layer * 1024 * 1024, 1024, 1024, (bf16_t*)((unsigned char*)W + W_OUT), 1024, kt * 64, nt * 64, nullptr, tile); return; } it -= WT_OUT;
    if (it < WT_FF1) { int kt = it / 64, nt = it % 64; transpose_f32(p.in[I_WFF1] + (size_t)layer * 1024 * 4096, 4096, 4096, (bf16_t*)((unsigned char*)W + W_FF1), 1024, kt * 64, nt * 64, nullptr, tile); return; } it -= WT_FF1;
    if (it < WT_FF2) { int kt = it / 16, nt = it % 16; transpose_f32(p.in[I_WFF2] + (size_t)layer * 4096 * 1024, 1024, 1024, (bf16_t*)((unsigned char*)W + W_FF2), 4096, kt * 64, nt * 64, nullptr, tile); return; } it -= WT_FF2;
    if (it < WT_UQ) { int kt = it / 9, nt = it % 9; transpose_f32(p.in[I_WUQ] + (size_t)layer * 256 * 576, 576, 576, (bf16_t*)((unsigned char*)W + W_UQ), 256, kt * 64, nt * 64, p.in[I_GCQ] + layer * 256, tile); return; } it -= WT_UQ;
    { int kt = it / 12, nt = it % 12; transpose_f32(p.in[I_WUKV] + (size_t)layer * 128 * 768, 768, 768, (bf16_t*)((unsigned char*)W + W_UKV), 128, kt * 64, nt * 64, p.in[I_GCKV] + layer * 128, tile); }
}
DI void mod_item(const Params& p, int it, unsigned char* smem) {
    const int layer = it / 192, c0 = (it % 192) * 32, tid = get_tid();
    float* sl = (float*)smem;
    float* red = sl + 5 * 1024;
#pragma unroll
    for (int j = 0; j < 20; ++j) { const int i = tid + 256 * j, b = i >> 10, k = i & 1023; float v = (b < 4) ? p.in[I_C][b * 1024 + k] : p.in[I_CCTX][k]; sl[i] = silu(v); }
    __syncthreads();
    const int col = tid & 31, kg = tid >> 5;
    const float* W = p.in[I_WMOD] + (size_t)layer * 1024 * 6144 + c0 + col;
    float a0 = 0, a1 = 0, a2 = 0, a3 = 0, a4 = 0;
#pragma unroll 8
    for (int k = kg * 128; k < kg * 128 + 128; ++k) { float w = W[(size_t)k * 6144]; a0 += sl[k] * w; a1 += sl[1024 + k] * w; a2 += sl[2048 + k] * w; a3 += sl[3072 + k] * w; a4 += sl[4096 + k] * w; }
    red[(kg * 5 + 0) * 32 + col] = a0; red[(kg * 5 + 1) * 32 + col] = a1; red[(kg * 5 + 2) * 32 + col] = a2; red[(kg * 5 + 3) * 32 + col] = a3; red[(kg * 5 + 4) * 32 + col] = a4;
    __syncthreads();
    if (tid < 160) { int b = tid >> 5, c = tid & 31; float s = p.in[I_BMOD][layer * 6144 + c0 + c];
#pragma unroll
        for (int g = 0; g < 8; ++g) s += red[(g * 5 + b) * 32 + c];
        ((float*)(p.ws + WS_MOD))[(size_t)(layer * 5 + b) * 6144 + c0 + c] = s; }
    __syncthreads();
}
template <int L>
DI void filt_item(const Params& p, int layer, int it, unsigned char* smem, bf16_t* Fout, float* Part) {
    const int lb = it >> 2, cb = it & 3, tid = get_tid();
    float* feats = (float*)smem;
    float* h1 = feats + 32 * 33;
    float* h2 = h1 + 32 * 64;
    float* w1s = h2 + 32 * 64;
    float* w2s = w1s + 33 * 64;
    {
        const float* w1g = p.in[I_WF1] + layer * 33 * 64; const float* w2g = p.in[I_WF2] + layer * 64 * 64;
        float t1[9], t2[16];
#pragma unroll
        for (int j = 0; j < 9; ++j) { const int i = tid + 256 * j; t1[j] = (i < 33 * 64) ? w1g[i] : 0.f; }
#pragma unroll
        for (int j = 0; j < 16; ++j) t2[j] = w2g[tid + 256 * j];
#pragma unroll
        for (int j = 0; j < 9; ++j) { const int i = tid + 256 * j; if (i < 33 * 64) w1s[i] = t1[j]; }
#pragma unroll
        for (int j = 0; j < 16; ++j) w2s[tid + 256 * j] = t2[j];
    }
    const float wstep = (float)(2.0 * 3.14159265358979323846 / (double)L);
#pragma unroll 1
    for (int i = tid; i < 32 * 33; i += 256) { int lg = i / 33, f = i % 33, lag = lb * 32 + lg; float v;
        if (f == 0) v = (float)lag / (float)(L - 1);
        else { int bi = (f - 1) & 15; float band = 1e-4f + (float)bi * ((15.f - 1e-4f) / 15.f); float ang = band * (wstep * (float)lag); v = (f <= 16) ? cosf(ang) : -sinf(ang); }
        feats[i] = v; }
    __syncthreads();
    const float* w1 = w1s; const float* w2 = w2s;
#pragma unroll 1
    for (int i = tid; i < 2048; i += 256) { int lg = i >> 6, j = i & 63; float s = p.in[I_BF1][layer * 64 + j];
#pragma unroll 3
        for (int f = 0; f < 33; ++f) s += feats[lg * 33 + f] * w1[f * 64 + j];
        h1[i] = sinf(p.in[I_FQ1][layer * 64 + j] * s); }
    __syncthreads();
#pragma unroll 1
    for (int i = tid; i < 2048; i += 256) { int lg = i >> 6, j = i & 63; float s = p.in[I_BF2][layer * 64 + j];
#pragma unroll 4
        for (int f = 0; f < 64; ++f) s += h1[lg * 64 + f] * w2[f * 64 + j];
        h2[i] = sinf(p.in[I_FQ2][layer * 64 + j] * s); }
    __syncthreads();
    const int col = cb * 256 + tid, dir = col >> 9, o = (col >> 8) & 1, ch = col & 255;
    const float* w3 = p.in[I_WF3] + (size_t)layer * 64 * 1024 + col;
    const float d0 = -4.605170185988091f / 1.5f, d1 = -4.605170185988091f / 0.3f;
    const float delta = fabsf(d0 + (float)ch * ((d1 - d0) / 255.f));
    bf16_t* F = Fout + (size_t)(o * 256 + ch) * (2 * L);
    float asum = 0.f;
    float wreg[64];
#pragma unroll
    for (int k = 0; k < 64; ++k) wreg[k] = w3[k * 1024];
#pragma unroll 1
    for (int lg = 0; lg < 32; ++lg) {
        float a0 = 0.f, a1 = 0.f;
#pragma unroll
        for (int k = 0; k < 64; k += 8) { const f32x4 hv = *(const f32x4*)(h2 + lg * 64 + k), hw = *(const f32x4*)(h2 + lg * 64 + k + 4);
            a0 += hv.x * wreg[k] + hv.y * wreg[k + 1] + hv.z * wreg[k + 2] + hv.w * wreg[k + 3];
            a1 += hw.x * wreg[k + 4] + hw.y * wreg[k + 5] + hw.z * wreg[k + 6] + hw.w * wreg[k + 7]; }
        const int lag = lb * 32 + lg; const float t01 = (float)lag / (float)(L - 1); const float v = (a0 + a1) * __expf(-t01 * delta);
        if (dir == 0) { F[L + lag] = f2bf(v); asum += fabsf(v); }
        else { if (lag == 0) F[0] = 0; else { F[L - lag] = f2bf(v); asum += fabsf(v); } }
    }
    Part[lb * 1024 + col] = asum;
    __syncthreads();
}

DI void norm_rows(const Params& p, int layer, int which  , int nrows, bool from_input) {
    const int lane = get_tid() & 63, gw = blockIdx.x * 4 + (get_tid() >> 6), NGW = gridDim.x * 4;
    const float* g = p.in[which ? I_GMLP : I_GMIX] + layer * 1024;
    const float* MOD = (const float*)(p.ws + WS_MOD) + (size_t)layer * 5 * 6144;
    bf16_t* H = (bf16_t*)(p.ws + WS_H);
    const int rpw = (nrows + NGW - 1) / NGW, rbeg = gw * rpw, rend = min(nrows, rbeg + rpw);
    f32x4 ga[4], sb[4]; int mb_cur = -1;
    auto rowsrc = [&](int r) -> const float* {
        return (r < NL) ? (from_input ? p.in[I_X] : p.out) + (size_t)r * 1024 : (from_input ? p.in[I_CTX] : (const float*)(p.ws + WS_XC)) + (size_t)(r - NL) * 1024; };
    f32x4 v[4], vn[4];
    if (rbeg < rend) { const float* s0 = rowsrc(rbeg);
#pragma unroll
        for (int j = 0; j < 4; ++j) v[j] = *(const f32x4*)(s0 + 256 * j + 4 * lane); }
    for (int r = rbeg; r < rend; ++r) {
        const int mb = (r < NL) ? (r >> 12) : 4;
        if (r + 1 < rend) { const float* s1 = rowsrc(r + 1);
#pragma unroll
            for (int j = 0; j < 4; ++j) vn[j] = *(const f32x4*)(s1 + 256 * j + 4 * lane); }
        float ss = 0.f;
#pragma unroll
        for (int j = 0; j < 4; ++j) ss += v[j].x * v[j].x + v[j].y * v[j].y + v[j].z * v[j].z + v[j].w * v[j].w;
        if (mb != mb_cur) {
            const float* sh = MOD + mb * 6144 + (which ? 3072 : 0); const float* sc = sh + 1024;
#pragma unroll
            for (int j = 0; j < 4; ++j) { const int c = 256 * j + 4 * lane; const f32x4 gg = *(const f32x4*)(g + c), s1 = *(const f32x4*)(sc + c); sb[j] = *(const f32x4*)(sh + c);
                ga[j].x = gg.x * (1.f + s1.x); ga[j].y = gg.y * (1.f + s1.y); ga[j].z = gg.z * (1.f + s1.z); ga[j].w = gg.w * (1.f + s1.w); }
            mb_cur = mb;
        }
        const float rstd = 1.f / sqrtf(wave_sum(ss) * (1.f / 1024.f) + EPS);
#pragma unroll
        for (int j = 0; j < 4; ++j) { const int c = 256 * j + 4 * lane;
            const float o0 = v[j].x * rstd * ga[j].x + sb[j].x, o1 = v[j].y * rstd * ga[j].y + sb[j].y, o2 = v[j].z * rstd * ga[j].z + sb[j].z, o3 = v[j].w * rstd * ga[j].w + sb[j].w;
            u32x2 w; w.x = pack2(o0, o1); w.y = pack2(o2, o3); *(u32x2*)(H + (size_t)r * 1024 + c) = w; }
#pragma unroll
        for (int j = 0; j < 4; ++j) v[j] = vn[j];
    }
}

DI void hyconv_item(const Params& p, int layer, int it, unsigned char* smem) {
    const int rt = it / 12, ct = it % 12, r0 = rt * 64, c0 = ct * 64, tid = get_tid();
    float* tile = (float*)smem;
    const bf16_t* PROJ = (const bf16_t*)(p.ws + WS_PROJ);
    int b, t, L; row_info(r0, b, t, L);
    u32x2 hv[5];
#pragma unroll
    for (int j = 0; j < 5; ++j) { const int i = tid + 256 * j, rr = i >> 4, c = (i & 15) * 4, tt = t + rr - 1; hv[j].x = 0u; hv[j].y = 0u;
        if (i < 66 * 16 && tt >= 0 && tt < L) hv[j] = *(const u32x2*)(PROJ + (size_t)(r0 + rr - 1) * INP + O_HY + c0 + c); }
#pragma unroll
    for (int j = 0; j < 5; ++j) { const int i = tid + 256 * j, rr = i >> 4, c = (i & 15) * 4; const u32x2 v = hv[j];
        if (i < 66 * 16) { float* tp = tile + rr * 65 + c; tp[0] = bf2f((bf16_t)(v.x & 0xffff)); tp[1] = bf2f((bf16_t)(v.x >> 16)); tp[2] = bf2f((bf16_t)(v.y & 0xffff)); tp[3] = bf2f((bf16_t)(v.y >> 16)); } }
    const float* w = p.in[I_WCH] + layer * 3 * 768; const float* bb = p.in[I_BCH] + layer * 768;
    bf16_t* P = (bf16_t*)(p.ws + WS_P);
    float* wl = tile + 66 * 65;
    { const int q = tid >> 6, c = tid & 63; wl[tid] = (q == 0) ? bb[c0 + c] : w[(q - 1) * 768 + c0 + c]; }
    __syncthreads();
#pragma unroll
    for (int j = 0; j < 8; ++j) { const int i = tid + 256 * j, c = i >> 5, rp = (i & 31) * 2, cc = c0 + c;
        const float t0 = tile[rp * 65 + c], t1 = tile[(rp + 1) * 65 + c], t2 = tile[(rp + 2) * 65 + c], t3 = tile[(rp + 3) * 65 + c];
        const float bq = wl[c], wa = wl[64 + c], wb = wl[128 + c], wc = wl[192 + c];
        const float v0 = bq + wa * t0 + wb * t1 + wc * t2, v1 = bq + wa * t1 + wb * t2 + wc * t3;
        *(unsigned*)(P + (size_t)cc * NT + r0 + rp) = pack2(v0, v1); }
    __syncthreads();
}
DI void ssmconv_item(const Params& p, int layer, int it, const float* w, const float* bb) {
    const int r0 = it * 32, tid = get_tid();
    const bf16_t* PROJ = (const bf16_t*)(p.ws + WS_PROJ); bf16_t* UZ = (bf16_t*)(p.ws + WS_UZ); float* DT = (float*)(p.ws + WS_DT);
    int b, t0, L; row_info(r0, b, t0, L);
#pragma unroll 1
    for (int j0 = 0; j0 < 10; j0 += 5) {
        bf16x8 xc[5], xp[5], xn[5];
#pragma unroll
        for (int j = 0; j < 5; ++j) { const int i = tid + 256 * (j0 + j), rl = i / 80, c = (i - rl * 80) * 8, t = t0 + rl; const size_t r = r0 + rl;
            const bf16_t* src = PROJ + r * INP + O_XBC + c;
            xc[j] = ld8(src); xp[j] = xc[j]; xn[j] = xc[j];
            if (t > 0) xp[j] = ld8(src - INP);
            if (t < L - 1) xn[j] = ld8(src + INP); }
#pragma unroll
        for (int j = 0; j < 5; ++j) { const int i = tid + 256 * (j0 + j), rl = i / 80, c = (i - rl * 80) * 8, t = t0 + rl; const size_t r = r0 + rl;
            const bool hp = t > 0, hn = t < L - 1;
            const f32x4 b0 = *(const f32x4*)(bb + c), b1 = *(const f32x4*)(bb + c + 4), wa0 = *(const f32x4*)(w + c), wa1 = *(const f32x4*)(w + c + 4),
                        wb0 = *(const f32x4*)(w + 640 + c), wb1 = *(const f32x4*)(w + 640 + c + 4), wc0 = *(const f32x4*)(w + 1280 + c), wc1 = *(const f32x4*)(w + 1280 + c + 4);
            const float bv[8] = { b0.x, b0.y, b0.z, b0.w, b1.x, b1.y, b1.z, b1.w }, w0v[8] = { wa0.x, wa0.y, wa0.z, wa0.w, wa1.x, wa1.y, wa1.z, wa1.w },
                        w1v[8] = { wb0.x, wb0.y, wb0.z, wb0.w, wb1.x, wb1.y, wb1.z, wb1.w }, w2v[8] = { wc0.x, wc0.y, wc0.z, wc0.w, wc1.x, wc1.y, wc1.z, wc1.w };
            float o[8];
#pragma unroll
            for (int e = 0; e < 8; ++e) { float v = bv[e] + w1v[e] * bf2f((bf16_t)xc[j][e]);
                if (hp) v += w0v[e] * bf2f((bf16_t)xp[j][e]);
                if (hn) v += w2v[e] * bf2f((bf16_t)xn[j][e]);
                o[e] = silu(v); }
            *(bf16x8*)(UZ + r * 1024 + c) = pack8(o[0], o[1], o[2], o[3], o[4], o[5], o[6], o[7]); }
    }
    { u32x4 zc[6];
#pragma unroll
      for (int j = 0; j < 6; ++j) { const int i = tid + 256 * j, rl = i / 48, c = (i - rl * 48) * 8; zc[j] = *(const u32x4*)(PROJ + (size_t)(r0 + rl) * INP + O_Z + c); }
#pragma unroll
      for (int j = 0; j < 6; ++j) { const int i = tid + 256 * j, rl = i / 48, c = (i - rl * 48) * 8; *(u32x4*)(UZ + (size_t)(r0 + rl) * 1024 + 640 + c) = zc[j]; } }
    for (int i = tid; i < 32 * 12; i += 256) { const int rl = i / 12, c = i - rl * 12; const size_t r = r0 + rl;
        DT[r * 12 + c] = softplus(bf2f(PROJ[r * INP + O_DT + c]) + p.in[I_DTB][layer * 12 + c]); }
}
DI void qkv_item(const Params& p, int layer, int it, unsigned char* smem) {
    const int tid = get_tid(), lane = tid & 63, wave = tid >> 6, li = lane & 31, lh = lane >> 5;
    const int ug = it & 3, hd0 = 3 * (ug & 1);
    const int rbase = (it >> 2) * 128 + 32 * wave;
    const bf16_t* PROJ = (const bf16_t*)(p.ws + WS_PROJ);
    bf16_t* Ws = (bf16_t*)smem;
    int b, t0, L; row_info(rbase, b, t0, L);
    const bool lat = rbase < NL;
    float cs[16], sn[16];
    {
        const int axis = li >> 4, f = li & 7; const float inv = exp2f(-(float)f * (13.287712379549449f / 8.f));
#pragma unroll
        for (int reg = 0; reg < 16; ++reg) { int t = t0 + crow(reg, lh); float pos = (float)(axis ? (t & 63) : (t >> 6)); const float ang = pos * inv; cs[reg] = __cosf(ang); sn[reg] = __sinf(ang); }
    }
    const bool second = (li >> 3) & 1;
    if (ug < 2) {
        const bf16_t* Wq = (const bf16_t*)(p.ws + wbase(layer) + W_UQ);
        const float* gq = p.in[I_GQH] + layer * 96;
        const bf16_t* arow = PROJ + (size_t)(rbase + li) * INP + O_CQ + 8 * lh;
        float ss = 0.f;
#pragma unroll 1
        for (int kh = 0; kh < 2; ++kh) { bf16x8 a[8];
#pragma unroll
            for (int ks = 0; ks < 8; ++ks) a[ks] = ld8(arow + 128 * kh + 16 * ks);
#pragma unroll
            for (int ks = 0; ks < 8; ++ks) {
#pragma unroll
                for (int j = 0; j < 8; ++j) { float x = bf2f((bf16_t)a[ks][j]); ss += x * x; } } }
        ss += __shfl_xor(ss, 32);
        const float alpha = 1.f / sqrtf(ss * (1.f / 256.f) + EPS);
        float al[16];
#pragma unroll
        for (int reg = 0; reg < 16; ++reg) al[reg] = __shfl(alpha, crow(reg, lh));
        const float g0 = gq[li], g1 = gq[32 + li], g2 = gq[64 + li];
#pragma unroll 1
        for (int hd = hd0; hd < hd0 + 3; ++hd) {
            __syncthreads();
#pragma unroll 1
            for (int jb = 0; jb < 12; jb += 6) { u32x4 sw[6];
#pragma unroll
              for (int j = 0; j < 6; ++j) { const int i = tid + 256 * (jb + j), n = i >> 5, kc = i & 31; sw[j] = *(const u32x4*)(Wq + (size_t)(hd * 96 + n) * 256 + kc * 8); }
#pragma unroll
              for (int j = 0; j < 6; ++j) { const int i = tid + 256 * (jb + j), n = i >> 5, kc = i & 31; *(u32x4*)(Ws + n * 264 + kc * 8) = sw[j]; } }
            __syncthreads();
            f32x16 c0 = zero16(), c1 = zero16(), c2 = zero16();
            const bf16_t* wb = Ws + li * 264 + 8 * lh;
#pragma unroll 1
            for (int kh = 0; kh < 4; ++kh) { bf16x8 a[4];
#pragma unroll
                for (int ks = 0; ks < 4; ++ks) a[ks] = ld8(arow + 64 * kh + 16 * ks);
                __builtin_amdgcn_sched_barrier(0);
#pragma unroll
                for (int ks = 0; ks < 4; ++ks) { const bf16_t* w_ = wb + 64 * kh + 16 * ks;
                    c0 = MFMA(a[ks], ld8(w_), c0); c1 = MFMA(a[ks], ld8(w_ + 32 * 264), c1); c2 = MFMA(a[ks], ld8(w_ + 64 * 264), c2);
                    if ((ks & 1) == 1) __builtin_amdgcn_sched_barrier(0);
                } }
            bf16_t* Qp = lat ? (bf16_t*)(p.ws + WS_Q) + ((size_t)(b * 6 + hd) * SEQ + t0) * 96 : (bf16_t*)(p.ws + WS_QC) + ((size_t)(b * 6 + hd) * CTX + t0) * 96;
#pragma unroll
            for (int reg = 0; reg < 16; ++reg) {
                float s2 = xor_red32(c0[reg] * c0[reg] + c1[reg] * c1[reg] + c2[reg] * c2[reg]);
                const float ar = al[reg], rs = 1.f / sqrtf(ar * ar * s2 * (1.f / 96.f) + EPS), sc = ar * rs;
                float v0 = c0[reg] * sc * g0, v1 = c1[reg] * sc * g1, v2 = c2[reg] * sc * g2;
                float pr = __shfl_xor(v2, 8);
                if (lat) v2 = second ? (v2 * cs[reg] + pr * sn[reg]) : (v2 * cs[reg] - pr * sn[reg]);
                bf16_t* q = Qp + (size_t)crow(reg, lh) * 96;
                q[li] = f2bf(v0); q[32 + li] = f2bf(v1); q[64 + li] = f2bf(v2);
                if ((reg & 3) == 3) __builtin_amdgcn_sched_barrier(0);
            }
        }
        __syncthreads();
    }
    else {
        const bf16_t* Wkv = (const bf16_t*)(p.ws + wbase(layer) + W_UKV);
        const float* gk = p.in[I_GKH] + layer * 96;
        const bf16_t* arow = PROJ + (size_t)(rbase + li) * INP + O_CKV + 8 * lh;
        float ss = 0.f;
        { bf16x8 a[8];
#pragma unroll
          for (int ks = 0; ks < 8; ++ks) a[ks] = ld8(arow + 16 * ks);
#pragma unroll
          for (int ks = 0; ks < 8; ++ks) {
#pragma unroll
            for (int j = 0; j < 8; ++j) { float x = bf2f((bf16_t)a[ks][j]); ss += x * x; } } }
        ss += __shfl_xor(ss, 32);
        const float alpha = 1.f / sqrtf(ss * (1.f / 128.f) + EPS);
        float al[16], krv[16];
#pragma unroll
        for (int reg = 0; reg < 16; ++reg) { al[reg] = __shfl(alpha, crow(reg, lh)); krv[reg] = bf2f(PROJ[(size_t)(rbase + crow(reg, lh)) * INP + O_KR + li]); }
        const float g0 = gk[li], g1 = gk[32 + li], g2 = gk[64 + li];
        const int kbase = lat ? (CTX + t0) : t0;
#pragma unroll 1
        for (int hd = hd0; hd < hd0 + 3; ++hd) {
            __syncthreads();
#pragma unroll 1
            for (int jb = 0; jb < 8; jb += 4) { u32x4 sw[4];
#pragma unroll
              for (int j = 0; j < 4; ++j) { const int i = tid + 256 * (jb + j), n = i >> 4, kc = i & 15; sw[j] = *(const u32x4*)(Wkv + (size_t)(hd * 128 + n) * 128 + kc * 8); }
#pragma unroll
              for (int j = 0; j < 4; ++j) { const int i = tid + 256 * (jb + j), n = i >> 4, kc = i & 15; *(u32x4*)(Ws + n * 136 + kc * 8) = sw[j]; } }
            __syncthreads();
            f32x16 c0 = zero16(), c1 = zero16(), c2 = zero16(), c3 = zero16();
            const bf16_t* wb = Ws + li * 136 + 8 * lh;
#pragma unroll 1
            for (int kh = 0; kh < 2; ++kh) { bf16x8 a[4];
#pragma unroll
                for (int ks = 0; ks < 4; ++ks) a[ks] = ld8(arow + 64 * kh + 16 * ks);
                __builtin_amdgcn_sched_barrier(0);
#pragma unroll
                for (int ks = 0; ks < 4; ++ks) { const bf16_t* w_ = wb + 64 * kh + 16 * ks;
                    c0 = MFMA(a[ks], ld8(w_), c0); c1 = MFMA(a[ks], ld8(w_ + 32 * 136), c1);
                    c2 = MFMA(a[ks], ld8(w_ + 64 * 136), c2); c3 = MFMA(a[ks], ld8(w_ + 96 * 136), c3);
                    __builtin_amdgcn_sched_barrier(0);
                } }
            bf16_t* Kp = (bf16_t*)(p.ws + WS_K) + ((size_t)(b * 6 + hd) * NKEY + kbase) * 96;
            bf16_t* Vp = (bf16_t*)(p.ws + WS_VT) + ((size_t)(b * 6 + hd) * 64) * NKEY + kbase;
#pragma unroll
            for (int reg = 0; reg < 16; ++reg) {
                const float ar = al[reg];
                float s2 = xor_red32(ar * ar * (c0[reg] * c0[reg] + c1[reg] * c1[reg]) + krv[reg] * krv[reg]);
                const float rs = 1.f / sqrtf(s2 * (1.f / 96.f) + EPS);
                float v0 = c0[reg] * ar * rs * g0, v1 = c1[reg] * ar * rs * g1, v2 = krv[reg] * rs * g2;
                float pr = __shfl_xor(v2, 8);
                if (lat) v2 = second ? (v2 * cs[reg] + pr * sn[reg]) : (v2 * cs[reg] - pr * sn[reg]);
                bf16_t* k = Kp + (size_t)crow(reg, lh) * 96;
                k[li] = f2bf(v0); k[32 + li] = f2bf(v1); k[64 + li] = f2bf(v2);
                if ((reg & 3) == 3) __builtin_amdgcn_sched_barrier(0);
            }
#pragma unroll
            for (int rg = 0; rg < 4; ++rg) {
                const int k0 = 8 * rg + 4 * lh;
                u32x2 w0, w1;
                w0.x = pack2(c2[4 * rg] * al[4 * rg], c2[4 * rg + 1] * al[4 * rg + 1]); w0.y = pack2(c2[4 * rg + 2] * al[4 * rg + 2], c2[4 * rg + 3] * al[4 * rg + 3]);
                w1.x = pack2(c3[4 * rg] * al[4 * rg], c3[4 * rg + 1] * al[4 * rg + 1]); w1.y = pack2(c3[4 * rg + 2] * al[4 * rg + 2], c3[4 * rg + 3] * al[4 * rg + 3]);
                *(u32x2*)(Vp + (size_t)li * NKEY + k0) = w0;
                *(u32x2*)(Vp + (size_t)(32 + li) * NKEY + k0) = w1;
            }
        }
        __syncthreads();
    }
}

DI void attn_item(const Params& p, const bf16_t* Qbase  , int bh, int q0, int nkeys, int out_row0, unsigned char* smem) {
    constexpr int KS = 104, VS = 68;
    bf16_t* Ks = (bf16_t*)smem;
    bf16_t* Vs = Ks + 2 * 64 * KS;
    const int tid = get_tid(), lane = tid & 63, wave = tid >> 6, li = lane & 31, lh = lane >> 5;
    const bf16_t* Kg = (const bf16_t*)(p.ws + WS_K) + (size_t)bh * NKEY * 96;
    const bf16_t* Vg = (const bf16_t*)(p.ws + WS_VT) + (size_t)bh * 64 * NKEY;
    bf16x8 qf[6];
#pragma unroll
    for (int ks = 0; ks < 6; ++ks) qf[ks] = ld8(Qbase + (size_t)(q0 + 32 * wave + li) * 96 + 16 * ks + 8 * lh);
    u32x4 rk[3], rv[2];
    auto gload = [&](int kt) {
#pragma unroll
        for (int i = 0; i < 3; ++i) { int id = tid + 256 * i; rk[i] = *(const u32x4*)(Kg + (size_t)kt * 64 * 96 + id * 8); }
#pragma unroll
        for (int i = 0; i < 2; ++i) { int id = tid + 256 * i, v = id >> 3, kc = id & 7; rv[i] = *(const u32x4*)(Vg + (size_t)v * NKEY + kt * 64 + kc * 8); }
    };
    auto sstore = [&](int buf) {
#pragma unroll
        for (int i = 0; i < 3; ++i) { int id = tid + 256 * i, key = id / 12, dc = id - key * 12; *(u32x4*)(Ks + (buf * 64 + key) * KS + dc * 8) = rk[i]; }
#pragma unroll
        for (int i = 0; i < 2; ++i) { int id = tid + 256 * i, v = id >> 3, kc = id & 7; bf16_t* d = Vs + (buf * 64 + v) * VS + kc * 8;
            u32x2 lo, hi; lo.x = rv[i].x; lo.y = rv[i].y; hi.x = rv[i].z; hi.y = rv[i].w; *(u32x2*)d = lo; *(u32x2*)(d + 4) = hi; }
    };
    const int nkt = nkeys >> 6;
    const float scl = 0.10206207261596577f * 1.4426950408889634f;
    f32x16 o0 = zero16(), o1 = zero16(); float m = -1e30f, l = 0.f;
    __syncthreads();
    gload(0); sstore(0); __syncthreads();
    for (int kt = 0; kt < nkt; ++kt) {
        const int buf = kt & 1;
        if (kt + 1 < nkt) gload(kt + 1);
        __builtin_amdgcn_sched_barrier(0);
        f32x16 s0 = zero16(), s1 = zero16();
        const bf16_t* kb = Ks + (buf * 64 + li) * KS + 8 * lh;
#pragma unroll
        for (int ks = 0; ks < 6; ++ks) { s0 = MFMA(ld8(kb + 16 * ks), qf[ks], s0); s1 = MFMA(ld8(kb + 32 * KS + 16 * ks), qf[ks], s1); }
        float mx = fmaxf(s0[0], s1[0]);
#pragma unroll
        for (int r = 1; r < 16; ++r) mx = fmaxf(fmaxf(mx, s0[r]), s1[r]);
        mx = fmaxf(mx, __shfl_xor(mx, 32));
        const float mn = fmaxf(m, mx);
        if (__any(mn > m)) {
            const float corr = __builtin_amdgcn_exp2f((m - mn) * scl);
            l *= corr;
#pragma unroll
            for (int r = 0; r < 16; ++r) { o0[r] *= corr; o1[r] *= corr; }
            m = mn;
        }
        const float nb = -m * scl;
        float sum0 = 0.f, sum1 = 0.f;
#pragma unroll
        for (int r = 0; r < 16; ++r) { s0[r] = __builtin_amdgcn_exp2f(fmaf(s0[r], scl, nb)); s1[r] = __builtin_amdgcn_exp2f(fmaf(s1[r], scl, nb)); sum0 += s0[r]; sum1 += s1[r]; }
        float sum = sum0 + sum1;
        sum += __shfl_xor(sum, 32);
        l += sum;
        bf16x8 pf[2][2];
        pf[0][0] = pack8(s0[0], s0[1], s0[2], s0[3], s0[4], s0[5], s0[6], s0[7]); pf[0][1] = pack8(s0[8], s0[9], s0[10], s0[11], s0[12], s0[13], s0[14], s0[15]);
        pf[1][0] = pack8(s1[0], s1[1], s1[2], s1[3], s1[4], s1[5], s1[6], s1[7]); pf[1][1] = pack8(s1[8], s1[9], s1[10], s1[11], s1[12], s1[13], s1[14], s1[15]);
        const bf16_t* vb = Vs + (buf * 64 + li) * VS + 4 * lh;
#pragma unroll
        for (int j = 0; j < 2; ++j)
#pragma unroll
            for (int s = 0; s < 2; ++s) {
                const int ko = 32 * j + 16 * s;
                o0 = MFMA(ld4x2(vb + ko, vb + ko + 8), pf[j][s], o0);
                o1 = MFMA(ld4x2(vb + 32 * VS + ko, vb + 32 * VS + ko + 8), pf[j][s], o1);
            }
        __builtin_amdgcn_sched_barrier(0);
        if (kt + 1 < nkt) sstore(buf ^ 1);
        __syncthreads();
    }
    const float inv = 1.f / l;
    bf16_t* MIX = (bf16_t*)(p.ws + WS_MIX);
    const int hd = bh % 6;
    bf16_t* orow = MIX + (size_t)(out_row0 + q0 + 32 * wave + li) * 1024 + hd * 64;
#pragma unroll
    for (int rg = 0; rg < 4; ++rg) {
        u32x2 w0, w1;
        w0.x = pack2(o0[4 * rg] * inv, o0[4 * rg + 1] * inv); w0.y = pack2(o0[4 * rg + 2] * inv, o0[4 * rg + 3] * inv);
        w1.x = pack2(o1[4 * rg] * inv, o1[4 * rg + 1] * inv); w1.y = pack2(o1[4 * rg + 2] * inv, o1[4 * rg + 3] * inv);
        *(u32x2*)(orow + 8 * rg + 4 * lh) = w0;
        *(u32x2*)(orow + 32 + 8 * rg + 4 * lh) = w1;
    }
}

DI void wave_scan128(const float* v, float* out, bool reverse, int lane) {
    const float v0 = v[2 * lane], v1 = v[2 * lane + 1];
    float s = v0 + v1;
#pragma unroll
    for (int o = 1; o < 64; o <<= 1) { float t = __shfl_up(s, o); if (lane >= o) s += t; }
    const float total = __shfl(s, 63);
    if (!reverse) { out[2 * lane] = s - v1; out[2 * lane + 1] = s; }
    else { out[2 * lane] = total - (s - v0 - v1); out[2 * lane + 1] = total - (s - v1); }
}
DI int chunk_row0(int b, int cidx) { return cidx < 2 ? NL + b * CTX + cidx * 128 : b * SEQ + (cidx - 2) * 128; }

DI void ssdA_item(const Params& p, int layer, int it, unsigned char* smem) {
    const int cidx = it % NCHK, hd = (it / NCHK) % 6, b = it / (NCHK * 6), g = hd / 3;
    const int tid = get_tid(), lane = tid & 63, wave = tid >> 6, li = lane & 31, lh = lane >> 5;
    constexpr int TS = 136;
    bf16_t* BT = (bf16_t*)smem;
    bf16_t* XT = BT + 64 * TS;
    float* dtv = (float*)(XT + 64 * TS);
    float* av = dtv + 256;
    float* cum = av + 256;
    const int r0 = chunk_row0(b, cidx);
    const bf16_t* UZ = (const bf16_t*)(p.ws + WS_UZ); const float* DT = (const float*)(p.ws + WS_DT);
    __syncthreads();
    { const int t = tid & 127, d = tid >> 7; const float dt = DT[(size_t)(r0 + t) * 12 + d * 6 + hd]; const float a = -__expf(p.in[I_ALOG][layer * 12 + d * 6 + hd]); dtv[d * 128 + t] = dt; av[d * 128 + t] = dt * a; }
    { bf16x8 sv[4];
#pragma unroll
      for (int q = 0; q < 4; ++q) { const int i = tid + 256 * q, t = i >> 3, c8 = i & 7; sv[q] = ld8(UZ + (size_t)(r0 + t) * 1024 + 384 + g * 64 + c8 * 8); }
#pragma unroll
      for (int q = 0; q < 4; ++q) { const int i = tid + 256 * q, t = i >> 3, c8 = i & 7;
#pragma unroll
        for (int j = 0; j < 8; ++j) BT[(c8 * 8 + j) * TS + t] = (bf16_t)sv[q][j]; } }
    __syncthreads();
    if (wave < 2) wave_scan128(av + wave * 128, cum + wave * 128, wave == 1, lane);
    __syncthreads();
    float* ST = (float*)(p.ws + stbase(layer)); float* DEC = (float*)(p.ws + stbase(layer) + ST_BYTES);
    for (int d = 0; d < 2; ++d) {
        const float total = d == 0 ? cum[127] : cum[128];
        { bf16x8 sv[4];
#pragma unroll
          for (int q = 0; q < 4; ++q) { const int i = tid + 256 * q, t = i >> 3, c8 = i & 7; sv[q] = ld8(UZ + (size_t)(r0 + t) * 1024 + hd * 64 + c8 * 8); }
#pragma unroll
          for (int q = 0; q < 4; ++q) { const int i = tid + 256 * q, t = i >> 3, c8 = i & 7;
            const float w = __expf(total - cum[d * 128 + t]) * dtv[d * 128 + t];
#pragma unroll
            for (int j = 0; j < 8; ++j) XT[(c8 * 8 + j) * TS + t] = f2bf(bf2f((bf16_t)sv[q][j]) * w); } }
        __syncthreads();
        const int pt = wave >> 1, nt = wave & 1;
        f32x16 acc = zero16();
#pragma unroll
        for (int ks = 0; ks < 8; ++ks) acc = MFMA(ld8(XT + (32 * pt + li) * TS + 16 * ks + 8 * lh), ld8(BT + (32 * nt + li) * TS + 16 * ks + 8 * lh), acc);
        float* st = ST + ((((size_t)d * 4 + b) * 6 + hd) * NCHK + cidx) * 4096;
#pragma unroll
        for (int reg = 0; reg < 16; ++reg) st[(32 * pt + crow(reg, lh)) * 64 + 32 * nt + li] = acc[reg];
        if (tid == 0) DEC[(((size_t)d * 4 + b) * 6 + hd) * NCHK + cidx] = __expf(total);
        __syncthreads();
    }
}
DI void hy_rawload(const unsigned* fd, unsigned (&raw)[10]) {
#pragma unroll
    for (int j = 0; j < 5; ++j) { raw[j] = fd[j]; raw[5 + j] = fd[j - 8]; }
}
DI void hy_conv(const bf16_t* ub, const bf16_t* filt, f32x16 (&acc)[2], int nbase, int li, int lh) {
    const int klo = 32 * nbase - 127, khi = 32 * (nbase + 1) + 31;
    const int m0 = 4096 + li - 8 * lh - 7;
    const unsigned sh = (unsigned)(m0 & 1) * 16u;
    const unsigned* fd0 = (const unsigned*)filt + (m0 >> 1);
    unsigned raw[10];
    hy_rawload(fd0 + 16 * klo, raw);
#pragma unroll 4
    for (int k = klo; k <= khi; ++k) {
        u32x4 ua, ub4;
        ua.x = __builtin_amdgcn_alignbit(raw[1], raw[0], sh); ua.y = __builtin_amdgcn_alignbit(raw[2], raw[1], sh); ua.z = __builtin_amdgcn_alignbit(raw[3], raw[2], sh); ua.w = __builtin_amdgcn_alignbit(raw[4], raw[3], sh);
        ub4.x = __builtin_amdgcn_alignbit(raw[6], raw[5], sh); ub4.y = __builtin_amdgcn_alignbit(raw[7], raw[6], sh); ub4.z = __builtin_amdgcn_alignbit(raw[8], raw[7], sh); ub4.w = __builtin_amdgcn_alignbit(raw[9], raw[8], sh);
        const bf16x8 a0 = __builtin_bit_cast(bf16x8, ua), a1 = __builtin_bit_cast(bf16x8, ub4);
        if (k < khi) hy_rawload(fd0 + 16 * (k + 1), raw);
        bf16x8 b0[2], b1[2]; bool use[2];
#pragma unroll
        for (int n = 0; n < 2; ++n) {
            const int nn = nbase + n; use[n] = (k >= 32 * nn - 127) && (k <= 32 * nn + 31);
            const int c = 32 * nn + li - k;
            const bf16_t* up = ub + c * 40 + 8 * lh;
            b0[n] = ld8(up); b1[n] = ld8(up + 16);
        }
#pragma unroll
        for (int n = 0; n < 2; ++n) if (use[n]) { acc[n] = MFMA(a0, b0[n], acc[n]); acc[n] = MFMA(a1, b1[n], acc[n]); }
    }
}
DI u32x4 rev8(u32x4 v) { u32x4 r; r.x = (v.w >> 16) | (v.w << 16); r.y = (v.z >> 16) | (v.z << 16); r.z = (v.y >> 16) | (v.y << 16); r.w = (v.x >> 16) | (v.x << 16); return r; }
DI void hyena_lat_item(const Params& p, int layer, int it, unsigned char* smem) {
    const int ch = it >> 1, bp = it & 1;
    const int tid = get_tid(), lane = tid & 63, wave = tid >> 6, li = lane & 31, lh = lane >> 5;
    const int bl = wave >> 1, nbase = 2 * (wave & 1), bg = 2 * bp + bl;
    constexpr int UB = 192 * 40;
    bf16_t* U = (bf16_t*)smem + 32 * 40;
    bf16_t* Fl = (bf16_t*)smem + 2 * UB;
    float* red = (float*)(Fl + 8192 + 16);
    const bf16_t* P = (const bf16_t*)(p.ws + WS_P); const bf16_t* FL = (const bf16_t*)(p.ws + WS_FL); const float* FP = (const float*)(p.ws + WS_FPL);
    __syncthreads();
    { const int lb = tid & 127, dir = tid >> 7;
      float v0 = wave_sum(FP[lb * 1024 + dir * 512 + ch]), v1 = wave_sum(FP[lb * 1024 + dir * 512 + 256 + ch]);
      if (lane == 0) { red[wave] = v0; red[4 + wave] = v1; } }
    { u32x4 su[4], sf[4];
#pragma unroll
      for (int j = 0; j < 4; ++j) su[j] = *(const u32x4*)(P + (size_t)ch * NT + (size_t)bp * 2 * SEQ + (tid + 256 * j) * 8);
#pragma unroll
      for (int j = 0; j < 4; ++j) sf[j] = *(const u32x4*)(FL + (size_t)(0 * 256 + ch) * 8192 + (tid + 256 * j) * 8);
#pragma unroll
      for (int j = 0; j < 4; ++j) { const int i = tid + 256 * j, b = i >> 9, r = i & 511, blk = r >> 2, q = r & 3; *(u32x4*)(U + b * UB + blk * 40 + q * 8) = rev8(su[j]); }
      { unsigned zz = 0u; asm volatile("" : "+v"(zz)); u32x4 z4; z4.x = zz; z4.y = zz; z4.z = zz; z4.w = zz;
#pragma unroll
        for (int j = 0; j < 3; ++j) { const int i = tid + 256 * j; if (i < 2 * 2 * 32 * 5) { const int b = i / 320, r = i - b * 320, side = r / 160, e = r - side * 160; *(u32x4*)(U + b * UB + (side ? 128 * 40 : -32 * 40) + e * 8) = z4; } } }
#pragma unroll
      for (int j = 0; j < 4; ++j) *(u32x4*)(Fl + (tid + 256 * j) * 8) = sf[j];
      if (tid < 8) ((unsigned*)(Fl + 8192))[tid] = 0u; }
    __syncthreads();
    const float inv0 = 1.f / (red[0] + red[1] + red[2] + red[3] + EPS), inv1 = 1.f / (red[4] + red[5] + red[6] + red[7] + EPS);
    const float d0 = p.in[I_DSH][layer * 512 + ch], d1 = p.in[I_DSH][layer * 512 + 256 + ch];
    bf16_t* ub = U + bl * UB;
    f32x16 acc[2];
    acc[0] = zero16(); acc[1] = zero16();
    hy_conv(ub, Fl, acc, nbase, li, lh);
    __syncthreads();
    { u32x4 sf[4];
#pragma unroll
      for (int j = 0; j < 4; ++j) sf[j] = *(const u32x4*)(FL + (size_t)(1 * 256 + ch) * 8192 + (tid + 256 * j) * 8);
#pragma unroll
      for (int n = 0; n < 2; ++n)
#pragma unroll
        for (int rg = 0; rg < 4; ++rg) {
            const int a = 32 * (nbase + n) + li, ii = 8 * rg + 4 * lh; bf16_t* up = ub + a * 40 + 8 * rg + 4 * (1 - lh);
            const u32x2 zz = *(const u32x2*)up; const u32x2 pp = *(const u32x2*)(P + (size_t)(256 + ch) * NT + bg * SEQ + 32 * a + ii);
            float z[4] = { bf2f((bf16_t)(zz.y >> 16)), bf2f((bf16_t)(zz.y & 0xffff)), bf2f((bf16_t)(zz.x >> 16)), bf2f((bf16_t)(zz.x & 0xffff)) };
            float q[4] = { bf2f((bf16_t)(pp.x & 0xffff)), bf2f((bf16_t)(pp.x >> 16)), bf2f((bf16_t)(pp.y & 0xffff)), bf2f((bf16_t)(pp.y >> 16)) };
            float o[4];
#pragma unroll
            for (int e = 0; e < 4; ++e) o[e] = q[e] * (acc[n][4 * rg + e] * inv0 + z[e] * d0);
            u32x2 w; w.x = pack2(o[3], o[2]); w.y = pack2(o[1], o[0]); *(u32x2*)up = w;
        }
#pragma unroll
      for (int j = 0; j < 4; ++j) *(u32x4*)(Fl + (tid + 256 * j) * 8) = sf[j]; }
    __syncthreads();
    acc[0] = zero16(); acc[1] = zero16();
    hy_conv(ub, Fl, acc, nbase, li, lh);
    bf16_t* HY = (bf16_t*)(p.ws + WS_HYOT);
#pragma unroll
    for (int n = 0; n < 2; ++n)
#pragma unroll
        for (int rg = 0; rg < 4; ++rg) {
            const int a = 32 * (nbase + n) + li, ii = 8 * rg + 4 * lh; const bf16_t* up = ub + a * 40 + 8 * rg + 4 * (1 - lh);
            const u32x2 zz = *(const u32x2*)up; const u32x2 pp = *(const u32x2*)(P + (size_t)(512 + ch) * NT + bg * SEQ + 32 * a + ii);
            float z[4] = { bf2f((bf16_t)(zz.y >> 16)), bf2f((bf16_t)(zz.y & 0xffff)), bf2f((bf16_t)(zz.x >> 16)), bf2f((bf16_t)(zz.x & 0xffff)) };
            float q[4] = { bf2f((bf16_t)(pp.x & 0xffff)), bf2f((bf16_t)(pp.x >> 16)), bf2f((bf16_t)(pp.y & 0xffff)), bf2f((bf16_t)(pp.y >> 16)) };
            float o[4];
#pragma unroll
            for (int e = 0; e < 4; ++e) o[e] = q[e] * (acc[n][4 * rg + e] * inv1 + z[e] * d1);
            u32x2 w; w.x = pack2(o[0], o[1]); w.y = pack2(o[2], o[3]); *(u32x2*)(HY + (size_t)ch * NT + bg * SEQ + 32 * a + ii) = w;
        }
}
DI void hyena_ctx_item(const Params& p, int layer, int ch, unsigned char* smem) {
    const int tid = get_tid();
    float* u = (float*)smem;
    float* f = u + 1024;
    const bf16_t* P = (const bf16_t*)(p.ws + WS_P); const bf16_t* FC = (const bf16_t*)(p.ws + WS_FC); const float* FP = (const float*)(p.ws + WS_FPC);
    bf16_t* HY = (bf16_t*)(p.ws + WS_HYOT);
    __syncthreads();
    float nrm[2] = { 0.f, 0.f };
#pragma unroll
    for (int o = 0; o < 2; ++o) for (int lb = 0; lb < 8; ++lb) nrm[o] += FP[lb * 1024 + o * 256 + ch] + FP[lb * 1024 + 512 + o * 256 + ch];
    for (int i = tid; i < 1024; i += 256) u[i] = bf2f(P[(size_t)ch * NT + NL + i]);
    float zprev[4];
    for (int o = 0; o < 2; ++o) {
        for (int i = tid; i < 512; i += 256) f[i] = bf2f(FC[(size_t)(o * 256 + ch) * 512 + i]);
        __syncthreads();
        float y[4] = { 0.f, 0.f, 0.f, 0.f };
        for (int s = 0; s < 256; ++s) { const float fv = f[256 + tid - s]; y[0] += fv * u[s]; y[1] += fv * u[256 + s]; y[2] += fv * u[512 + s]; y[3] += fv * u[768 + s]; }
        const float inv = 1.f / (nrm[o] + EPS), dsk = p.in[I_DSH][layer * 512 + o * 256 + ch];
#pragma unroll
        for (int b = 0; b < 4; ++b) { const float pv = bf2f(P[(size_t)((o + 1) * 256 + ch) * NT + NL + b * 256 + tid]); zprev[b] = pv * (y[b] * inv + u[b * 256 + tid] * dsk); }
        __syncthreads();
        if (o == 0) {
#pragma unroll
            for (int b = 0; b < 4; ++b) u[b * 256 + tid] = zprev[b]; }
        else {
#pragma unroll
            for (int b = 0; b < 4; ++b) HY[(size_t)ch * NT + NL + b * 256 + tid] = f2bf(zprev[b]); }
        __syncthreads();
    }
}

DI void ssd_scan(const Params& p, int layer) {
    float* ST = (float*)(p.ws + stbase(layer)); const float* DEC = (const float*)(p.ws + stbase(layer) + ST_BYTES);
    const int total = 2 * 4 * 6 * 4096;
    for (int i = blockIdx.x * 256 + get_tid(); i < total; i += gridDim.x * 256) {
        const int e = i & 4095, dbh = i >> 12, d = dbh / 24;
        float* st = ST + (size_t)dbh * NCHK * 4096 + e; const float* dec = DEC + dbh * NCHK;
        float x[NCHK], dc[NCHK];
#pragma unroll
        for (int c = 0; c < NCHK; ++c) { x[c] = st[(size_t)c * 4096]; dc[c] = dec[c]; }
        float s = 0.f;
        if (d == 0) {
#pragma unroll
            for (int c = 0; c < NCHK; ++c) { st[(size_t)c * 4096] = s; s = s * dc[c] + x[c]; } }
        else {
#pragma unroll
            for (int c = 1; c >= 0; --c) { st[(size_t)c * 4096] = s; s = s * dc[c] + x[c]; }
#pragma unroll
            for (int c = NCHK - 1; c >= 2; --c) { st[(size_t)c * 4096] = s; s = s * dc[c] + x[c]; } }
    }
}

DI void ssdC_item(const Params& p, int layer, int it, unsigned char* smem) {
    const int g = it & 1, cidx = (it >> 1) % NCHK, b = it / (2 * NCHK);
    const int tid = get_tid(), lane = tid & 63, wave = tid >> 6, li = lane & 31, lh = lane >> 5;
    constexpr int NS = 72, TS = 136;
    bf16_t* Bn = (bf16_t*)smem;
    bf16_t* Cn = Bn + 128 * NS;
    bf16_t* XT = Cn + 128 * NS;
    float* dtv = (float*)(XT + 64 * TS);
    float* av = dtv + 256;
    float* cum = av + 256;
    const int r0 = chunk_row0(b, cidx);
    const bf16_t* UZ = (const bf16_t*)(p.ws + WS_UZ); const float* DT = (const float*)(p.ws + WS_DT); const float* ST = (const float*)(p.ws + stbase(layer));
    __syncthreads();
    { u32x4 sb[4], sc[4];
#pragma unroll
      for (int q = 0; q < 4; ++q) { const int i = tid + 256 * q, t = i >> 3, c8 = i & 7;
        sb[q] = *(const u32x4*)(UZ + (size_t)(r0 + t) * 1024 + 384 + g * 64 + c8 * 8); sc[q] = *(const u32x4*)(UZ + (size_t)(r0 + t) * 1024 + 512 + g * 64 + c8 * 8); }
#pragma unroll
      for (int q = 0; q < 4; ++q) { const int i = tid + 256 * q, t = i >> 3, c8 = i & 7; *(u32x4*)(Bn + t * NS + c8 * 8) = sb[q]; *(u32x4*)(Cn + t * NS + c8 * 8) = sc[q]; } }
    const int itok = 32 * wave + li;
    float ssq = 0.f;
    bf16_t* orow = (bf16_t*)(p.ws + WS_MIX) + (size_t)(r0 + itok) * 1024 + 384 + g * 192;
#pragma unroll 1
    for (int hh = 0; hh < 3; ++hh) {
        const int hd = g * 3 + hh;
        __syncthreads();
        { const int t = tid & 127, d = tid >> 7; const float dt = DT[(size_t)(r0 + t) * 12 + d * 6 + hd]; const float a = -__expf(p.in[I_ALOG][layer * 12 + d * 6 + hd]); dtv[d * 128 + t] = dt; av[d * 128 + t] = dt * a; }
        { bf16x8 sv[4];
#pragma unroll
          for (int q = 0; q < 4; ++q) { const int i = tid + 256 * q, t = i >> 3, c8 = i & 7; sv[q] = ld8(UZ + (size_t)(r0 + t) * 1024 + hd * 64 + c8 * 8); }
#pragma unroll
          for (int q = 0; q < 4; ++q) { const int i = tid + 256 * q, t = i >> 3, c8 = i & 7;
#pragma unroll
            for (int j = 0; j < 8; ++j) XT[(c8 * 8 + j) * TS + t] = (bf16_t)sv[q][j]; } }
        __syncthreads();
        if (wave < 2) wave_scan128(av + wave * 128, cum + wave * 128, wave == 1, lane);
        __syncthreads();
        f32x16 y0 = zero16(), y1 = zero16();
#pragma unroll 1
        for (int d = 0; d < 2; ++d) {
            const float ci = cum[d * 128 + itok], ei = __expf(ci);
            {
                const float* prev = ST + ((((size_t)d * 4 + b) * 6 + hd) * NCHK + cidx) * 4096;
#pragma unroll
                for (int ks = 0; ks < 4; ++ks) {
                    const f32x4 pa = *(const f32x4*)(prev + (li) * 64 + 16 * ks + 8 * lh), pb = *(const f32x4*)(prev + (li) * 64 + 16 * ks + 8 * lh + 4);
                    const f32x4 pc = *(const f32x4*)(prev + (32 + li) * 64 + 16 * ks + 8 * lh), pd = *(const f32x4*)(prev + (32 + li) * 64 + 16 * ks + 8 * lh + 4);
                    const bf16x8 cr = ld8(Cn + itok * NS + 16 * ks + 8 * lh);
                    const bf16x8 cf = pack8(bf2f((bf16_t)cr[0]) * ei, bf2f((bf16_t)cr[1]) * ei, bf2f((bf16_t)cr[2]) * ei, bf2f((bf16_t)cr[3]) * ei,
                                            bf2f((bf16_t)cr[4]) * ei, bf2f((bf16_t)cr[5]) * ei, bf2f((bf16_t)cr[6]) * ei, bf2f((bf16_t)cr[7]) * ei);
                    y0 = MFMA(pack8(pa.x, pa.y, pa.z, pa.w, pb.x, pb.y, pb.z, pb.w), cf, y0);
                    y1 = MFMA(pack8(pc.x, pc.y, pc.z, pc.w, pd.x, pd.y, pd.z, pd.w), cf, y1);
                }
            }
#pragma unroll 1
            for (int jt = 0; jt < 4; ++jt) {
                if (d == 0 ? (jt > wave) : (jt < wave)) continue;
                f32x16 gt = zero16();
#pragma unroll
                for (int ks = 0; ks < 4; ++ks) gt = MFMA(ld8(Bn + (32 * jt + li) * NS + 16 * ks + 8 * lh), ld8(Cn + itok * NS + 16 * ks + 8 * lh), gt);
#pragma unroll
                for (int r = 0; r < 16; ++r) { const int j = 32 * jt + crow(r, lh); const bool valid = d == 0 ? (j <= itok) : (j >= itok);
                    const float df = fminf(ci - cum[d * 128 + j], 0.f);
                    gt[r] = valid ? gt[r] * __expf(df) * dtv[d * 128 + j] : 0.f; }
                const bf16x8 pf0 = pack8(gt[0], gt[1], gt[2], gt[3], gt[4], gt[5], gt[6], gt[7]), pf1 = pack8(gt[8], gt[9], gt[10], gt[11], gt[12], gt[13], gt[14], gt[15]);
                const bf16_t* xb = XT + li * TS + 32 * jt + 4 * lh;
                y0 = MFMA(ld4x2(xb, xb + 8), pf0, y0); y0 = MFMA(ld4x2(xb + 16, xb + 24), pf1, y0);
                y1 = MFMA(ld4x2(xb + 32 * TS, xb + 32 * TS + 8), pf0, y1); y1 = MFMA(ld4x2(xb + 32 * TS + 16, xb + 32 * TS + 24), pf1, y1);
            }
        }
        const float dsk = p.in[I_DSS][layer * 6 + hd];
        const bf16_t* zrow = UZ + (size_t)(r0 + itok) * 1024 + 640 + hd * 64;
#pragma unroll
        for (int pt = 0; pt < 2; ++pt)
#pragma unroll
            for (int rg = 0; rg < 4; ++rg) {
                const int p0 = 32 * pt + 8 * rg + 4 * lh;
                const u32x2 zz = *(const u32x2*)(zrow + p0);
                const float z[4] = { bf2f((bf16_t)(zz.x & 0xffff)), bf2f((bf16_t)(zz.x >> 16)), bf2f((bf16_t)(zz.y & 0xffff)), bf2f((bf16_t)(zz.y >> 16)) };
                float o[4];
#pragma unroll
                for (int e = 0; e < 4; ++e) { const float yv = (pt ? y1[4 * rg + e] : y0[4 * rg + e]) + bf2f(XT[(p0 + e) * TS + itok]) * dsk; o[e] = yv * silu(z[e]); ssq += o[e] * o[e]; }
                u32x2 w; w.x = pack2(o[0], o[1]); w.y = pack2(o[2], o[3]); *(u32x2*)(orow + hh * 64 + p0) = w;
            }
    }
    ssq += __shfl_xor(ssq, 32);
    const float rstd = 1.f / sqrtf(ssq * (1.f / 192.f) + EPS);
    const float* gn = p.in[I_GSO] + layer * 384 + g * 192;
#pragma unroll 1
    for (int q = 0; q < 24; ++q) {
        const int c = 8 * q + 4 * lh; const u32x2 w = *(const u32x2*)(orow + c); const f32x4 gg = *(const f32x4*)(gn + c);
        u32x2 o; o.x = pack2(bf2f((bf16_t)(w.x & 0xffff)) * rstd * gg.x, bf2f((bf16_t)(w.x >> 16)) * rstd * gg.y);
        o.y = pack2(bf2f((bf16_t)(w.y & 0xffff)) * rstd * gg.z, bf2f((bf16_t)(w.y >> 16)) * rstd * gg.w);
        *(u32x2*)(orow + c) = o;
    }
}

DI int dyn_next(const Params& p, unsigned char* smem, int word) {
    volatile LAS unsigned* st = (volatile LAS unsigned*)(smem + LDS_MAIN);
    __syncthreads();
    if (get_tid() == 0) st[2] = atomicAdd((unsigned*)(p.ws + WS_CTRL) + word, 1u);
    __syncthreads();
    const unsigned v = st[2];
    return v > 0x3fffffffu ? 0x3fffffff : (int)v;
}
#define XCD_TILE_LOOP(MT, NTN, m_, n_) for (int lt_ = (bid >> 3), m_ = 0, n_ = 0; (lt_ < ((MT) >> 3) * (NTN)) && ((m_ = (bid & 7) + 8 * (lt_ / (NTN))), (n_ = lt_ % (NTN)), true); lt_ += (G >> 3))
constexpr int NPHASE = 24, PPL = 12;
DI void run_phase(const Params& p, int ph, unsigned char* smem, int sub = 0) {
    const int layer = ph / PPL, k = ph % PPL, G = gridDim.x, bid = blockIdx.x;
    const float* MOD = (const float*)(p.ws + WS_MOD) + (size_t)layer * 5 * 6144;
    switch (k) {
    case 0: {
        if (layer != 0) break;
        const int n1 = 384, n4 = n1 + WT_IN;
        for (int it = dyn_next(p, smem, 20); it < n4; it = dyn_next(p, smem, 20)) {
            if (it < n1) mod_item(p, it, smem);
            else wprep_item(p, 0, it - n1, smem);
        }
    } break;
    case 1: {
        norm_rows(p, layer, 0, NT, layer == 0);
    } break;
    case 2: {
        bf16_t* PROJ = (bf16_t*)(p.ws + WS_PROJ);
        auto epi = [&](int r, int c, float v, float) { PROJ[(size_t)r * INP + c] = f2bf(v); };
        auto nocol = [&](int, int) { return 0.f; };
        XCD_TILE_LOOP(NT / 128, INP / 128, tm, tn) gemm_tile((const bf16_t*)(p.ws + WS_H), 1024, (const bf16_t*)(p.ws + wbase(layer) + W_IN), 1024, 1024, tm * 128, tn * 128, smem, epi, nocol);
        if (layer == 0) {
            const int n2 = 512, n3 = n2 + 32, n4 = n3 + (WT_TOTAL - WT_IN);
            for (int it = dyn_next(p, smem, 22); it < n4; it = dyn_next(p, smem, 22)) {
                if (it < n2) filt_item<SEQ>(p, 0, it, smem, (bf16_t*)(p.ws + WS_FL), (float*)(p.ws + WS_FPL));
                else if (it < n3) filt_item<CTX>(p, 0, it - n2, smem, (bf16_t*)(p.ws + WS_FC), (float*)(p.ws + WS_FPC));
                else wprep_item(p, 0, WT_IN + (it - n3), smem);
            }
        }
    } break;
    case 3: {
        const int n0 = NT / 128, n1 = n0 + (NT / 128) * 4, n3 = n1 + (NT / 64) * 12;
        for (int it = dyn_next(p, smem, 18 + layer); it < n3; it = dyn_next(p, smem, 18 + layer)) {
            if (it < n0) {
                if (sub == 0 || sub == 2) {
                    float* wl = (float*)smem;
                    __syncthreads();
                    { float tw[10];
#pragma unroll
                      for (int j = 0; j < 10; ++j) { const int i = get_tid() + 256 * j; tw[j] = (i < 1920) ? p.in[I_WCS][layer * 1920 + i] : p.in[I_BCS][layer * 640 + i - 1920]; }
#pragma unroll
                      for (int j = 0; j < 10; ++j) wl[get_tid() + 256 * j] = tw[j]; }
                    __syncthreads();
                    for (int q = 0; q < 4; ++q) ssmconv_item(p, layer, 4 * it + q, wl, wl + 1920);
                    __threadfence_block(); __syncthreads();
                    const int r0 = it * 128; int b, cidx;
                    if (r0 < NL) { b = r0 >> 12; cidx = 2 + ((r0 & 4095) >> 7); } else { b = (r0 - NL) >> 8; cidx = ((r0 - NL) & 255) >> 7; }
                    for (int hd = 0; hd < 6; ++hd) ssdA_item(p, layer, (b * 6 + hd) * NCHK + cidx, smem);
                }
            }
            else if (it < n1) { if (sub == 0 || sub == 1) qkv_item(p, layer, it - n0, smem); }
            else { if (sub == 0 || sub == 3) hyconv_item(p, layer, it - n1, smem); }
        }
    } break;
    case 4: break;
    case 5: ssd_scan(p, layer); break;
    case 6: {
        const int nH = 512, nA = 4 * 6 * 32, nS = 4 * NCHK * 2, nAc = (layer == 0) ? 4 * 6 * 2 : 0, nHc = (layer == 0) ? 256 : 0;
        const int n1 = nH, n2 = n1 + nA, n3 = n2 + nS, n4 = n3 + nAc, n5 = n4 + nHc;
        unsigned* ctr = (unsigned*)(p.ws + WS_CTRL) + 16 + layer;
        volatile LAS unsigned* st = (volatile LAS unsigned*)(smem + LDS_MAIN);
        for (;;) {
            __syncthreads();
            if (get_tid() == 0) st[2] = sub ? 0xffffffffu : atomicAdd(ctr, 1u);
            __syncthreads();
            const int it = (int)st[2];
            if (it < 0 || it >= n5) break;
            if (it < n1) hyena_lat_item(p, layer, it, smem);
            else if (it < n2) { const int j = it - n1, bh = j >> 5, qt = j & 31; attn_item(p, (const bf16_t*)(p.ws + WS_Q) + (size_t)bh * SEQ * 96, bh, qt * 128, NKEY, (bh / 6) * SEQ, smem); }
            else if (it < n3) { const int j = it - n2, cidx = (j >> 1) % NCHK; if (!(layer == 1 && cidx < 2)) ssdC_item(p, layer, j, smem); }
            else if (it < n4) { const int j = it - n3, bh = j >> 1, qt = j & 1; attn_item(p, (const bf16_t*)(p.ws + WS_QC) + (size_t)bh * CTX * 96, bh, qt * 128, CTX, NL + (bh / 6) * CTX, smem); }
            else hyena_ctx_item(p, layer, it - n4, smem);
        }
    } break;
    case 7: break;
    case 8: {
        const float* xin = p.in[I_X]; const float* cin = p.in[I_CTX]; float* out = p.out; float* XC = (float*)(p.ws + WS_XC);
        auto gate = [&](int m0_, int c) { return MOD[(m0_ < NL ? (m0_ >> 12) : 4) * 6144 + 2048 + c]; };
        auto epi = [&](int r, int c, float v, float ga) {
            if (r < NL) { const size_t o = (size_t)r * 1024 + c; out[o] = (layer == 0 ? xin[o] : out[o]) + ga * v; }
            else { const size_t o = (size_t)(r - NL) * 1024 + c; XC[o] = cin[o] + ga * v; } };
        XCD_TILE_LOOP((layer == 0 ? NT : NL) / 128, 8, tm, tn) gemm_tile((const bf16_t*)(p.ws + WS_MIX), 1024, (const bf16_t*)(p.ws + wbase(layer) + W_OUT), 1024, 1024, tm * 128, tn * 128, smem, epi, gate, (const bf16_t*)(p.ws + WS_HYOT));
        if (layer == 0) {
            const int n1 = 512, n2 = n1 + WT_TOTAL;
            for (int it = dyn_next(p, smem, 21); it < n2; it = dyn_next(p, smem, 21)) {
                if (it < n1) filt_item<SEQ>(p, 1, it, smem, (bf16_t*)(p.ws + WS_FL), (float*)(p.ws + WS_FPL));
                else wprep_item(p, 1, it - n1, smem);
            }
        }
    } break;
    case 9: norm_rows(p, layer, 1, layer == 0 ? NT : NL, false); break;
    case 10: {
        bf16_t* HID = (bf16_t*)(p.ws + WS_HID);
        auto epi = [&](int r, int c, float v, float) { const float a = fmaxf(v, 0.f); HID[(size_t)r * 4096 + c] = f2bf(a * a); };
        auto nocol = [&](int, int) { return 0.f; };
        XCD_TILE_LOOP((layer == 0 ? NT : NL) / 128, 32, tm, tn) gemm_tile((const bf16_t*)(p.ws + WS_H), 1024, (const bf16_t*)(p.ws + wbase(layer) + W_FF1), 1024, 1024, tm * 128, tn * 128, smem, epi, nocol);
    } break;
    case 11: {
        float* out = p.out; float* XC = (float*)(p.ws + WS_XC);
        auto gate = [&](int m0_, int c) { return MOD[(m0_ < NL ? (m0_ >> 12) : 4) * 6144 + 5120 + c]; };
        auto epi = [&](int r, int c, float v, float ga) {
            if (r < NL) out[(size_t)r * 1024 + c] += ga * v;
            else XC[(size_t)(r - NL) * 1024 + c] += ga * v; };
        XCD_TILE_LOOP(NL / 128, 8, tm, tn) gemm_tile((const bf16_t*)(p.ws + WS_HID), 4096, (const bf16_t*)(p.ws + wbase(layer) + W_FF2), 4096, 4096, tm * 128, tn * 128, smem, epi, gate);
        if (layer == 0) {
            auto epa = [&](int r, int c, float v, float ga) { atomicAdd(&XC[(size_t)(r - NL) * 1024 + c], ga * v); };
            for (int it = bid; it < 64 * 8; it += G) { const int tl = it >> 3, ks = it & 7;
                gemm_tile((const bf16_t*)(p.ws + WS_HID) + ks * 512, 4096, (const bf16_t*)(p.ws + wbase(layer) + W_FF2) + ks * 512, 4096, 512, NL + (tl / 8) * 128, (tl % 8) * 128, smem, epa, gate); }
        }
    } break;
    }
}

__global__ void __launch_bounds__(NTHREADS, 2) mega_fwd(Params p, int ph_lo, int ph_hi) {
    extern __shared__ __align__(16) unsigned char smem[];
    volatile LAS unsigned* st = (volatile LAS unsigned*)(smem + LDS_MAIN);
    if (__builtin_amdgcn_workitem_id_x() == 0) { st[0] = 0u; st[1] = 0u; }
    __syncthreads();
    const bool multi = ph_hi - ph_lo > 1;
    XcdBarrier xb; xb.bar = (unsigned*)(p.ws + WS_CTRL); xb.x = 0; xb.st = st;
    if (multi) xb = xcd_barrier_post((unsigned*)(p.ws + WS_CTRL), st);
    if (ph_hi < 0) cg::this_grid().sync();
    for (int ph = ph_lo; ph < ph_hi; ++ph) {
        if (ph == PPL || (ph % PPL) == 7 || (ph % PPL) == 4) continue;
        run_phase(p, ph, smem);
#if REP_MASK
        if ((REP_MASK >> (ph % PPL)) & 1) { xcd_barrier(xb); run_phase(p, ph, smem, PROBE_SUB); }
#endif
        if (ph + 1 < ph_hi) xcd_barrier(xb);
    }
}

extern "C" void kernel_launch(void* const* d_in, const int* in_sizes, int n_in, void* d_out, int out_size, void* d_ws, size_t ws_size, hipStream_t stream) {
    static int grid = 0;
    if (grid == 0) {
        if (n_in != 34 || ws_size < WS_TOTAL) { fprintf(stderr, "kernel_launch: unexpected n_in %d / ws %zu (need %zu)\n", n_in, ws_size, (size_t)WS_TOTAL); grid = -1; return; }
        int dev = 0, cus = 0, per_cu = 0;
        hipGetDevice(&dev);
        hipDeviceGetAttribute(&cus, hipDeviceAttributeMultiprocessorCount, dev);
        hipFuncSetAttribute((const void*)mega_fwd, hipFuncAttributeMaxDynamicSharedMemorySize, LDS_BYTES);
        hipOccupancyMaxActiveBlocksPerMultiprocessor(&per_cu, (const void*)mega_fwd, NTHREADS, LDS_BYTES);
        if (per_cu < 1) per_cu = 1;
        if (per_cu > 2) per_cu = 2;
        grid = cus * per_cu;
        fprintf(stderr, "kernel_launch: cus %d per_cu %d grid %d\n", cus, per_cu, grid);
    }
    if (grid < 0) return;
    Params p{};
    for (int i = 0; i < 34; ++i) p.in[i] = (const float*)d_in[i];
    p.out = (float*)d_out; p.ws = (unsigned char*)d_ws;
#if N_LAUNCH_MODE == 1
    hipMemsetAsync((unsigned char*)d_ws + WS_CTRL, 0, XCD_BAR_WORDS * 4, stream);
    int lo = 0, hi = NPHASE;
    void* args[] = { &p, &lo, &hi };
    hipError_t e = hipLaunchCooperativeKernel((const void*)mega_fwd, dim3(grid), dim3(NTHREADS), args, LDS_BYTES, stream);
    if (e != hipSuccess) fprintf(stderr, "cooperative launch failed: %s (grid %d)\n", hipGetErrorString(e), grid);
#else
    for (int ph = 0; ph < NPHASE; ++ph) { if (ph == PPL) continue; mega_fwd<<<dim3(grid), dim3(NTHREADS), LDS_BYTES, stream>>>(p, ph, ph + 1); }
#endif
}
```

```cpp
#include <hip/hip_runtime.h>
#include <hip/hip_cooperative_groups.h>
#include <cstdio>
#include <cstdint>
namespace cg = cooperative_groups;

#ifndef REP_MASK
#define REP_MASK 0
#endif
#define PROBE_SUB 0
#ifndef N_LAUNCH_MODE
#define N_LAUNCH_MODE 1
#endif

typedef unsigned short bf16_t;
typedef short bf16x8 __attribute__((ext_vector_type(8)));
typedef short s16x4 __attribute__((ext_vector_type(4)));
typedef float f32x16 __attribute__((ext_vector_type(16)));
typedef float f32x4 __attribute__((ext_vector_type(4)));
typedef unsigned u32x4 __attribute__((ext_vector_type(4)));
typedef unsigned u32x2 __attribute__((ext_vector_type(2)));
#define DI __device__ __forceinline__
#define MFMA(a, b, c) __builtin_amdgcn_mfma_f32_32x32x16_bf16((a), (b), (c), 0, 0, 0)

constexpr int D = 1024, NB = 4, SEQ = 4096, CTX = 256;
constexpr int NL = NB * SEQ, NC = NB * CTX, NT = NL + NC;
constexpr int INC = 2220, INP = 2304;
constexpr int O_CQ = 0, O_CKV = 256, O_KR = 384, O_Z = 416, O_XBC = 800, O_DT = 1440, O_HY = 1452;
constexpr int NKEY = CTX + SEQ;
constexpr int NCHK = 34;
constexpr float EPS = 1e-6f;
constexpr int LDS_MAIN = 73728;
constexpr int LDS_BYTES = LDS_MAIN + 16;
constexpr int NTHREADS = 256;

constexpr size_t WS_CTRL = 0;
constexpr size_t WS_MOD = 16384;
constexpr size_t WS_W = WS_MOD + 245760;
constexpr size_t W_IN = 0, W_OUT = W_IN + (size_t)INP * 1024 * 2, W_FF1 = W_OUT + 1024 * 1024 * 2, W_FF2 = W_FF1 + 4096 * 1024 * 2,
                 W_UQ = W_FF2 + 4096 * 1024 * 2, W_UKV = W_UQ + 576 * 256 * 2, W_END = W_UKV + 768 * 128 * 2;
constexpr size_t ST_BYTES = (size_t)2 * 4 * 6 * NCHK * 4096 * 4, WREG = ST_BYTES + 8192;
static_assert(W_END <= WREG, "weight region");
constexpr size_t WS_FL = WS_W + WREG;
constexpr size_t WS_FC = WS_FL + 2 * 256 * 8192 * 2;
constexpr size_t WS_FPL = WS_FC + 2 * 256 * 512 * 2;
constexpr size_t WS_FPC = WS_FPL + 128 * 1024 * 4;
constexpr size_t WS_XC = WS_FPC + 8 * 1024 * 4;
constexpr size_t WS_H = WS_XC + (size_t)NC * 1024 * 4;
constexpr size_t WS_Q = WS_H;
constexpr size_t WS_QC = WS_Q + (size_t)4 * 6 * 4096 * 96 * 2;
constexpr size_t WS_VT = WS_QC + (size_t)4 * 6 * 256 * 96 * 2;
constexpr size_t WS_PROJ = WS_H + (size_t)NT * 1024 * 2;
constexpr size_t WS_ST = WS_PROJ;
constexpr size_t WS_DEC = WS_ST + (size_t)2 * 4 * 6 * NCHK * 4096 * 4;
constexpr size_t WS_HYOT = WS_DEC + 8192;
constexpr size_t WS_MIX = WS_HYOT + (size_t)256 * NT * 2;
constexpr size_t WS_K = WS_PROJ + (size_t)NT * INP * 2;
constexpr size_t WS_UZ = WS_K + (size_t)4 * 6 * NKEY * 96 * 2;
constexpr size_t WS_DT = WS_UZ + (size_t)NT * 1024 * 2;
constexpr size_t WS_P = WS_DT + (size_t)NT * 12 * 4;
constexpr size_t WS_END = WS_P + (size_t)3 * 256 * NT * 2;
constexpr size_t WS_HID = WS_PROJ;
constexpr size_t WS_W2 = WS_END;
constexpr size_t WS_TOTAL = WS_W2 + WREG;
DI size_t wbase(int layer) { return layer ? WS_W2 : WS_W; }
DI size_t stbase(int layer) { return layer ? WS_W : WS_W2; }
static_assert(WS_MIX + (size_t)NT * 1024 * 2 <= WS_K, "alias overflow");
static_assert(WS_VT + (size_t)4 * 6 * 64 * NKEY * 2 <= WS_PROJ, "alias overflow");
static_assert(WS_HID + (size_t)NT * 4096 * 2 <= WS_END, "hid overflow");
static_assert(WS_TOTAL <= 268435456ull, "ws overflow");

struct Params { const float* in[34]; float* out; unsigned char* ws; };
enum { I_X = 0, I_C, I_CTX, I_CCTX, I_WMOD, I_BMOD, I_GMIX, I_GMLP, I_WIN, I_WOUT, I_GCQ, I_GCKV, I_WUQ, I_WUKV, I_GQH, I_GKH,
       I_WCS, I_BCS, I_ALOG, I_DTB, I_DSS, I_GSO, I_WCH, I_BCH, I_WF1, I_BF1, I_FQ1, I_WF2, I_BF2, I_FQ2, I_WF3, I_DSH, I_WFF1, I_WFF2 };

DI int get_tid() { int t = (int)__builtin_amdgcn_workitem_id_x(); asm volatile("" : "+v"(t)); return t; }
DI float bf2f(bf16_t v) { return __uint_as_float(((unsigned)v) << 16); }
DI unsigned pack2(float lo, float hi) { unsigned r; asm("v_cvt_pk_bf16_f32 %0, %1, %2" : "=v"(r) : "v"(lo), "v"(hi)); return r; }
DI bf16_t f2bf(float x) { unsigned r; asm("v_cvt_pk_bf16_f32 %0, %1, %1" : "=v"(r) : "v"(x)); return (bf16_t)r; }
DI int crow(int reg, int h) { return (reg & 3) + 8 * (reg >> 2) + 4 * h; }
DI f32x16 zero16() { f32x16 z; _Pragma("unroll") for (int i = 0; i < 16; ++i) z[i] = 0.f; return z; }
DI bf16x8 pack8(float a0, float a1, float a2, float a3, float a4, float a5, float a6, float a7) {
    u32x4 u; u.x = pack2(a0, a1); u.y = pack2(a2, a3); u.z = pack2(a4, a5); u.w = pack2(a6, a7); return __builtin_bit_cast(bf16x8, u);
}
DI bf16x8 ld8(const bf16_t* p) { return *(const bf16x8*)p; }
DI bf16x8 ld4x2(const bf16_t* p0, const bf16_t* p1) {
    u32x2 a = *(const u32x2*)p0, b = *(const u32x2*)p1; u32x4 u; u.x = a.x; u.y = a.y; u.z = b.x; u.w = b.y; return __builtin_bit_cast(bf16x8, u);
}
DI float xor_red32(float v) { v += __shfl_xor(v, 16); v += __shfl_xor(v, 8); v += __shfl_xor(v, 4); v += __shfl_xor(v, 2); v += __shfl_xor(v, 1); return v; }
DI float wave_sum(float v) { _Pragma("unroll") for (int o = 1; o < 64; o <<= 1) v += __shfl_xor(v, o); return v; }
DI float silu(float x) { return x / (1.f + __expf(-x)); }
DI float softplus(float x) { return fmaxf(x, 0.f) + log1pf(__expf(-fabsf(x))); }


#define XB_TMO      128
#define XB_XCNT(j)  (256  + 64 * (j))
#define XB_XSUB(j)  (1280 + 64 * (j))
#define XB_XGEN(j)  (2304 + 64 * (j))
#define XB_TOP      3328
#define XB_TOPGEN   3392
#define XCD_BAR_WORDS 3456
#define XB_SPIN_CAP (1u << 20)
#define LAS __attribute__((address_space(3)))
DI unsigned xb_ld(unsigned* p)              { return __hip_atomic_load(p, __ATOMIC_RELAXED, __HIP_MEMORY_SCOPE_AGENT); }
DI unsigned xb_add(unsigned* p, unsigned v) { return __hip_atomic_fetch_add(p, v, __ATOMIC_RELAXED, __HIP_MEMORY_SCOPE_AGENT); }
DI unsigned xb_xcc_id() { return (unsigned)__builtin_amdgcn_s_getreg((3 << 11) | 20) & 0xFu; }
#define XB_SPIN(cond, bar) do { unsigned _sp = 0; while (cond) { __builtin_amdgcn_s_sleep(1); \
    if ((++_sp & 255u) == 0u) { if (xb_ld(&(bar)[XB_TMO])) break; if (_sp > XB_SPIN_CAP) { atomicAdd(&(bar)[XB_TMO], 1u); break; } } } } while (0)
struct XcdBarrier { unsigned* bar; unsigned x; volatile LAS unsigned* st; };
DI XcdBarrier xcd_barrier_post(unsigned* bar, volatile LAS unsigned* st) {
    XcdBarrier b; b.bar = bar; b.x = xb_xcc_id(); b.st = st;
    if (__builtin_amdgcn_workitem_id_x() == 0) (void)xb_add(&bar[XB_XCNT(b.x)], 1u);
    return b;
}
DI void xcd_barrier_complete(unsigned* bar, unsigned x, unsigned& nloc, unsigned& nx) {
    const unsigned G = gridDim.x * gridDim.y * gridDim.z;
    unsigned sum, cnt, mine, sp = 0u;
    for (;;) {
        sum = 0u; cnt = 0u; mine = 0u;
#pragma unroll
        for (unsigned j = 0; j < 16; ++j) { const unsigned c = xb_ld(&bar[XB_XCNT(j)]); sum += c; cnt += (c > 0u) ? 1u : 0u; mine = (j == x) ? c : mine; }
        if (sum == G) break;
        __builtin_amdgcn_s_sleep(1);
        if ((++sp & 255u) == 0u) { if (xb_ld(&bar[XB_TMO])) break; if (sp > XB_SPIN_CAP) { atomicAdd(&bar[XB_TMO], 1u); break; } }
    }
    nloc = mine > 0u ? mine : 1u; nx = cnt > 0u ? cnt : 1u;
}
DI void xcd_barrier(const XcdBarrier& b) {
    asm volatile("s_waitcnt vmcnt(0)" ::: "memory");
    __syncthreads();
    if (__builtin_amdgcn_workitem_id_x() == 0) {
        unsigned* bar = b.bar;
        __builtin_amdgcn_s_waitcnt(0);
        unsigned nloc = b.st[0], nx = b.st[1];
        if (nloc == 0u) { xcd_barrier_complete(bar, b.x, nloc, nx); b.st[0] = nloc; b.st[1] = nx; }
        const unsigned old = xb_add(&bar[XB_XSUB(b.x)], 1u);
        const unsigned gen = old / nloc;
        if (old + 1u == (gen + 1u) * nloc) {
            __builtin_amdgcn_fence(__ATOMIC_RELEASE, "agent");
            asm volatile("s_waitcnt vmcnt(0)" ::: "memory");
            const unsigned og = xb_add(&bar[XB_TOP], 1u);
            const unsigned tg = og / nx;
            if (og + 1u == (tg + 1u) * nx) xb_add(&bar[XB_TOPGEN], 1u);
            else XB_SPIN(xb_ld(&bar[XB_TOPGEN]) == tg, bar);
            __builtin_amdgcn_fence(__ATOMIC_ACQUIRE, "agent");
            xb_add(&bar[XB_XGEN(b.x)], 1u);
            asm volatile("s_waitcnt vmcnt(0)" ::: "memory");
        } else {
            XB_SPIN(xb_ld(&bar[XB_XGEN(b.x)]) == gen, bar);
            __builtin_amdgcn_fence(__ATOMIC_ACQUIRE, "agent");
            asm volatile("s_waitcnt vmcnt(0)" ::: "memory");
        }
    }
    __syncthreads();
}

DI void row_info(int r, int& b, int& t, int& L) { if (r < NL) { b = r >> 12; t = r & 4095; L = SEQ; } else { int q = r - NL; b = q >> 8; t = q & 255; L = CTX; } }

template <class Epi, class ColV>
DI void gemm_tile(const bf16_t* __restrict__ A, int lda, const bf16_t* __restrict__ Bt, int ldb, int K, int m0, int n0, unsigned char* smem, Epi epi, ColV colv, const bf16_t* __restrict__ HYT = nullptr) {
    constexpr int LS = 72;
    bf16_t* As = (bf16_t*)smem;
    bf16_t* Bs = As + 2 * 128 * LS;
    const int tid = get_tid(), lane = tid & 63, wave = tid >> 6, wr = wave >> 1, wc = wave & 1, li = lane & 31, lh = lane >> 5;
    f32x16 acc[2][2];
#pragma unroll
    for (int a = 0; a < 2; ++a)
#pragma unroll
        for (int b = 0; b < 2; ++b) acc[a][b] = zero16();
    u32x4 R0[8], R1[8];
    const int nk = K >> 6;
    auto gload = [&](u32x4 (&r)[8], int kt) {
#pragma unroll
        for (int i = 0; i < 4; ++i) { int id = tid + 256 * i, row = id >> 3, kc = id & 7;
            if (HYT && kt >= 12) r[i] = *(const u32x4*)(HYT + (size_t)((kt - 12) * 64 + (id >> 4)) * NT + m0 + (id & 15) * 8);
            else r[i] = *(const u32x4*)(A + (size_t)(m0 + row) * lda + kt * 64 + kc * 8);
            r[4 + i] = *(const u32x4*)(Bt + (size_t)(n0 + row) * ldb + kt * 64 + kc * 8); }
    };
    auto sstore = [&](const u32x4 (&r)[8], int buf, int kt) {
#pragma unroll
        for (int i = 0; i < 4; ++i) { int id = tid + 256 * i, row = id >> 3, kc = id & 7;
            if (HYT && kt >= 12) { const int kk = id >> 4, rr = (id & 15) * 8; bf16_t* d = As + (buf * 128 + rr) * LS + kk; const bf16x8 v = __builtin_bit_cast(bf16x8, r[i]);
#pragma unroll
                for (int e = 0; e < 8; ++e) d[e * LS] = (bf16_t)v[e]; }
            else *(u32x4*)(As + (buf * 128 + row) * LS + kc * 8) = r[i];
            *(u32x4*)(Bs + (buf * 128 + row) * LS + kc * 8) = r[4 + i]; }
    };
    auto step = [&](int kt, u32x4 (&ldset)[8], const u32x4 (&stset)[8]) {
        const int buf = kt & 1;
        if (kt + 2 < nk) gload(ldset, kt + 2);
        const bf16_t* Ab = As + (buf * 128 + 64 * wr + li) * LS + 8 * lh;
        const bf16_t* Bb = Bs + (buf * 128 + 64 * wc + li) * LS + 8 * lh;
        bf16x8 fa[2][2], fb[2][2], ga[2][2], gb[2][2];
#pragma unroll
        for (int k2 = 0; k2 < 2; ++k2) { fa[k2][0] = ld8(Ab + 16 * k2); fa[k2][1] = ld8(Ab + 32 * LS + 16 * k2); fb[k2][0] = ld8(Bb + 16 * k2); fb[k2][1] = ld8(Bb + 32 * LS + 16 * k2); }
        __builtin_amdgcn_sched_barrier(0);
#pragma unroll
        for (int k2 = 0; k2 < 2; ++k2) {
            acc[0][0] = MFMA(fa[k2][0], fb[k2][0], acc[0][0]); acc[0][1] = MFMA(fa[k2][0], fb[k2][1], acc[0][1]);
            acc[1][0] = MFMA(fa[k2][1], fb[k2][0], acc[1][0]); acc[1][1] = MFMA(fa[k2][1], fb[k2][1], acc[1][1]);
        }
#pragma unroll
        for (int k2 = 0; k2 < 2; ++k2) { const int ks = 2 + k2; ga[k2][0] = ld8(Ab + 16 * ks); ga[k2][1] = ld8(Ab + 32 * LS + 16 * ks); gb[k2][0] = ld8(Bb + 16 * ks); gb[k2][1] = ld8(Bb + 32 * LS + 16 * ks); }
#pragma unroll
        for (int k2 = 0; k2 < 2; ++k2) {
            acc[0][0] = MFMA(ga[k2][0], gb[k2][0], acc[0][0]); acc[0][1] = MFMA(ga[k2][0], gb[k2][1], acc[0][1]);
            acc[1][0] = MFMA(ga[k2][1], gb[k2][0], acc[1][0]); acc[1][1] = MFMA(ga[k2][1], gb[k2][1], acc[1][1]);
        }
        if (kt + 1 < nk) sstore(stset, buf ^ 1, kt + 1);
#pragma unroll
        for (int i = 0; i < 8; ++i) { __builtin_amdgcn_sched_group_barrier(0x008, 1, 0); __builtin_amdgcn_sched_group_barrier(0x100, 1, 0); }
#pragma unroll
        for (int i = 0; i < 8; ++i) { __builtin_amdgcn_sched_group_barrier(0x008, 1, 0); __builtin_amdgcn_sched_group_barrier(0x200, 1, 0); }
        __builtin_amdgcn_sched_barrier(0);
        __syncthreads();
    };
    gload(R0, 0); gload(R1, 1);
    sstore(R0, 0, 0); __syncthreads();
    for (int kt = 0; kt < nk; kt += 2) {
        step(kt, R0, R1);
        if (kt + 1 < nk) step(kt + 1, R1, R0);
    }
    const float cv0 = colv(m0, n0 + 64 * wc + li), cv1 = colv(m0, n0 + 64 * wc + 32 + li);
#pragma unroll
    for (int mi = 0; mi < 2; ++mi)
#pragma unroll
        for (int ni = 0; ni < 2; ++ni)
#pragma unroll
            for (int reg = 0; reg < 16; ++reg)
                epi(m0 + 64 * wr + 32 * mi + crow(reg, lh), n0 + 64 * wc + 32 * ni + li, acc[mi][ni][reg], ni ? cv1 : cv0);
}

DI void transpose_f32(const float* __restrict__ src, int ld_src, int Cvalid, bf16_t* __restrict__ dst, int ld_dst, int r0, int c0, const float* rscale, float* tile) {
    const int tid = get_tid();
    float tv[16];
#pragma unroll
    for (int j = 0; j < 16; ++j) { const int i = tid + 256 * j, r = i >> 6, c = i & 63; tv[j] = (c0 + c < Cvalid) ? src[(size_t)(r0 + r) * ld_src + c0 + c] : 0.f; }
#pragma unroll
    for (int j = 0; j < 16; ++j) { const int i = tid + 256 * j, r = i >> 6, c = i & 63; float v = tv[j]; if (rscale) v *= rscale[r0 + r]; tile[r * 65 + c] = v; }
    __syncthreads();
#pragma unroll
    for (int j = 0; j < 16; ++j) { const int i = tid + 256 * j, c = i >> 6, r = i & 63; dst[(size_t)(c0 + c) * ld_dst + r0 + r] = f2bf(tile[r * 65 + c]); }
    __syncthreads();
}
DI void transpose_bf16(const bf16_t* __restrict__ src, int ld_src, bf16_t* __restrict__ dst, int ld_dst, int r0, int c0, float* tile) {
    const int tid = get_tid();
    bf16_t tv[16];
#pragma unroll
    for (int j = 0; j < 16; ++j) { const int i = tid + 256 * j, r = i >> 6, c = i & 63; tv[j] = src[(size_t)(r0 + r) * ld_src + c0 + c]; }
#pragma unroll
    for (int j = 0; j < 16; ++j) { const int i = tid + 256 * j, r = i >> 6, c = i & 63; tile[r * 65 + c] = bf2f(tv[j]); }
    __syncthreads();
#pragma unroll
    for (int j = 0; j < 16; ++j) { const int i = tid + 256 * j, c = i >> 6, r = i & 63; dst[(size_t)(c0 + c) * ld_dst + r0 + r] = f2bf(tile[r * 65 + c]); }
    __syncthreads();
}
constexpr int WT_IN = 16 * 36, WT_OUT = 16 * 16, WT_FF1 = 16 * 64, WT_FF2 = 64 * 16, WT_UQ = 4 * 9, WT_UKV = 2 * 12;
constexpr int WT_TOTAL = WT_IN + WT_OUT + WT_FF1 + WT_FF2 + WT_UQ + WT_UKV;
DI void wprep_item(const Params& p, int layer, int it, unsigned char* smem) {
    float* tile = (float*)smem; bf16_t* W = (bf16_t*)(p.ws + wbase(layer));
    if (it < WT_IN) { int kt = it / 36, nt = it % 36; transpose_f32(p.in[I_WIN] + (size_t)layer * 1024 * INC, INC, INC, (bf16_t*)((unsigned char*)W + W_IN), 1024, kt * 64, nt * 64, nullptr, tile); return; } it -= WT_IN;
    if (it < WT_OUT) { int kt = it / 16, nt = it % 16; transpose_f32(p.in[I_WOUT] + (size_t)layer * 1024 * 1024, 1024, 1024, (bf16_t*)((unsigned char*)W + W_OUT), 1024, kt * 64, nt * 64, nullptr, tile); return; } it -= WT_OUT;
    if (it < WT_FF1) { int kt = it / 64, nt = it % 64; transpose_f32(p.in[I_WFF1] + (size_t)layer * 1024 * 4096, 4096, 4096, (bf16_t*)((unsigned char*)W + W_FF1), 1024, kt * 64, nt * 64, nullptr, tile); return; } it -= WT_FF1;
    if (it < WT_FF2) { int kt = it / 16, nt = it % 16; transpose_f32(p.in[I_WFF2] + (size_t)layer * 4096 * 1024, 1024, 1024, (bf16_t*)((unsigned char*)W + W_FF2), 4096, kt * 64, nt * 64, nullptr, tile); return; } it -= WT_FF2;
    if (it < WT_UQ) { int kt = it / 9, nt = it % 9; transpose_f32(p.in[I_WUQ] + (size_t)layer * 256 * 576, 576, 576, (bf16_t*)((unsigned char*)W + W_UQ), 256, kt * 64, nt * 64, p.in[I_GCQ] + layer * 256, tile); return; } it -= WT_UQ;
    { int kt = it / 12, nt = it % 12; transpose_f32(p.in[I_WUKV] + (size_t)layer * 128 * 768, 768, 768, (bf16_t*)((unsigned char*)W + W_UKV), 128, kt * 64, nt * 64, p.in[I_GCKV] + layer * 128, tile); }
}
DI void mod_item(const Params& p, int it, unsigned char* smem) {
    const int layer = it / 192, c0 = (it % 192) * 32, tid = get_tid();
    float* sl = (float*)smem;
    float* red = sl + 5 * 1024;
#pragma unroll
    for (int j = 0; j < 20; ++j) { const int i = tid + 256 * j, b = i >> 10, k = i & 1023; float v = (b < 4) ? p.in[I_C][b * 1024 + k] : p.in[I_CCTX][k]; sl[i] = silu(v); }
    __syncthreads();
    const int col = tid & 31, kg = tid >> 5;
    const float* W = p.in[I_WMOD] + (size_t)layer * 1024 * 6144 + c0 + col;
    float a0 = 0, a1 = 0, a2 = 0, a3 = 0, a4 = 0;
#pragma unroll 8
    for (int k = kg * 128; k < kg * 128 + 128; ++k) { float w = W[(size_t)k * 6144]; a0 += sl[k] * w; a1 += sl[1024 + k] * w; a2 += sl[2048 + k] * w; a3 += sl[3072 + k] * w; a4 += sl[4096 + k] * w; }
    red[(kg * 5 + 0) * 32 + col] = a0; red[(kg * 5 + 1) * 32 + col] = a1; red[(kg * 5 + 2) * 32 + col] = a2; red[(kg * 5 + 3) * 32 + col] = a3; red[(kg * 5 + 4) * 32 + col] = a4;
    __syncthreads();
    if (tid < 160) { int b = tid >> 5, c = tid & 31; float s = p.in[I_BMOD][layer * 6144 + c0 + c];
#pragma unroll
        for (int g = 0; g < 8; ++g) s += red[(g * 5 + b) * 32 + c];
        ((float*)(p.ws + WS_MOD))[(size_t)(layer * 5 + b) * 6144 + c0 + c] = s; }
    __syncthreads();
}
template <int L>
DI void filt_item(const Params& p, int layer, int it, unsigned char* smem, bf16_t* Fout, float* Part) {
    const int lb = it >> 2, cb = it & 3, tid = get_tid();
    float* feats = (float*)smem;
    float* h1 = feats + 32 * 33;
    float* h2 = h1 + 32 * 64;
    float* w1s = h2 + 32 * 64;
    float* w2s = w1s + 33 * 64;
    {
        const float* w1g = p.in[I_WF1] + layer * 33 * 64; const float* w2g = p.in[I_WF2] + layer * 64 * 64;
        float t1[9], t2[16];
#pragma unroll
        for (int j = 0; j < 9; ++j) { const int i = tid + 256 * j; t1[j] = (i < 33 * 64) ? w1g[i] : 0.f; }
#pragma unroll
        for (int j = 0; j < 16; ++j) t2[j] = w2g[tid + 256 * j];
#pragma unroll
        for (int j = 0; j < 9; ++j) { const int i = tid + 256 * j; if (i < 33 * 64) w1s[i] = t1[j]; }
#pragma unroll
        for (int j = 0; j < 16; ++j) w2s[tid + 256 * j] = t2[j];
    }
    const float wstep = (float)(2.0 * 3.14159265358979323846 / (double)L);
#pragma unroll 1
    for (int i = tid; i < 32 * 33; i += 256) { int lg = i / 33, f = i % 33, lag = lb * 32 + lg; float v;
        if (f == 0) v = (float)lag / (float)(L - 1);
        else { int bi = (f - 1) & 15; float band = 1e-4f + (float)bi * ((15.f - 1e-4f) / 15.f); float ang = band * (wstep * (float)lag); v = (f <= 16) ? cosf(ang) : -sinf(ang); }
        feats[i] = v; }
    __syncthreads();
    const float* w1 = w1s; const float* w2 = w2s;
#pragma unroll 1
    for (int i = tid; i < 2048; i += 256) { int lg = i >> 6, j = i & 63; float s = p.in[I_BF1][layer * 64 + j];
#pragma unroll 3
        for (int f = 0; f < 33; ++f) s += feats[lg * 33 + f] * w1[f * 64 + j];
        h1[i] = sinf(p.in[I_FQ1][layer * 64 + j] * s); }
    __syncthreads();
#pragma unroll 1
    for (int i = tid; i < 2048; i += 256) { int lg = i >> 6, j = i & 63; float s = p.in[I_BF2][layer * 64 + j];
#pragma unroll 4
        for (int f = 0; f < 64; ++f) s += h1[lg * 64 + f] * w2[f * 64 + j];
        h2[i] = sinf(p.in[I_FQ2][layer * 64 + j] * s); }
    __syncthreads();
    const int col = cb * 256 + tid, dir = col >> 9, o = (col >> 8) & 1, ch = col & 255;
    const float* w3 = p.in[I_WF3] + (size_t)layer * 64 * 1024 + col;
    const float d0 = -4.605170185988091f / 1.5f, d1 = -4.605170185988091f / 0.3f;
    const float delta = fabsf(d0 + (float)ch * ((d1 - d0) / 255.f));
    bf16_t* F = Fout + (size_t)(o * 256 + ch) * (2 * L);
    float asum = 0.f;
    float wreg[64];
#pragma unroll
    for (int k = 0; k < 64; ++k) wreg[k] = w3[k * 1024];
#pragma unroll 1
    for (int lg = 0; lg < 32; ++lg) {
        float a0 = 0.f, a1 = 0.f;
#pragma unroll
        for (int k = 0; k < 64; k += 8) { const f32x4 hv = *(const f32x4*)(h2 + lg * 64 + k), hw = *(const f32x4*)(h2 + lg * 64 + k + 4);
            a0 += hv.x * wreg[k] + hv.y * wreg[k + 1] + hv.z * wreg[k + 2] + hv.w * wreg[k + 3];
            a1 += hw.x * wreg[k + 4] + hw.y * wreg[k + 5] + hw.z * wreg[k + 6] + hw.w * wreg[k + 7]; }
        const int lag = lb * 32 + lg; const float t01 = (float)lag / (float)(L - 1); const float v = (a0 + a1) * __expf(-t01 * delta);
        if (dir == 0) { F[L + lag] = f2bf(v); asum += fabsf(v); }
        else { if (lag == 0) F[0] = 0; else { F[L - lag] = f2bf(v); asum += fabsf(v); } }
    }
    Part[lb * 1024 + col] = asum;
    __syncthreads();
}

DI void norm_rows(const Params& p, int layer, int which  , int nrows, bool from_input) {
    const int lane = get_tid() & 63, gw = blockIdx.x * 4 + (get_tid() >> 6), NGW = gridDim.x * 4;
    const float* g = p.in[which ? I_GMLP : I_GMIX] + layer * 1024;
    const float* MOD = (const float*)(p.ws + WS_MOD) + (size_t)layer * 5 * 6144;
    bf16_t* H = (bf16_t*)(p.ws + WS_H);
    const int rpw = (nrows + NGW - 1) / NGW, rbeg = gw * rpw, rend = min(nrows, rbeg + rpw);
    f32x4 ga[4], sb[4]; int mb_cur = -1;
    auto rowsrc = [&](int r) -> const float* {
        return (r < NL) ? (from_input ? p.in[I_X] : p.out) + (size_t)r * 1024 : (from_input ? p.in[I_CTX] : (const float*)(p.ws + WS_XC)) + (size_t)(r - NL) * 1024; };
    f32x4 v[4], vn[4];
    if (rbeg < rend) { const float* s0 = rowsrc(rbeg);
#pragma unroll
        for (int j = 0; j < 4; ++j) v[j] = *(const f32x4*)(s0 + 256 * j + 4 * lane); }
    for (int r = rbeg; r < rend; ++r) {
        const int mb = (r < NL) ? (r >> 12) : 4;
        if (r + 1 < rend) { const float* s1 = rowsrc(r + 1);
#pragma unroll
            for (int j = 0; j < 4; ++j) vn[j] = *(const f32x4*)(s1 + 256 * j + 4 * lane); }
        float ss = 0.f;
#pragma unroll
        for (int j = 0; j < 4; ++j) ss += v[j].x * v[j].x + v[j].y * v[j].y + v[j].z * v[j].z + v[j].w * v[j].w;
        if (mb != mb_cur) {
            const float* sh = MOD + mb * 6144 + (which ? 3072 : 0); const float* sc = sh + 1024;
#pragma unroll
            for (int j = 0; j < 4; ++j) { const int c = 256 * j + 4 * lane; const f32x4 gg = *(const f32x4*)(g + c), s1 = *(const f32x4*)(sc + c); sb[j] = *(const f32x4*)(sh + c);
                ga[j].x = gg.x * (1.f + s1.x); ga[j].y = gg.y * (1.f + s1.y); ga[j].z = gg.z * (1.f + s1.z); ga[j].w = gg.w * (1.f + s1.w); }
            mb_cur = mb;
        }
        const float rstd = 1.f / sqrtf(wave_sum(ss) * (1.f / 1024.f) + EPS);
#pragma unroll
        for (int j = 0; j < 4; ++j) { const int c = 256 * j + 4 * lane;
            const float o0 = v[j].x * rstd * ga[j].x + sb[j].x, o1 = v[j].y * rstd * ga[j].y + sb[j].y, o2 = v[j].z * rstd * ga[j].z + sb[j].z, o3 = v[j].w * rstd * ga[j].w + sb[j].w;
            u32x2 w; w.x = pack2(o0, o1); w.y = pack2(o2, o3); *(u32x2*)(H + (size_t)r * 1024 + c) = w; }
#pragma unroll
        for (int j = 0; j < 4; ++j) v[j] = vn[j];
    }
}

DI void hyconv_item(const Params& p, int layer, int it, unsigned char* smem) {
    const int rt = it / 12, ct = it % 12, r0 = rt * 64, c0 = ct * 64, tid = get_tid();
    float* tile = (float*)smem;
    const bf16_t* PROJ = (const bf16_t*)(p.ws + WS_PROJ);
    int b, t, L; row_info(r0, b, t, L);
    u32x2 hv[5];
#pragma unroll
    for (int j = 0; j < 5; ++j) { const int i = tid + 256 * j, rr = i >> 4, c = (i & 15) * 4, tt = t + rr - 1; hv[j].x = 0u; hv[j].y = 0u;
        if (i < 66 * 16 && tt >= 0 && tt < L) hv[j] = *(const u32x2*)(PROJ + (size_t)(r0 + rr - 1) * INP + O_HY + c0 + c); }
#pragma unroll
    for (int j = 0; j < 5; ++j) { const int i = tid + 256 * j, rr = i >> 4, c = (i & 15) * 4; const u32x2 v = hv[j];
        if (i < 66 * 16) { float* tp = tile + rr * 65 + c; tp[0] = bf2f((bf16_t)(v.x & 0xffff)); tp[1] = bf2f((bf16_t)(v.x >> 16)); tp[2] = bf2f((bf16_t)(v.y & 0xffff)); tp[3] = bf2f((bf16_t)(v.y >> 16)); } }
    const float* w = p.in[I_WCH] + layer * 3 * 768; const float* bb = p.in[I_BCH] + layer * 768;
    bf16_t* P = (bf16_t*)(p.ws + WS_P);
    float* wl = tile + 66 * 65;
    { const int q = tid >> 6, c = tid & 63; wl[tid] = (q == 0) ? bb[c0 + c] : w[(q - 1) * 768 + c0 + c]; }
    __syncthreads();
#pragma unroll
    for (int j = 0; j < 8; ++j) { const int i = tid + 256 * j, c = i >> 5, rp = (i & 31) * 2, cc = c0 + c;
        const float t0 = tile[rp * 65 + c], t1 = tile[(rp + 1) * 65 + c], t2 = tile[(rp + 2) * 65 + c], t3 = tile[(rp + 3) * 65 + c];
        const float bq = wl[c], wa = wl[64 + c], wb = wl[128 + c], wc = wl[192 + c];
        const float v0 = bq + wa * t0 + wb * t1 + wc * t2, v1 = bq + wa * t1 + wb * t2 + wc * t3;
        *(unsigned*)(P + (size_t)cc * NT + r0 + rp) = pack2(v0, v1); }
    __syncthreads();
}
DI void ssmconv_item(const Params& p, int layer, int it, const float* w, const float* bb) {
    const int r0 = it * 32, tid = get_tid();
    const bf16_t* PROJ = (const bf16_t*)(p.ws + WS_PROJ); bf16_t* UZ = (bf16_t*)(p.ws + WS_UZ); float* DT = (float*)(p.ws + WS_DT);
    int b, t0, L; row_info(r0, b, t0, L);
#pragma unroll 1
    for (int j0 = 0; j0 < 10; j0 += 5) {
        bf16x8 xc[5], xp[5], xn[5];
#pragma unroll
        for (int j = 0; j < 5; ++j) { const int i = tid + 256 * (j0 + j), rl = i / 80, c = (i - rl * 80) * 8, t = t0 + rl; const size_t r = r0 + rl;
            const bf16_t* src = PROJ + r * INP + O_XBC + c;
            xc[j] = ld8(src); xp[j] = xc[j]; xn[j] = xc[j];
            if (t > 0) xp[j] = ld8(src - INP);
            if (t < L - 1) xn[j] = ld8(src + INP); }
#pragma unroll
        for (int j = 0; j < 5; ++j) { const int i = tid + 256 * (j0 + j), rl = i / 80, c = (i - rl * 80) * 8, t = t0 + rl; const size_t r = r0 + rl;
            const bool hp = t > 0, hn = t < L - 1;
            const f32x4 b0 = *(const f32x4*)(bb + c), b1 = *(const f32x4*)(bb + c + 4), wa0 = *(const f32x4*)(w + c), wa1 = *(const f32x4*)(w + c + 4),
                        wb0 = *(const f32x4*)(w + 640 + c), wb1 = *(const f32x4*)(w + 640 + c + 4), wc0 = *(const f32x4*)(w + 1280 + c), wc1 = *(const f32x4*)(w + 1280 + c + 4);
            const float bv[8] = { b0.x, b0.y, b0.z, b0.w, b1.x, b1.y, b1.z, b1.w }, w0v[8] = { wa0.x, wa0.y, wa0.z, wa0.w, wa1.x, wa1.y, wa1.z, wa1.w },
                        w1v[8] = { wb0.x, wb0.y, wb0.z, wb0.w, wb1.x, wb1.y, wb1.z, wb1.w }, w2v[8] = { wc0.x, wc0.y, wc0.z, wc0.w, wc1.x, wc1.y, wc1.z, wc1.w };
            float o[8];
#pragma unroll
            for (int e = 0; e < 8; ++e) { float v = bv[e] + w1v[e] * bf2f((bf16_t)xc[j][e]);
                if (hp) v += w0v[e] * bf2f((bf16_t)xp[j][e]);
                if (hn) v += w2v[e] * bf2f((bf16_t)xn[j][e]);
                o[e] = silu(v); }
            *(bf16x8*)(UZ + r * 1024 + c) = pack8(o[0], o[1], o[2], o[3], o[4], o[5], o[6], o[7]); }
    }
    { u32x4 zc[6];
#pragma unroll
      for (int j = 0; j < 6; ++j) { const int i = tid + 256 * j, rl = i / 48, c = (i - rl * 48) * 8; zc[j] = *(const u32x4*)(PROJ + (size_t)(r0 + rl) * INP + O_Z + c); }
#pragma unroll
      for (int j = 0; j < 6; ++j) { const int i = tid + 256 * j, rl = i / 48, c = (i - rl * 48) * 8; *(u32x4*)(UZ + (size_t)(r0 + rl) * 1024 + 640 + c) = zc[j]; } }
    for (int i = tid; i < 32 * 12; i += 256) { const int rl = i / 12, c = i - rl * 12; const size_t r = r0 + rl;
        DT[r * 12 + c] = softplus(bf2f(PROJ[r * INP + O_DT + c]) + p.in[I_DTB][layer * 12 + c]); }
}
DI void qkv_item(const Params& p, int layer, int it, unsigned char* smem) {
    const int tid = get_tid(), lane = tid & 63, wave = tid >> 6, li = lane & 31, lh = lane >> 5;
    const int ug = it & 3, hd0 = 3 * (ug & 1);
    const int rbase = (it >> 2) * 128 + 32 * wave;
    const bf16_t* PROJ = (const bf16_t*)(p.ws + WS_PROJ);
    bf16_t* Ws = (bf16_t*)smem;
    int b, t0, L; row_info(rbase, b, t0, L);
    const bool lat = rbase < NL;
    float cs[16], sn[16];
    {
        const int axis = li >> 4, f = li & 7; const float inv = exp2f(-(float)f * (13.287712379549449f / 8.f));
#pragma unroll
        for (int reg = 0; reg < 16; ++reg) { int t = t0 + crow(reg, lh); float pos = (float)(axis ? (t & 63) : (t >> 6)); const float ang = pos * inv; cs[reg] = __cosf(ang); sn[reg] = __sinf(ang); }
    }
    const bool second = (li >> 3) & 1;
    if (ug < 2) {
        const bf16_t* Wq = (const bf16_t*)(p.ws + wbase(layer) + W_UQ);
        const float* gq = p.in[I_GQH] + layer * 96;
        const bf16_t* arow = PROJ + (size_t)(rbase + li) * INP + O_CQ + 8 * lh;
        float ss = 0.f;
#pragma unroll 1
        for (int kh = 0; kh < 2; ++kh) { bf16x8 a[8];
#pragma unroll
            for (int ks = 0; ks < 8; ++ks) a[ks] = ld8(arow + 128 * kh + 16 * ks);
#pragma unroll
            for (int ks = 0; ks < 8; ++ks) {
#pragma unroll
                for (int j = 0; j < 8; ++j) { float x = bf2f((bf16_t)a[ks][j]); ss += x * x; } } }
        ss += __shfl_xor(ss, 32);
        const float alpha = 1.f / sqrtf(ss * (1.f / 256.f) + EPS);
        float al[16];
#pragma unroll
        for (int reg = 0; reg < 16; ++reg) al[reg] = __shfl(alpha, crow(reg, lh));
        const float g0 = gq[li], g1 = gq[32 + li], g2 = gq[64 + li];
#pragma unroll 1
        for (int hd = hd0; hd < hd0 + 3; ++hd) {
            __syncthreads();
#pragma unroll 1
            for (int jb = 0; jb < 12; jb += 6) { u32x4 sw[6];
#pragma unroll
              for (int j = 0; j < 6; ++j) { const int i = tid + 256 * (jb + j), n = i >> 5, kc = i & 31; sw[j] = *(const u32x4*)(Wq + (size_t)(hd * 96 + n) * 256 + kc * 8); }
#pragma unroll
              for (int j = 0; j < 6; ++j) { const int i = tid + 256 * (jb + j), n = i >> 5, kc = i & 31; *(u32x4*)(Ws + n * 264 + kc * 8) = sw[j]; } }
            __syncthreads();
            f32x16 c0 = zero16(), c1 = zero16(), c2 = zero16();
            const bf16_t* wb = Ws + li * 264 + 8 * lh;
#pragma unroll 1
            for (int kh = 0; kh < 4; ++kh) { bf16x8 a[4];
#pragma unroll
                for (int ks = 0; ks < 4; ++ks) a[ks] = ld8(arow + 64 * kh + 16 * ks);
                __builtin_amdgcn_sched_barrier(0);
#pragma unroll
                for (int ks = 0; ks < 4; ++ks) { const bf16_t* w_ = wb + 64 * kh + 16 * ks;
                    c0 = MFMA(a[ks], ld8(w_), c0); c1 = MFMA(a[ks], ld8(w_ + 32 * 264), c1); c2 = MFMA(a[ks], ld8(w_ + 64 * 264), c2);
                    if ((ks & 1) == 1) __builtin_amdgcn_sched_barrier(0);
                } }
            bf16_t* Qp = lat ? (bf16_t*)(p.ws + WS_Q) + ((size_t)(b * 6 + hd) * SEQ + t0) * 96 : (bf16_t*)(p.ws + WS_QC) + ((size_t)(b * 6 + hd) * CTX + t0) * 96;
#pragma unroll
            for (int reg = 0; reg < 16; ++reg) {
                float s2 = xor_red32(c0[reg] * c0[reg] + c1[reg] * c1[reg] + c2[reg] * c2[reg]);
                const float ar = al[reg], rs = 1.f / sqrtf(ar * ar * s2 * (1.f / 96.f) + EPS), sc = ar * rs;
                float v0 = c0[reg] * sc * g0, v1 = c1[reg] * sc * g1, v2 = c2[reg] * sc * g2;
                float pr = __shfl_xor(v2, 8);
                if (lat) v2 = second ? (v2 * cs[reg] + pr * sn[reg]) : (v2 * cs[reg] - pr * sn[reg]);
                bf16_t* q = Qp + (size_t)crow(reg, lh) * 96;
                q[li] = f2bf(v0); q[32 + li] = f2bf(v1); q[64 + li] = f2bf(v2);
                if ((reg & 3) == 3) __builtin_amdgcn_sched_barrier(0);
            }
        }
        __syncthreads();
    }
    else {
        const bf16_t* Wkv = (const bf16_t*)(p.ws + wbase(layer) + W_UKV);
        const float* gk = p.in[I_GKH] + layer * 96;
        const bf16_t* arow = PROJ + (size_t)(rbase + li) * INP + O_CKV + 8 * lh;
        float ss = 0.f;
        { bf16x8 a[8];
#pragma unroll
          for (int ks = 0; ks < 8; ++ks) a[ks] = ld8(arow + 16 * ks);
#pragma unroll
          for (int ks = 0; ks < 8; ++ks) {
#pragma unroll
            for (int j = 0; j < 8; ++j) { float x = bf2f((bf16_t)a[ks][j]); ss += x * x; } } }
        ss += __shfl_xor(ss, 32);
        const float alpha = 1.f / sqrtf(ss * (1.f / 128.f) + EPS);
        float al[16], krv[16];
#pragma unroll
        for (int reg = 0; reg < 16; ++reg) { al[reg] = __shfl(alpha, crow(reg, lh)); krv[reg] = bf2f(PROJ[(size_t)(rbase + crow(reg, lh)) * INP + O_KR + li]); }
        const float g0 = gk[li], g1 = gk[32 + li], g2 = gk[64 + li];
        const int kbase = lat ? (CTX + t0) : t0;
#pragma unroll 1
        for (int hd = hd0; hd < hd0 + 3; ++hd) {
            __syncthreads();
#pragma unroll 1
            for (int jb = 0; jb < 8; jb += 4) { u32x4 sw[4];
#pragma unroll
              for (int j = 0; j < 4; ++j) { const int i = tid + 256 * (jb + j), n = i >> 4, kc = i & 15; sw[j] = *(const u32x4*)(Wkv + (size_t)(hd * 128 + n) * 128 + kc * 8); }
#pragma unroll
              for (int j = 0; j < 4; ++j) { const int i = tid + 256 * (jb + j), n = i >> 4, kc = i & 15; *(u32x4*)(Ws + n * 136 + kc * 8) = sw[j]; } }
            __syncthreads();
            f32x16 c0 = zero16(), c1 = zero16(), c2 = zero16(), c3 = zero16();
            const bf16_t* wb = Ws + li * 136 + 8 * lh;
#pragma unroll 1
            for (int kh = 0; kh < 2; ++kh) { bf16x8 a[4];
#pragma unroll
                for (int ks = 0; ks < 4; ++ks) a[ks] = ld8(arow + 64 * kh + 16 * ks);
                __builtin_amdgcn_sched_barrier(0);
#pragma unroll
                for (int ks = 0; ks < 4; ++ks) { const bf16_t* w_ = wb + 64 * kh + 16 * ks;
                    c0 = MFMA(a[ks], ld8(w_), c0); c1 = MFMA(a[ks], ld8(w_ + 32 * 136), c1);
                    c2 = MFMA(a[ks], ld8(w_ + 64 * 136), c2); c3 = MFMA(a[ks], ld8(w_ + 96 * 136), c3);
                    __builtin_amdgcn_sched_barrier(0);
                } }
            bf16_t* Kp = (bf16_t*)(p.ws + WS_K) + ((size_t)(b * 6 + hd) * NKEY + kbase) * 96;
            bf16_t* Vp = (bf16_t*)(p.ws + WS_VT) + ((size_t)(b * 6 + hd) * 64) * NKEY + kbase;
#pragma unroll
            for (int reg = 0; reg < 16; ++reg) {
                const float ar = al[reg];
                float s2 = xor_red32(ar * ar * (c0[reg] * c0[reg] + c1[reg] * c1[reg]) + krv[reg] * krv[reg]);
                const float rs = 1.f / sqrtf(s2 * (1.f / 96.f) + EPS);
                float v0 = c0[reg] * ar * rs * g0, v1 = c1[reg] * ar * rs * g1, v2 = krv[reg] * rs * g2;
                float pr = __shfl_xor(v2, 8);
                if (lat) v2 = second ? (v2 * cs[reg] + pr * sn[reg]) : (v2 * cs[reg] - pr * sn[reg]);
                bf16_t* k = Kp + (size_t)crow(reg, lh) * 96;
                k[li] = f2bf(v0); k[32 + li] = f2bf(v1); k[64 + li] = f2bf(v2);
                if ((reg & 3) == 3) __builtin_amdgcn_sched_barrier(0);
            }
#pragma unroll
            for (int rg = 0; rg < 4; ++rg) {
                const int k0 = 8 * rg + 4 * lh;
                u32x2 w0, w1;
                w0.x = pack2(c2[4 * rg] * al[4 * rg], c2[4 * rg + 1] * al[4 * rg + 1]); w0.y = pack2(c2[4 * rg + 2] * al[4 * rg + 2], c2[4 * rg + 3] * al[4 * rg + 3]);
                w1.x = pack2(c3[4 * rg] * al[4 * rg], c3[4 * rg + 1] * al[4 * rg + 1]); w1.y = pack2(c3[4 * rg + 2] * al[4 * rg + 2], c3[4 * rg + 3] * al[4 * rg + 3]);
                *(u32x2*)(Vp + (size_t)li * NKEY + k0) = w0;
                *(u32x2*)(Vp + (size_t)(32 + li) * NKEY + k0) = w1;
            }
        }
        __syncthreads();
    }
}

DI void attn_item(const Params& p, const bf16_t* Qbase  , int bh, int q0, int nkeys, int out_row0, unsigned char* smem) {
    constexpr int KS = 104, VS = 68;
    bf16_t* Ks = (bf16_t*)smem;
    bf16_t* Vs = Ks + 2 * 64 * KS;
    const int tid = get_tid(), lane = tid & 63, wave = tid >> 6, li = lane & 31, lh = lane >> 5;
    const bf16_t* Kg = (const bf16_t*)(p.ws + WS_K) + (size_t)bh * NKEY * 96;
    const bf16_t* Vg = (const bf16_t*)(p.ws + WS_VT) + (size_t)bh * 64 * NKEY;
    bf16x8 qf[6];
#pragma unroll
    for (int ks = 0; ks < 6; ++ks) qf[ks] = ld8(Qbase + (size_t)(q0 + 32 * wave + li) * 96 + 16 * ks + 8 * lh);
    u32x4 rk[3], rv[2];
    auto gload = [&](int kt) {
#pragma unroll
        for (int i = 0; i < 3; ++i) { int id = tid + 256 * i; rk[i] = *(const u32x4*)(Kg + (size_t)kt * 64 * 96 + id * 8); }
#pragma unroll
        for (int i = 0; i < 2; ++i) { int id = tid + 256 * i, v = id >> 3, kc = id & 7; rv[i] = *(const u32x4*)(Vg + (size_t)v * NKEY + kt * 64 + kc * 8); }
    };
    auto sstore = [&](int buf) {
#pragma unroll
        for (int i = 0; i < 3; ++i) { int id = tid + 256 * i, key = id / 12, dc = id - key * 12; *(u32x4*)(Ks + (buf * 64 + key) * KS + dc * 8) = rk[i]; }
#pragma unroll
        for (int i = 0; i < 2; ++i) { int id = tid + 256 * i, v = id >> 3, kc = id & 7; bf16_t* d = Vs + (buf * 64 + v) * VS + kc * 8;
            u32x2 lo, hi; lo.x = rv[i].x; lo.y = rv[i].y; hi.x = rv[i].z; hi.y = rv[i].w; *(u32x2*)d = lo; *(u32x2*)(d + 4) = hi; }
    };
    const int nkt = nkeys >> 6;
    const float scl = 0.10206207261596577f * 1.4426950408889634f;
    f32x16 o0 = zero16(), o1 = zero16(); float m = -1e30f, l = 0.f;
    __syncthreads();
    gload(0); sstore(0); __syncthreads();
    for (int kt = 0; kt < nkt; ++kt) {
        const int buf = kt & 1;
        if (kt + 1 < nkt) gload(kt + 1);
        __builtin_amdgcn_sched_barrier(0);
        f32x16 s0 = zero16(), s1 = zero16();
        const bf16_t* kb = Ks + (buf * 64 + li) * KS + 8 * lh;
#pragma unroll
        for (int ks = 0; ks < 6; ++ks) { s0 = MFMA(ld8(kb + 16 * ks), qf[ks], s0); s1 = MFMA(ld8(kb + 32 * KS + 16 * ks), qf[ks], s1); }
        float mx = fmaxf(s0[0], s1[0]);
#pragma unroll
        for (int r = 1; r < 16; ++r) mx = fmaxf(fmaxf(mx, s0[r]), s1[r]);
        mx = fmaxf(mx, __shfl_xor(mx, 32));
        const float mn = fmaxf(m, mx);
        if (__any(mn > m)) {
            const float corr = __builtin_amdgcn_exp2f((m - mn) * scl);
            l *= corr;
#pragma unroll
            for (int r = 0; r < 16; ++r) { o0[r] *= corr; o1[r] *= corr; }
            m = mn;
        }
        const float nb = -m * scl;
        float sum0 = 0.f, sum1 = 0.f;
#pragma unroll
        for (int r = 0; r < 16; ++r) { s0[r] = __builtin_amdgcn_exp2f(fmaf(s0[r], scl, nb)); s1[r] = __builtin_amdgcn_exp2f(fmaf(s1[r], scl, nb)); sum0 += s0[r]; sum1 += s1[r]; }
        float sum = sum0 + sum1;
        sum += __shfl_xor(sum, 32);
        l += sum;
        bf16x8 pf[2][2];
        pf[0][0] = pack8(s0[0], s0[1], s0[2], s0[3], s0[4], s0[5], s0[6], s0[7]); pf[0][1] = pack8(s0[8], s0[9], s0[10], s0[11], s0[12], s0[13], s0[14], s0[15]);
        pf[1][0] = pack8(s1[0], s1[1], s1[2], s1[3], s1[4], s1[5], s1[6], s1[7]); pf[1][1] = pack8(s1[8], s1[9], s1[10], s1[11], s1[12], s1[13], s1[14], s1[15]);
        const bf16_t* vb = Vs + (buf * 64 + li) * VS + 4 * lh;
#pragma unroll
        for (int j = 0; j < 2; ++j)
#pragma unroll
            for (int s = 0; s < 2; ++s) {
                const int ko = 32 * j + 16 * s;
                o0 = MFMA(ld4x2(vb + ko, vb + ko + 8), pf[j][s], o0);
                o1 = MFMA(ld4x2(vb + 32 * VS + ko, vb + 32 * VS + ko + 8), pf[j][s], o1);
            }
        __builtin_amdgcn_sched_barrier(0);
        if (kt + 1 < nkt) sstore(buf ^ 1);
        __syncthreads();
    }
    const float inv = 1.f / l;
    bf16_t* MIX = (bf16_t*)(p.ws + WS_MIX);
    const int hd = bh % 6;
    bf16_t* orow = MIX + (size_t)(out_row0 + q0 + 32 * wave + li) * 1024 + hd * 64;
#pragma unroll
    for (int rg = 0; rg < 4; ++rg) {
        u32x2 w0, w1;
        w0.x = pack2(o0[4 * rg] * inv, o0[4 * rg + 1] * inv); w0.y = pack2(o0[4 * rg + 2] * inv, o0[4 * rg + 3] * inv);
        w1.x = pack2(o1[4 * rg] * inv, o1[4 * rg + 1] * inv); w1.y = pack2(o1[4 * rg + 2] * inv, o1[4 * rg + 3] * inv);
        *(u32x2*)(orow + 8 * rg + 4 * lh) = w0;
        *(u32x2*)(orow + 32 + 8 * rg + 4 * lh) = w1;
    }
}

DI void wave_scan128(const float* v, float* out, bool reverse, int lane) {
    const float v0 = v[2 * lane], v1 = v[2 * lane + 1];
    float s = v0 + v1;
#pragma unroll
    for (int o = 1; o < 64; o <<= 1) { float t = __shfl_up(s, o); if (lane >= o) s += t; }
    const float total = __shfl(s, 63);
    if (!reverse) { out[2 * lane] = s - v1; out[2 * lane + 1] = s; }
    else { out[2 * lane] = total - (s - v0 - v1); out[2 * lane + 1] = total - (s - v1); }
}
DI int chunk_row0(int b, int cidx) { return cidx < 2 ? NL + b * CTX + cidx * 128 : b * SEQ + (cidx - 2) * 128; }

DI void ssdA_item(const Params& p, int layer, int it, unsigned char* smem) {
    const int cidx = it % NCHK, hd = (it / NCHK) % 6, b = it / (NCHK * 6), g = hd / 3;
    const int tid = get_tid(), lane = tid & 63, wave = tid >> 6, li = lane & 31, lh = lane >> 5;
    constexpr int TS = 136;
    bf16_t* BT = (bf16_t*)smem;
    bf16_t* XT = BT + 64 * TS;
    float* dtv = (float*)(XT + 64 * TS);
    float* av = dtv + 256;
    float* cum = av + 256;
    const int r0 = chunk_row0(b, cidx);
    const bf16_t* UZ = (const bf16_t*)(p.ws + WS_UZ); const float* DT = (const float*)(p.ws + WS_DT);
    __syncthreads();
    { const int t = tid & 127, d = tid >> 7; const float dt = DT[(size_t)(r0 + t) * 12 + d * 6 + hd]; const float a = -__expf(p.in[I_ALOG][layer * 12 + d * 6 + hd]); dtv[d * 128 + t] = dt; av[d * 128 + t] = dt * a; }
    { bf16x8 sv[4];
#pragma unroll
      for (int q = 0; q < 4; ++q) { const int i = tid + 256 * q, t = i >> 3, c8 = i & 7; sv[q] = ld8(UZ + (size_t)(r0 + t) * 1024 + 384 + g * 64 + c8 * 8); }
#pragma unroll
      for (int q = 0; q < 4; ++q) { const int i = tid + 256 * q, t = i >> 3, c8 = i & 7;
#pragma unroll
        for (int j = 0; j < 8; ++j) BT[(c8 * 8 + j) * TS + t] = (bf16_t)sv[q][j]; } }
    __syncthreads();
    if (wave < 2) wave_scan128(av + wave * 128, cum + wave * 128, wave == 1, lane);
    __syncthreads();
    float* ST = (float*)(p.ws + stbase(layer)); float* DEC = (float*)(p.ws + stbase(layer) + ST_BYTES);
    for (int d = 0; d < 2; ++d) {
        const float total = d == 0 ? cum[127] : cum[128];
        { bf16x8 sv[4];
#pragma unroll
          for (int q = 0; q < 4; ++q) { const int i = tid + 256 * q, t = i >> 3, c8 = i & 7; sv[q] = ld8(UZ + (size_t)(r0 + t) * 1024 + hd * 64 + c8 * 8); }
#pragma unroll
          for (int q = 0; q < 4; ++q) { const int i = tid + 256 * q, t = i >> 3, c8 = i & 7;
            const float w = __expf(total - cum[d * 128 + t]) * dtv[d * 128 + t];
#pragma unroll
            for (int j = 0; j < 8; ++j) XT[(c8 * 8 + j) * TS + t] = f2bf(bf2f((bf16_t)sv[q][j]) * w); } }
        __syncthreads();
        const int pt = wave >> 1, nt = wave & 1;
        f32x16 acc = zero16();
#pragma unroll
        for (int ks = 0; ks < 8; ++ks) acc = MFMA(ld8(XT + (32 * pt + li) * TS + 16 * ks + 8 * lh), ld8(BT + (32 * nt + li) * TS + 16 * ks + 8 * lh), acc);
        float* st = ST + ((((size_t)d * 4 + b) * 6 + hd) * NCHK + cidx) * 4096;
#pragma unroll
        for (int reg = 0; reg < 16; ++reg) st[(32 * pt + crow(reg, lh)) * 64 + 32 * nt + li] = acc[reg];
        if (tid == 0) DEC[(((size_t)d * 4 + b) * 6 + hd) * NCHK + cidx] = __expf(total);
        __syncthreads();
    }
}
DI void hy_rawload(const unsigned* fd, unsigned (&raw)[10]) {
#pragma unroll
    for (int j = 0; j < 5; ++j) { raw[j] = fd[j]; raw[5 + j] = fd[j - 8]; }
}
DI void hy_conv(const bf16_t* ub, const bf16_t* filt, f32x16 (&acc)[2], int nbase, int li, int lh) {
    const int klo = 32 * nbase - 127, khi = 32 * (nbase + 1) + 31;
    const int m0 = 4096 + li - 8 * lh - 7;
    const unsigned sh = (unsigned)(m0 & 1) * 16u;
    const unsigned* fd0 = (const unsigned*)filt + (m0 >> 1);
    unsigned raw[10];
    hy_rawload(fd0 + 16 * klo, raw);
#pragma unroll 4
    for (int k = klo; k <= khi; ++k) {
        u32x4 ua, ub4;
        ua.x = __builtin_amdgcn_alignbit(raw[1], raw[0], sh); ua.y = __builtin_amdgcn_alignbit(raw[2], raw[1], sh); ua.z = __builtin_amdgcn_alignbit(raw[3], raw[2], sh); ua.w = __builtin_amdgcn_alignbit(raw[4], raw[3], sh);
        ub4.x = __builtin_amdgcn_alignbit(raw[6], raw[5], sh); ub4.y = __builtin_amdgcn_alignbit(raw[7], raw[6], sh); ub4.z = __builtin_amdgcn_alignbit(raw[8], raw[7], sh); ub4.w = __builtin_amdgcn_alignbit(raw[9], raw[8], sh);
        const bf16x8 a0 = __builtin_bit_cast(bf16x8, ua), a1 = __builtin_bit_cast(bf16x8, ub4);
        if (k < khi) hy_rawload(fd0 + 16 * (k + 1), raw);
        bf16x8 b0[2], b1[2]; bool use[2];
#pragma unroll
        for (int n = 0; n < 2; ++n) {
            const int nn = nbase + n; use[n] = (k >= 32 * nn - 127) && (k <= 32 * nn + 31);
            const int c = 32 * nn + li - k;
            const bf16_t* up = ub + c * 40 + 8 * lh;
            b0[n] = ld8(up); b1[n] = ld8(up + 16);
        }
#pragma unroll
        for (int n = 0; n < 2; ++n) if (use[n]) { acc[n] = MFMA(a0, b0[n], acc[n]); acc[n] = MFMA(a1, b1[n], acc[n]); }
    }
}
DI u32x4 rev8(u32x4 v) { u32x4 r; r.x = (v.w >> 16) | (v.w << 16); r.y = (v.z >> 16) | (v.z << 16); r.z = (v.y >> 16) | (v.y << 16); r.w = (v.x >> 16) | (v.x << 16); return r; }
DI void hyena_lat_item(const Params& p, int layer, int it, unsigned char* smem) {
    const int ch = it >> 1, bp = it & 1;
    const int tid = get_tid(), lane = tid & 63, wave = tid >> 6, li = lane & 31, lh = lane >> 5;
    const int bl = wave >> 1, nbase = 2 * (wave & 1), bg = 2 * bp + bl;
    constexpr int UB = 192 * 40;
    bf16_t* U = (bf16_t*)smem + 32 * 40;
    bf16_t* Fl = (bf16_t*)smem + 2 * UB;
    float* red = (float*)(Fl + 8192 + 16);
    const bf16_t* P = (const bf16_t*)(p.ws + WS_P); const bf16_t* FL = (const bf16_t*)(p.ws + WS_FL); const float* FP = (const float*)(p.ws + WS_FPL);
    __syncthreads();
    { const int lb = tid & 127, dir = tid >> 7;
      float v0 = wave_sum(FP[lb * 1024 + dir * 512 + ch]), v1 = wave_sum(FP[lb * 1024 + dir * 512 + 256 + ch]);
      if (lane == 0) { red[wave] = v0; red[4 + wave] = v1; } }
    { u32x4 su[4], sf[4];
#pragma unroll
      for (int j = 0; j < 4; ++j) su[j] = *(const u32x4*)(P + (size_t)ch * NT + (size_t)bp * 2 * SEQ + (tid + 256 * j) * 8);
#pragma unroll
      for (int j = 0; j < 4; ++j) sf[j] = *(const u32x4*)(FL + (size_t)(0 * 256 + ch) * 8192 + (tid + 256 * j) * 8);
#pragma unroll
      for (int j = 0; j < 4; ++j) { const int i = tid + 256 * j, b = i >> 9, r = i & 511, blk = r >> 2, q = r & 3; *(u32x4*)(U + b * UB + blk * 40 + q * 8) = rev8(su[j]); }
      { unsigned zz = 0u; asm volatile("" : "+v"(zz)); u32x4 z4; z4.x = zz; z4.y = zz; z4.z = zz; z4.w = zz;
#pragma unroll
        for (int j = 0; j < 3; ++j) { const int i = tid + 256 * j; if (i < 2 * 2 * 32 * 5) { const int b = i / 320, r = i - b * 320, side = r / 160, e = r - side * 160; *(u32x4*)(U + b * UB + (side ? 128 * 40 : -32 * 40) + e * 8) = z4; } } }
#pragma unroll
      for (int j = 0; j < 4; ++j) *(u32x4*)(Fl + (tid + 256 * j) * 8) = sf[j];
      if (tid < 8) ((unsigned*)(Fl + 8192))[tid] = 0u; }
    __syncthreads();
    const float inv0 = 1.f / (red[0] + red[1] + red[2] + red[3] + EPS), inv1 = 1.f / (red[4] + red[5] + red[6] + red[7] + EPS);
    const float d0 = p.in[I_DSH][layer * 512 + ch], d1 = p.in[I_DSH][layer * 512 + 256 + ch];
    bf16_t* ub = U + bl * UB;
    f32x16 acc[2];
    acc[0] = zero16(); acc[1] = zero16();
    hy_conv(ub, Fl, acc, nbase, li, lh);
    __syncthreads();
    { u32x4 sf[4];
#pragma unroll
      for (int j = 0; j < 4; ++j) sf[j] = *(const u32x4*)(FL + (size_t)(1 * 256 + ch) * 8192 + (tid + 256 * j) * 8);
#pragma unroll
      for (int n = 0; n < 2; ++n)
#pragma unroll
        for (int rg = 0; rg < 4; ++rg) {
            const int a = 32 * (nbase + n) + li, ii = 8 * rg + 4 * lh; bf16_t* up = ub + a * 40 + 8 * rg + 4 * (1 - lh);
            const u32x2 zz = *(const u32x2*)up; const u32x2 pp = *(const u32x2*)(P + (size_t)(256 + ch) * NT + bg * SEQ + 32 * a + ii);
            float z[4] = { bf2f((bf16_t)(zz.y >> 16)), bf2f((bf16_t)(zz.y & 0xffff)), bf2f((bf16_t)(zz.x >> 16)), bf2f((bf16_t)(zz.x & 0xffff)) };
            float q[4] = { bf2f((bf16_t)(pp.x & 0xffff)), bf2f((bf16_t)(pp.x >> 16)), bf2f((bf16_t)(pp.y & 0xffff)), bf2f((bf16_t)(pp.y >> 16)) };
            float o[4];
#pragma unroll
            for (int e = 0; e < 4; ++e) o[e] = q[e] * (acc[n][4 * rg + e] * inv0 + z[e] * d0);
            u32x2 w; w.x = pack2(o[3], o[2]); w.y = pack2(o[1], o[0]); *(u32x2*)up = w;
        }
#pragma unroll
      for (int j = 0; j < 4; ++j) *(u32x4*)(Fl + (tid + 256 * j) * 8) = sf[j]; }
    __syncthreads();
    acc[0] = zero16(); acc[1] = zero16();
    hy_conv(ub, Fl, acc, nbase, li, lh);
    bf16_t* HY = (bf16_t*)(p.ws + WS_HYOT);
#pragma unroll
    for (int n = 0; n < 2; ++n)
#pragma unroll
        for (int rg = 0; rg < 4; ++rg) {
            const int a = 32 * (nbase + n) + li, ii = 8 * rg + 4 * lh; const bf16_t* up = ub + a * 40 + 8 * rg + 4 * (1 - lh);
            const u32x2 zz = *(const u32x2*)up; const u32x2 pp = *(const u32x2*)(P + (size_t)(512 + ch) * NT + bg * SEQ + 32 * a + ii);
            float z[4] = { bf2f((bf16_t)(zz.y >> 16)), bf2f((bf16_t)(zz.y & 0xffff)), bf2f((bf16_t)(zz.x >> 16)), bf2f((bf16_t)(zz.x & 0xffff)) };
            float q[4] = { bf2f((bf16_t)(pp.x & 0xffff)), bf2f((bf16_t)(pp.x >> 16)), bf2f((bf16_t)(pp.y & 0xffff)), bf2f((bf16_t)(pp.y >> 16)) };
            float o[4];
#pragma unroll
            for (int e = 0; e < 4; ++e) o[e] = q[e] * (acc[n][4 * rg + e] * inv1 + z[e] * d1);
            u32x2 w; w.x = pack2(o[0], o[1]); w.y = pack2(o[2], o[3]); *(u32x2*)(HY + (size_t)ch * NT + bg * SEQ + 32 * a + ii) = w;
        }
}
DI void hyena_ctx_item(const Params& p, int layer, int ch, unsigned char* smem) {
    const int tid = get_tid();
    float* u = (float*)smem;
    float* f = u + 1024;
    const bf16_t* P = (const bf16_t*)(p.ws + WS_P); const bf16_t* FC = (const bf16_t*)(p.ws + WS_FC); const float* FP = (const float*)(p.ws + WS_FPC);
    bf16_t* HY = (bf16_t*)(p.ws + WS_HYOT);
    __syncthreads();
    float nrm[2] = { 0.f, 0.f };
#pragma unroll
    for (int o = 0; o < 2; ++o) for (int lb = 0; lb < 8; ++lb) nrm[o] += FP[lb * 1024 + o * 256 + ch] + FP[lb * 1024 + 512 + o * 256 + ch];
    for (int i = tid; i < 1024; i += 256) u[i] = bf2f(P[(size_t)ch * NT + NL + i]);
    float zprev[4];
    for (int o = 0; o < 2; ++o) {
        for (int i = tid; i < 512; i += 256) f[i] = bf2f(FC[(size_t)(o * 256 + ch) * 512 + i]);
        __syncthreads();
        float y[4] = { 0.f, 0.f, 0.f, 0.f };
        for (int s = 0; s < 256; ++s) { const float fv = f[256 + tid - s]; y[0] += fv * u[s]; y[1] += fv * u[256 + s]; y[2] += fv * u[512 + s]; y[3] += fv * u[768 + s]; }
        const float inv = 1.f / (nrm[o] + EPS), dsk = p.in[I_DSH][layer * 512 + o * 256 + ch];
#pragma unroll
        for (int b = 0; b < 4; ++b) { const float pv = bf2f(P[(size_t)((o + 1) * 256 + ch) * NT + NL + b * 256 + tid]); zprev[b] = pv * (y[b] * inv + u[b * 256 + tid] * dsk); }
        __syncthreads();
        if (o == 0) {
#pragma unroll
            for (int b = 0; b < 4; ++b) u[b * 256 + tid] = zprev[b]; }
        else {
#pragma unroll
            for (int b = 0; b < 4; ++b) HY[(size_t)ch * NT + NL + b * 256 + tid] = f2bf(zprev[b]); }
        __syncthreads();
    }
}

DI void ssd_scan(const Params& p, int layer) {
    float* ST = (float*)(p.ws + stbase(layer)); const float* DEC = (const float*)(p.ws + stbase(layer) + ST_BYTES);
    const int total = 2 * 4 * 6 * 4096;
    for (int i = blockIdx.x * 256 + get_tid(); i < total; i += gridDim.x * 256) {
        const int e = i & 4095, dbh = i >> 12, d = dbh / 24;
        float* st = ST + (size_t)dbh * NCHK * 4096 + e; const float* dec = DEC + dbh * NCHK;
        float x[NCHK], dc[NCHK];
#pragma unroll
        for (int c = 0; c < NCHK; ++c) { x[c] = st[(size_t)c * 4096]; dc[c] = dec[c]; }
        float s = 0.f;
        if (d == 0) {
#pragma unroll
            for (int c = 0; c < NCHK; ++c) { st[(size_t)c * 4096] = s; s = s * dc[c] + x[c]; } }
        else {
#pragma unroll
            for (int c = 1; c >= 0; --c) { st[(size_t)c * 4096] = s; s = s * dc[c] + x[c]; }
#pragma unroll
            for (int c = NCHK - 1; c >= 2; --c) { st[(size_t)c * 4096] = s; s = s * dc[c] + x[c]; } }
    }
}

DI void ssdC_item(const Params& p, int layer, int it, unsigned char* smem) {
    const int g = it & 1, cidx = (it >> 1) % NCHK, b = it / (2 * NCHK);
    const int tid = get_tid(), lane = tid & 63, wave = tid >> 6, li = lane & 31, lh = lane >> 5;
    constexpr int NS = 72, TS = 136;
    bf16_t* Bn = (bf16_t*)smem;
    bf16_t* Cn = Bn + 128 * NS;
    bf16_t* XT = Cn + 128 * NS;
    float* dtv = (float*)(XT + 64 * TS);
    float* av = dtv + 256;
    float* cum = av + 256;
    const int r0 = chunk_row0(b, cidx);
    const bf16_t* UZ = (const bf16_t*)(p.ws + WS_UZ); const float* DT = (const float*)(p.ws + WS_DT); const float* ST = (const float*)(p.ws + stbase(layer));
    __syncthreads();
    { u32x4 sb[4], sc[4];
#pragma unroll
      for (int q = 0; q < 4; ++q) { const int i = tid + 256 * q, t = i >> 3, c8 = i & 7;
        sb[q] = *(const u32x4*)(UZ + (size_t)(r0 + t) * 1024 + 384 + g * 64 + c8 * 8); sc[q] = *(const u32x4*)(UZ + (size_t)(r0 + t) * 1024 + 512 + g * 64 + c8 * 8); }
#pragma unroll
      for (int q = 0; q < 4; ++q) { const int i = tid + 256 * q, t = i >> 3, c8 = i & 7; *(u32x4*)(Bn + t * NS + c8 * 8) = sb[q]; *(u32x4*)(Cn + t * NS + c8 * 8) = sc[q]; } }
    const int itok = 32 * wave + li;
    float ssq = 0.f;
    bf16_t* orow = (bf16_t*)(p.ws + WS_MIX) + (size_t)(r0 + itok) * 1024 + 384 + g * 192;
#pragma unroll 1
    for (int hh = 0; hh < 3; ++hh) {
        const int hd = g * 3 + hh;
        __syncthreads();
        { const int t = tid & 127, d = tid >> 7; const float dt = DT[(size_t)(r0 + t) * 12 + d * 6 + hd]; const float a = -__expf(p.in[I_ALOG][layer * 12 + d * 6 + hd]); dtv[d * 128 + t] = dt; av[d * 128 + t] = dt * a; }
        { bf16x8 sv[4];
#pragma unroll
          for (int q = 0; q < 4; ++q) { const int i = tid + 256 * q, t = i >> 3, c8 = i & 7; sv[q] = ld8(UZ + (size_t)(r0 + t) * 1024 + hd * 64 + c8 * 8); }
#pragma unroll
          for (int q = 0; q < 4; ++q) { const int i = tid + 256 * q, t = i >> 3, c8 = i & 7;
#pragma unroll
            for (int j = 0; j < 8; ++j) XT[(c8 * 8 + j) * TS + t] = (bf16_t)sv[q][j]; } }
        __syncthreads();
        if (wave < 2) wave_scan128(av + wave * 128, cum + wave * 128, wave == 1, lane);
        __syncthreads();
        f32x16 y0 = zero16(), y1 = zero16();
#pragma unroll 1
        for (int d = 0; d < 2; ++d) {
            const float ci = cum[d * 128 + itok], ei = __expf(ci);
            {
                const float* prev = ST + ((((size_t)d * 4 + b) * 6 + hd) * NCHK + cidx) * 4096;
#pragma unroll
                for (int ks = 0; ks < 4; ++ks) {
                    const f32x4 pa = *(const f32x4*)(prev + (li) * 64 + 16 * ks + 8 * lh), pb = *(const f32x4*)(prev + (li) * 64 + 16 * ks + 8 * lh + 4);
                    const f32x4 pc = *(const f32x4*)(prev + (32 + li) * 64 + 16 * ks + 8 * lh), pd = *(const f32x4*)(prev + (32 + li) * 64 + 16 * ks + 8 * lh + 4);
                    const bf16x8 cr = ld8(Cn + itok * NS + 16 * ks + 8 * lh);
                    const bf16x8 cf = pack8(bf2f((bf16_t)cr[0]) * ei, bf2f((bf16_t)cr[1]) * ei, bf2f((bf16_t)cr[2]) * ei, bf2f((bf16_t)cr[3]) * ei,
                                            bf2f((bf16_t)cr[4]) * ei, bf2f((bf16_t)cr[5]) * ei, bf2f((bf16_t)cr[6]) * ei, bf2f((bf16_t)cr[7]) * ei);
                    y0 = MFMA(pack8(pa.x, pa.y, pa.z, pa.w, pb.x, pb.y, pb.z, pb.w), cf, y0);
                    y1 = MFMA(pack8(pc.x, pc.y, pc.z, pc.w, pd.x, pd.y, pd.z, pd.w), cf, y1);
                }
            }
#pragma unroll 1
            for (int jt = 0; jt < 4; ++jt) {
                if (d == 0 ? (jt > wave) : (jt < wave)) continue;
                f32x16 gt = zero16();
#pragma unroll
                for (int ks = 0; ks < 4; ++ks) gt = MFMA(ld8(Bn + (32 * jt + li) * NS + 16 * ks + 8 * lh), ld8(Cn + itok * NS + 16 * ks + 8 * lh), gt);
#pragma unroll
                for (int r = 0; r < 16; ++r) { const int j = 32 * jt + crow(r, lh); const bool valid = d == 0 ? (j <= itok) : (j >= itok);
                    const float df = fminf(ci - cum[d * 128 + j], 0.f);
                    gt[r] = valid ? gt[r] * __expf(df) * dtv[d * 128 + j] : 0.f; }
                const bf16x8 pf0 = pack8(gt[0], gt[1], gt[2], gt[3], gt[4], gt[5], gt[6], gt[7]), pf1 = pack8(gt[8], gt[9], gt[10], gt[11], gt[12], gt[13], gt[14], gt[15]);
                const bf16_t* xb = XT + li * TS + 32 * jt + 4 * lh;
                y0 = MFMA(ld4x2(xb, xb + 8), pf0, y0); y0 = MFMA(ld4x2(xb + 16, xb + 24), pf1, y0);
                y1 = MFMA(ld4x2(xb + 32 * TS, xb + 32 * TS + 8), pf0, y1); y1 = MFMA(ld4x2(xb + 32 * TS + 16, xb + 32 * TS + 24), pf1, y1);
            }
        }
        const float dsk = p.in[I_DSS][layer * 6 + hd];
        const bf16_t* zrow = UZ + (size_t)(r0 + itok) * 1024 + 640 + hd * 64;
#pragma unroll
        for (int pt = 0; pt < 2; ++pt)
#pragma unroll
            for (int rg = 0; rg < 4; ++rg) {
                const int p0 = 32 * pt + 8 * rg + 4 * lh;
                const u32x2 zz = *(const u32x2*)(zrow + p0);
                const float z[4] = { bf2f((bf16_t)(zz.x & 0xffff)), bf2f((bf16_t)(zz.x >> 16)), bf2f((bf16_t)(zz.y & 0xffff)), bf2f((bf16_t)(zz.y >> 16)) };
                float o[4];
#pragma unroll
                for (int e = 0; e < 4; ++e) { const float yv = (pt ? y1[4 * rg + e] : y0[4 * rg + e]) + bf2f(XT[(p0 + e) * TS + itok]) * dsk; o[e] = yv * silu(z[e]); ssq += o[e] * o[e]; }
                u32x2 w; w.x = pack2(o[0], o[1]); w.y = pack2(o[2], o[3]); *(u32x2*)(orow + hh * 64 + p0) = w;
            }
    }
    ssq += __shfl_xor(ssq, 32);
    const float rstd = 1.f / sqrtf(ssq * (1.f / 192.f) + EPS);
    const float* gn = p.in[I_GSO] + layer * 384 + g * 192;
#pragma unroll 8
    for (int q = 0; q < 24; ++q) {
        const int c = 8 * q + 4 * lh; const u32x2 w = *(const u32x2*)(orow + c); const f32x4 gg = *(const f32x4*)(gn + c);
        u32x2 o; o.x = pack2(bf2f((bf16_t)(w.x & 0xffff)) * rstd * gg.x, bf2f((bf16_t)(w.x >> 16)) * rstd * gg.y);
        o.y = pack2(bf2f((bf16_t)(w.y & 0xffff)) * rstd * gg.z, bf2f((bf16_t)(w.y >> 16)) * rstd * gg.w);
        *(u32x2*)(orow + c) = o;
    }
}

DI int dyn_next(const Params& p, unsigned char* smem, int word) {
    volatile LAS unsigned* st = (volatile LAS unsigned*)(smem + LDS_MAIN);
    __syncthreads();
    if (get_tid() == 0) st[2] = atomicAdd((unsigned*)(p.ws + WS_CTRL) + word, 1u);
    __syncthreads();
    const unsigned v = st[2];
    return v > 0x3fffffffu ? 0x3fffffff : (int)v;
}
#define XCD_TILE_LOOP(MT, NTN, m_, n_) for (int lt_ = (bid >> 3), m_ = 0, n_ = 0; (lt_ < ((MT) >> 3) * (NTN)) && ((m_ = (bid & 7) + 8 * (lt_ / (NTN))), (n_ = lt_ % (NTN)), true); lt_ += (G >> 3))
constexpr int NPHASE = 24, PPL = 12;
DI void run_phase(const Params& p, int ph, unsigned char* smem, int sub = 0) {
    const int layer = ph / PPL, k = ph % PPL, G = gridDim.x, bid = blockIdx.x;
    const float* MOD = (const float*)(p.ws + WS_MOD) + (size_t)layer * 5 * 6144;
    switch (k) {
    case 0: {
        if (layer != 0) break;
        const int n1 = 384, n4 = n1 + WT_IN;
        for (int it = dyn_next(p, smem, 20); it < n4; it = dyn_next(p, smem, 20)) {
            if (it < n1) mod_item(p, it, smem);
            else wprep_item(p, 0, it - n1, smem);
        }
    } break;
    case 1: {
        norm_rows(p, layer, 0, NT, layer == 0);
    } break;
    case 2: {
        bf16_t* PROJ = (bf16_t*)(p.ws + WS_PROJ);
        auto epi = [&](int r, int c, float v, float) { PROJ[(size_t)r * INP + c] = f2bf(v); };
        auto nocol = [&](int, int) { return 0.f; };
        XCD_TILE_LOOP(NT / 128, INP / 128, tm, tn) gemm_tile((const bf16_t*)(p.ws + WS_H), 1024, (const bf16_t*)(p.ws + wbase(layer) + W_IN), 1024, 1024, tm * 128, tn * 128, smem, epi, nocol);
        if (layer == 0) {
            const int n2 = 512, n3 = n2 + 32, n4 = n3 + (WT_TOTAL - WT_IN);
            for (int it = dyn_next(p, smem, 22); it < n4; it = dyn_next(p, smem, 22)) {
                if (it < n2) filt_item<SEQ>(p, 0, it, smem, (bf16_t*)(p.ws + WS_FL), (float*)(p.ws + WS_FPL));
                else if (it < n3) filt_item<CTX>(p, 0, it - n2, smem, (bf16_t*)(p.ws + WS_FC), (float*)(p.ws + WS_FPC));
                else wprep_item(p, 0, WT_IN + (it - n3), smem);
            }
        }
    } break;
    case 3: {
        const int n0 = NT / 128, n1 = n0 + (NT / 128) * 4, n3 = n1 + (NT / 64) * 12;
        for (int it = dyn_next(p, smem, 18 + layer); it < n3; it = dyn_next(p, smem, 18 + layer)) {
            if (it < n0) {
                if (sub == 0 || sub == 2) {
                    float* wl = (float*)smem;
                    __syncthreads();
                    { float tw[10];
#pragma unroll
                      for (int j = 0; j < 10; ++j) { const int i = get_tid() + 256 * j; tw[j] = (i < 1920) ? p.in[I_WCS][layer * 1920 + i] : p.in[I_BCS][layer * 640 + i - 1920]; }
#pragma unroll
                      for (int j = 0; j < 10; ++j) wl[get_tid() + 256 * j] = tw[j]; }
                    __syncthreads();
                    for (int q = 0; q < 4; ++q) ssmconv_item(p, layer, 4 * it + q, wl, wl + 1920);
                    __threadfence_block(); __syncthreads();
                    const int r0 = it * 128; int b, cidx;
                    if (r0 < NL) { b = r0 >> 12; cidx = 2 + ((r0 & 4095) >> 7); } else { b = (r0 - NL) >> 8; cidx = ((r0 - NL) & 255) >> 7; }
                    for (int hd = 0; hd < 6; ++hd) ssdA_item(p, layer, (b * 6 + hd) * NCHK + cidx, smem);
                }
            }
            else if (it < n1) { if (sub == 0 || sub == 1) qkv_item(p, layer, it - n0, smem); }
            else { if (sub == 0 || sub == 3) hyconv_item(p, layer, it - n1, smem); }
        }
    } break;
    case 4: break;
    case 5: ssd_scan(p, layer); break;
    case 6: {
        const int nH = 512, nA = 4 * 6 * 32, nS = 4 * NCHK * 2, nAc = (layer == 0) ? 4 * 6 * 2 : 0, nHc = (layer == 0) ? 256 : 0;
        const int n1 = nH, n2 = n1 + nA, n3 = n2 + nS, n4 = n3 + nAc, n5 = n4 + nHc;
        unsigned* ctr = (unsigned*)(p.ws + WS_CTRL) + 16 + layer;
        volatile LAS unsigned* st = (volatile LAS unsigned*)(smem + LDS_MAIN);
        for (;;) {
            __syncthreads();
            if (get_tid() == 0) st[2] = sub ? 0xffffffffu : atomicAdd(ctr, 1u);
            __syncthreads();
            const int it = (int)st[2];
            if (it < 0 || it >= n5) break;
            if (it < n1) hyena_lat_item(p, layer, it, smem);
            else if (it < n2) { const int j = it - n1, bh = j >> 5, qt = j & 31; attn_item(p, (const bf16_t*)(p.ws + WS_Q) + (size_t)bh * SEQ * 96, bh, qt * 128, NKEY, (bh / 6) * SEQ, smem); }
            else if (it < n3) { const int j = it - n2, cidx = (j >> 1) % NCHK; if (!(layer == 1 && cidx < 2)) ssdC_item(p, layer, j, smem); }
            else if (it < n4) { const int j = it - n3, bh = j >> 1, qt = j & 1; attn_item(p, (const bf16_t*)(p.ws + WS_QC) + (size_t)bh * CTX * 96, bh, qt * 128, CTX, NL + (bh / 6) * CTX, smem); }
            else hyena_ctx_item(p, layer, it - n4, smem);
        }
    } break;
    case 7: break;
    case 8: {
        const float* xin = p.in[I_X]; const float* cin = p.in[I_CTX]; float* out = p.out; float* XC = (float*)(p.ws + WS_XC);
        auto gate = [&](int m0_, int c) { return MOD[(m0_ < NL ? (m0_ >> 12) : 4) * 6144 + 2048 + c]; };
        auto epi = [&](int r, int c, float v, float ga) {
            if (r < NL) { const size_t o = (size_t)r * 1024 + c; out[o] = (layer == 0 ? xin[o] : out[o]) + ga * v; }
            else { const size_t o = (size_t)(r - NL) * 1024 + c; XC[o] = cin[o] + ga * v; } };
        XCD_TILE_LOOP((layer == 0 ? NT : NL) / 128, 8, tm, tn) gemm_tile((const bf16_t*)(p.ws + WS_MIX), 1024, (const bf16_t*)(p.ws + wbase(layer) + W_OUT), 1024, 1024, tm * 128, tn * 128, smem, epi, gate, (const bf16_t*)(p.ws + WS_HYOT));
        if (layer == 0) {
            const int n1 = 512, n2 = n1 + WT_TOTAL;
            for (int it = dyn_next(p, smem, 21); it < n2; it = dyn_next(p, smem, 21)) {
                if (it < n1) filt_item<SEQ>(p, 1, it, smem, (bf16_t*)(p.ws + WS_FL), (float*)(p.ws + WS_FPL));
                else wprep_item(p, 1, it - n1, smem);
            }
        }
    } break;
    case 9: norm_rows(p, layer, 1, layer == 0 ? NT : NL, false); break;
    case 10: {
        bf16_t* HID = (bf16_t*)(p.ws + WS_HID);
        auto epi = [&](int r, int c, float v, float) { const float a = fmaxf(v, 0.f); HID[(size_t)r * 4096 + c] = f2bf(a * a); };
        auto nocol = [&](int, int) { return 0.f; };
        XCD_TILE_LOOP((layer == 0 ? NT : NL) / 128, 32, tm, tn) gemm_tile((const bf16_t*)(p.ws + WS_H), 1024, (const bf16_t*)(p.ws + wbase(layer) + W_FF1), 1024, 1024, tm * 128, tn * 128, smem, epi, nocol);
    } break;
    case 11: {
        float* out = p.out; float* XC = (float*)(p.ws + WS_XC);
        auto gate = [&](int m0_, int c) { return MOD[(m0_ < NL ? (m0_ >> 12) : 4) * 6144 + 5120 + c]; };
        auto epi = [&](int r, int c, float v, float ga) {
            if (r < NL) out[(size_t)r * 1024 + c] += ga * v;
            else XC[(size_t)(r - NL) * 1024 + c] += ga * v; };
        XCD_TILE_LOOP(NL / 128, 8, tm, tn) gemm_tile((const bf16_t*)(p.ws + WS_HID), 4096, (const bf16_t*)(p.ws + wbase(layer) + W_FF2), 4096, 4096, tm * 128, tn * 128, smem, epi, gate);
        if (layer == 0) {
            auto epa = [&](int r, int c, float v, float ga) { atomicAdd(&XC[(size_t)(r - NL) * 1024 + c], ga * v); };
            for (int it = bid; it < 64 * 8; it += G) { const int tl = it >> 3, ks = it & 7;
                gemm_tile((const bf16_t*)(p.ws + WS_HID) + ks * 512, 4096, (const bf16_t*)(p.ws + wbase(layer) + W_FF2) + ks * 512, 4096, 512, NL + (tl / 8) * 128, (tl % 8) * 128, smem, epa, gate); }
        }
    } break;
    }
}

__global__ void __launch_bounds__(NTHREADS, 2) mega_fwd(Params p, int ph_lo, int ph_hi) {
    extern __shared__ __align__(16) unsigned char smem[];
    volatile LAS unsigned* st = (volatile LAS unsigned*)(smem + LDS_MAIN);
    if (__builtin_amdgcn_workitem_id_x() == 0) { st[0] = 0u; st[1] = 0u; }
    __syncthreads();
    const bool multi = ph_hi - ph_lo > 1;
    XcdBarrier xb; xb.bar = (unsigned*)(p.ws + WS_CTRL); xb.x = 0; xb.st = st;
    if (multi) xb = xcd_barrier_post((unsigned*)(p.ws + WS_CTRL), st);
    if (ph_hi < 0) cg::this_grid().sync();
    for (int ph = ph_lo; ph < ph_hi; ++ph) {
        if (ph == PPL || (ph % PPL) == 7 || (ph % PPL) == 4) continue;
        run_phase(p, ph, smem);
#if REP_MASK
        if ((REP_MASK >> (ph % PPL)) & 1) { xcd_barrier(xb); run_phase(p, ph, smem, PROBE_SUB); }
#endif
        if (ph + 1 < ph_hi) xcd_barrier(xb);
    }
}

extern "C" void kernel_launch(void* const* d_in, const int* in_sizes, int n_in, void* d_out, int out_size, void* d_ws, size_t ws_size, hipStream_t stream) {
    static int grid = 0;
    if (grid == 0) {
        if (n_in != 34 || ws_size < WS_TOTAL) { fprintf(stderr, "kernel_launch: unexpected n_in %d / ws %zu (need %zu)\n", n_in, ws_size, (size_t)WS_TOTAL); grid = -1; return; }
        int dev = 0, cus = 0, per_cu = 0;
        hipGetDevice(&dev);
        hipDeviceGetAttribute(&cus, hipDeviceAttributeMultiprocessorCount, dev);
        hipFuncSetAttribute((const void*)mega_fwd, hipFuncAttributeMaxDynamicSharedMemorySize, LDS_BYTES);
        hipOccupancyMaxActiveBlocksPerMultiprocessor(&per_cu, (const void*)mega_fwd, NTHREADS, LDS_BYTES);
        if (per_cu < 1) per_cu = 1;
        if (per_cu > 2) per_cu = 2;
        grid = cus * per_cu;
        fprintf(stderr, "kernel_launch: cus %d per_cu %d grid %d\n", cus, per_cu, grid);
    }
    if (grid < 0) return;
    Params p{};
    for (int i = 0; i < 34; ++i) p.in[i] = (const float*)d_in[i];
    p.out = (float*)d_out; p.ws = (unsigned char*)d_ws;
#if N_LAUNCH_MODE == 1
    hipMemsetAsync((unsigned char*)d_ws + WS_CTRL, 0, XCD_BAR_WORDS * 4, stream);
    int lo = 0, hi = NPHASE;
    void* args[] = { &p, &lo, &hi };
    hipError_t e = hipLaunchCooperativeKernel((const void*)mega_fwd, dim3(grid), dim3(NTHREADS), args, LDS_BYTES, stream);
    if (e != hipSuccess) fprintf(stderr, "cooperative launch failed: %s (grid %d)\n", hipGetErrorString(e), grid);
#else
    for (int ph = 0; ph < NPHASE; ++ph) { if (ph == PPL) continue; mega_fwd<<<dim3(grid), dim3(NTHREADS), LDS_BYTES, stream>>>(p, ph, ph + 1); }
#endif
}
```
